# Optimizing an MI355X kernel written in HIP

```python
import jax
import jax.numpy as jnp
from jax import lax
import numpy as np

D_MODEL = 1024
BATCH = 8
SEQ = 2048
DEPTH = 4

CHUNK = 64
N_EVEN = (DEPTH + 1) // 2
N_ODD = DEPTH // 2
D_FF = 2816
MIX_WIDTH = D_MODEL
RMS_EPS = 1e-6
LN_EPS = 1e-5

GSU_BLOCK = 128
A_GROUPS = 4
D_A = MIX_WIDTH // 2
A_GROUP_DIM = D_A // A_GROUPS
D_B = MIX_WIDTH - D_A
B_HEAD = 64
B_HEADS = D_B // B_HEAD
LORA_W = 64
LORA_A = 64
LORA_G = 128
LNX_EPS = 64e-5
P_B = 3 * D_B + LORA_W + LORA_A + LORA_G
P_EVEN = 2 * D_A + P_B
C_HEADS = 8
Q_LORA = 256
KV_LORA = 128
QK_NOPE = 64
QK_ROPE = 32
V_HEAD = 64
D_C = C_HEADS * V_HEAD
ROPE_THETA = 10000.0
Q_BLOCK = 128
ATTN_SCALE = (QK_NOPE + QK_ROPE) ** -0.5
D_D = MIX_WIDTH - D_C
CONV_K = 31
P_ODD = Q_LORA + KV_LORA + QK_ROPE + 2 * D_D

kernel_name = 'hybrid_chunk_causal_encoder'


def rmsnorm(x, g):
    xf = x.astype(jnp.float32)
    y = xf * lax.rsqrt(jnp.mean(xf * xf, axis=-1, keepdims=True) + RMS_EPS)
    return (y * g.astype(jnp.float32)).astype(x.dtype)


def layernorm(x, g, b, eps):
    xf = x.astype(jnp.float32)
    mu = jnp.mean(xf, axis=-1, keepdims=True)
    var = jnp.mean(jnp.square(xf - mu), axis=-1, keepdims=True)
    y = (xf - mu) * lax.rsqrt(var + eps) * g.astype(jnp.float32) + b.astype(jnp.float32)
    return y.astype(x.dtype)


def swiglu_ffn(x, w_in, w_out):
    gate, up = jnp.split(x @ w_in, 2, axis=-1)
    return (jax.nn.silu(gate) * up) @ w_out


def token_shift(z):
    return jnp.pad(z[:, :-1], ((0, 0), (1, 0), (0, 0)))


def rope_tables(s):
    inv_freq = ROPE_THETA ** (-jnp.arange(0, QK_ROPE, 2, dtype=jnp.float32) / QK_ROPE)
    ang = jnp.arange(s, dtype=jnp.float32)[:, None] * inv_freq[None, :]
    return jnp.cos(ang), jnp.sin(ang)


def apply_rope(x, cos, sin):
    x1, x2 = jnp.split(x, 2, axis=-1)
    c = cos[None, :, None, :]
    s = sin[None, :, None, :]
    return jnp.concatenate([x1 * c - x2 * s, x1 * s + x2 * c], axis=-1).astype(x.dtype)


def gsu_mixer(za, ws, bs, ln_g, ln_b):
    u, v = jnp.split(jax.nn.gelu(za), 2, axis=-1)
    v = layernorm(v, ln_g, ln_b, LN_EPS)
    b, s, _ = v.shape
    vb = v.reshape(b, s // GSU_BLOCK, GSU_BLOCK, A_GROUPS, A_GROUP_DIM)
    pos_chunk = jnp.arange(GSU_BLOCK) // CHUNK
    mask = pos_chunk[:, None] >= pos_chunk[None, :]
    w = jnp.where(mask[None], ws, jnp.zeros_like(ws))
    mixed = jnp.einsum('gij,bnjgc->bnigc', w, vb) + bs.T[None, None, :, :, None]
    return u * mixed.reshape(b, s, D_A)


def rwkv7_mixer(zb, shift_mu, decay_w0, decay_up, iclr_a0, iclr_up, gate_up,
                k_k, k_a, r_k, lnx_g, lnx_b):
    b, s, _ = zb.shape
    z = zb + shift_mu * (token_shift(zb) - zb)
    r, k, v, xw, xa, xg = jnp.split(
        z, [D_B, 2 * D_B, 3 * D_B, 3 * D_B + LORA_W, 3 * D_B + LORA_W + LORA_A], axis=-1)
    logw = -jax.nn.softplus(-(decay_w0 + jnp.tanh(xw) @ decay_up)) - 0.5
    decay = jnp.exp(-jnp.exp(logw.astype(jnp.float32)))
    a = jax.nn.sigmoid(iclr_a0 + xa @ iclr_up)
    g = jax.nn.sigmoid(xg) @ gate_up
    heads = lambda t: t.reshape(b, s, B_HEADS, B_HEAD)
    kk = heads(k * k_k).astype(jnp.float32)
    kk = kk / jnp.maximum(jnp.linalg.norm(kk, axis=-1, keepdims=True), 1e-12)
    k = k * (1.0 + (a - 1.0) * k_a)
    rh, kh, vh, ah = heads(r), heads(k), heads(v), heads(a)
    tm = lambda t: jnp.moveaxis(t, 1, 0).astype(jnp.float32)
    xs = (tm(rh), tm(heads(decay)), tm(kh), tm(vh), tm(-kk), tm(kk * ah))

    def step(state, inp):
        r_t, w_t, k_t, v_t, a_t, b_t = inp
        sa = jnp.einsum('bhvk,bhk->bhv', state, a_t)
        state = (state * w_t[:, :, None, :] + sa[..., None] * b_t[:, :, None, :]
                 + v_t[..., None] * k_t[:, :, None, :])
        return state, jnp.einsum('bhvk,bhk->bhv', state, r_t)

    state0 = jnp.zeros((b, B_HEADS, B_HEAD, B_HEAD), jnp.float32)
    _, y = lax.scan(step, state0, xs)
    y = jnp.moveaxis(y, 0, 1)
    y = layernorm(y, lnx_g.reshape(B_HEADS, B_HEAD), lnx_b.reshape(B_HEADS, B_HEAD), LNX_EPS)
    bonus = jnp.sum(rh * kh * r_k, axis=-1, keepdims=True) * vh
    return ((y + bonus).reshape(b, s, D_B) * g).astype(zb.dtype)


def mla_mixer(cq, ckv, kr, q_norm, wq_up, kv_norm, wkv_up, cos, sin):
    b, s, _ = cq.shape
    q = (rmsnorm(cq, q_norm) @ wq_up).reshape(b, s, C_HEADS, QK_NOPE + QK_ROPE)
    q_nope = q[..., :QK_NOPE]
    q_rope = apply_rope(q[..., QK_NOPE:], cos, sin)
    kv = (rmsnorm(ckv, kv_norm) @ wkv_up).reshape(b, s, C_HEADS, QK_NOPE + V_HEAD)
    k_nope, v = kv[..., :QK_NOPE], kv[..., QK_NOPE:]
    k_rope = apply_rope(kr[:, :, None, :], cos, sin)[:, :, 0]
    n_blk = s // Q_BLOCK

    def to_blocks(t):
        return jnp.moveaxis(t.reshape(b, n_blk, Q_BLOCK, C_HEADS, t.shape[-1]), 1, 0)

    key_chunk = jnp.arange(s) // CHUNK

    def attend(args):
        qn, qr, blk = args
        sc = (jnp.einsum('bqhd,bkhd->bhqk', qn, k_nope)
              + jnp.einsum('bqhd,bkd->bhqk', qr, k_rope))
        sc = sc.astype(jnp.float32) * ATTN_SCALE
        q_chunk = (blk * Q_BLOCK + jnp.arange(Q_BLOCK)) // CHUNK
        sc = jnp.where(key_chunk[None, :] <= q_chunk[:, None], sc, -jnp.inf)
        p = jax.nn.softmax(sc, axis=-1).astype(v.dtype)
        return jnp.einsum('bhqk,bkhd->bqhd', p, v)

    o = lax.map(attend, (to_blocks(q_nope), to_blocks(q_rope), jnp.arange(n_blk)))
    return jnp.moveaxis(o, 0, 1).reshape(b, s, D_C)


def conv_mixer(zd, conv_w, conv_b, ln_g, ln_b):
    h = jax.nn.glu(zd, axis=-1)
    h = lax.conv_general_dilated(h, conv_w[:, None, :], window_strides=(1,),
                                 padding=[(CONV_K - 1, 0)],
                                 dimension_numbers=('NWC', 'WIO', 'NWC'),
                                 feature_group_count=D_D) + conv_b
    return jax.nn.silu(layernorm(h, ln_g, ln_b, LN_EPS))


def setup_inputs(seed: int = 0) -> dict:
    key = jax.random.key(seed)
    ks = iter(jax.random.split(key, 48))
    f32 = jnp.float32

    def nrm(shape, scale):
        return jax.random.normal(next(ks), shape, f32) * scale

    def gain(shape):
        return 1.0 + nrm(shape, 0.01)

    return {
        'x': nrm((BATCH, SEQ, D_MODEL), 1.0),
        'norm_ffn1': gain((DEPTH, D_MODEL)),
        'ffn1_in': nrm((DEPTH, D_MODEL, 2 * D_FF), D_MODEL ** -0.5),
        'ffn1_out': nrm((DEPTH, D_FF, D_MODEL), D_FF ** -0.5),
        'norm_mix': gain((DEPTH, D_MODEL)),
        'norm_ffn2': gain((DEPTH, D_MODEL)),
        'ffn2_in': nrm((DEPTH, D_MODEL, 2 * D_FF), D_MODEL ** -0.5),
        'ffn2_out': nrm((DEPTH, D_FF, D_MODEL), D_FF ** -0.5),
        'even_w_in': nrm((N_EVEN, D_MODEL, P_EVEN), D_MODEL ** -0.5),
        'even_w_out': nrm((N_EVEN, MIX_WIDTH, D_MODEL), MIX_WIDTH ** -0.5),
        'gsu_ws': nrm((N_EVEN, A_GROUPS, GSU_BLOCK, GSU_BLOCK), 0.5 * GSU_BLOCK ** -0.5),
        'gsu_bs': 1.0 + nrm((N_EVEN, A_GROUPS, GSU_BLOCK), 0.1),
        'gsu_ln_g': gain((N_EVEN, D_A)),
        'gsu_ln_b': nrm((N_EVEN, D_A), 0.01),
        'shift_mu': jax.random.uniform(next(ks), (N_EVEN, P_B), f32),
        'decay_w0': jnp.linspace(-6.0, -1.0, D_B, dtype=f32)[None, :] + nrm((N_EVEN, D_B), 0.1),
        'decay_up': nrm((N_EVEN, LORA_W, D_B), 0.1),
        'iclr_a0': nrm((N_EVEN, D_B), 0.1),
        'iclr_up': nrm((N_EVEN, LORA_A, D_B), 0.5 * LORA_A ** -0.5),
        'gate_up': nrm((N_EVEN, LORA_G, D_B), LORA_G ** -0.5),
        'k_k': 0.85 + nrm((N_EVEN, D_B), 0.05),
        'k_a': 1.0 + nrm((N_EVEN, D_B), 0.05),
        'r_k': nrm((N_EVEN, B_HEADS, B_HEAD), 0.1),
        'lnx_g': gain((N_EVEN, D_B)),
        'lnx_b': nrm((N_EVEN, D_B), 0.01),
        'odd_w_in': nrm((N_ODD, D_MODEL, P_ODD), D_MODEL ** -0.5),
        'odd_w_out': nrm((N_ODD, MIX_WIDTH, D_MODEL), MIX_WIDTH ** -0.5),
        'q_norm': gain((N_ODD, Q_LORA)),
        'wq_up': nrm((N_ODD, Q_LORA, C_HEADS * (QK_NOPE + QK_ROPE)), Q_LORA ** -0.5),
        'kv_norm': gain((N_ODD, KV_LORA)),
        'wkv_up': nrm((N_ODD, KV_LORA, C_HEADS * (QK_NOPE + V_HEAD)), KV_LORA ** -0.5),
        'conv_w': nrm((N_ODD, CONV_K, D_D), CONV_K ** -0.5),
        'conv_b': nrm((N_ODD, D_D), 0.01),
        'conv_ln_g': gain((N_ODD, D_D)),
        'conv_ln_b': nrm((N_ODD, D_D), 0.01),
        'final_norm': gain((D_MODEL,)),
    }


def reference(x, norm_ffn1, ffn1_in, ffn1_out, norm_mix, norm_ffn2, ffn2_in, ffn2_out,
              even_w_in, even_w_out, gsu_ws, gsu_bs, gsu_ln_g, gsu_ln_b,
              shift_mu, decay_w0, decay_up, iclr_a0, iclr_up, gate_up,
              k_k, k_a, r_k, lnx_g, lnx_b,
              odd_w_in, odd_w_out, q_norm, wq_up, kv_norm, wkv_up,
              conv_w, conv_b, conv_ln_g, conv_ln_b, final_norm):
    cos, sin = rope_tables(x.shape[1])
    for layer in range(DEPTH):
        x = x + 0.5 * swiglu_ffn(rmsnorm(x, norm_ffn1[layer]), ffn1_in[layer], ffn1_out[layer])
        h = rmsnorm(x, norm_mix[layer])
        if layer % 2 == 0:
            e = layer // 2
            z = h @ even_w_in[e]
            ya = gsu_mixer(z[..., :2 * D_A], gsu_ws[e], gsu_bs[e], gsu_ln_g[e], gsu_ln_b[e])
            yb = rwkv7_mixer(z[..., 2 * D_A:], shift_mu[e], decay_w0[e], decay_up[e],
                             iclr_a0[e], iclr_up[e], gate_up[e], k_k[e], k_a[e], r_k[e],
                             lnx_g[e], lnx_b[e])
            x = x + jnp.concatenate([ya, yb], axis=-1) @ even_w_out[e]
        else:
            o = layer // 2
            z = h @ odd_w_in[o]
            cq = z[..., :Q_LORA]
            ckv = z[..., Q_LORA:Q_LORA + KV_LORA]
            kr = z[..., Q_LORA + KV_LORA:Q_LORA + KV_LORA + QK_ROPE]
            zd = z[..., Q_LORA + KV_LORA + QK_ROPE:]
            yc = mla_mixer(cq, ckv, kr, q_norm[o], wq_up[o], kv_norm[o], wkv_up[o], cos, sin)
            yd = conv_mixer(zd, conv_w[o], conv_b[o], conv_ln_g[o], conv_ln_b[o])
            x = x + jnp.concatenate([yc, yd], axis=-1) @ odd_w_out[o]
        x = x + 0.5 * swiglu_ffn(rmsnorm(x, norm_ffn2[layer]), ffn2_in[layer], ffn2_out[layer])
    return rmsnorm(x, final_norm)
```

```cpp
#include <hip/hip_runtime.h>
#include <hip/hip_cooperative_groups.h>
#include <cstdio>
#include <cstdint>
namespace cg = cooperative_groups;

#ifndef MK_MULTI
#define MK_MULTI 1
#endif

#ifndef PHM
#define PHM 0xFFFF
#endif
#define PH(b) ((PHM >> (b)) & 1)
#define LAS __attribute__((address_space(3)))
typedef unsigned short bf16_t;
typedef short bf16x8 __attribute__((ext_vector_type(8)));
typedef float f32x4 __attribute__((ext_vector_type(4)));
typedef float f32x2 __attribute__((ext_vector_type(2)));
typedef unsigned u32x4 __attribute__((ext_vector_type(4)));
typedef unsigned u32x2 __attribute__((ext_vector_type(2)));
typedef __bf16 bf16x2_t __attribute__((ext_vector_type(2)));

constexpr int T = 16384, DM = 1024, FF = 2816, SEQ = 2048, NBATCH = 8, DEPTH = 4;
constexpr int PE = 2816, PO = 1440, POP = 1536;
constexpr int PB = 1792;
constexpr float RMS_EPS = 1e-6f;
constexpr float QSCALE = 0.10206207261596575f * 1.4426950408889634f;

constexpr size_t MiB = 1u << 20;
constexpr size_t WS_SSQ = 1 * MiB;
constexpr size_t WS_PQ = 2 * MiB;
constexpr size_t WS_PKV = 2 * MiB + 256 * 1024;
constexpr size_t WS_COS = 2 * MiB + 512 * 1024;
constexpr size_t WS_SIN = 2 * MiB + 640 * 1024;
constexpr size_t WS_CB = 3 * MiB;
constexpr size_t WS_WBUF0 = 4 * MiB, WBUF_BYTES = 42 * MiB;
constexpr size_t WS_XB = 88 * MiB;
constexpr size_t WS_YMIX = 120 * MiB;
constexpr size_t WS_ACT = 152 * MiB;
constexpr size_t WS_SC = 240 * MiB;
constexpr size_t WS_Y = 336 * MiB;
constexpr size_t WS_END = 368 * MiB;
constexpr size_t WB_W1IN = 0, WB_W1OUT = 11534336, WB_W2IN = 17301504, WB_W2OUT = 28835840, WB_WMIN = 34603008, WB_WMOUT = 40370176, WB_WX = 42467328;
constexpr size_t SC_Q = 0, SC_KV = 24 * MiB, SC_KR = 56 * MiB;

constexpr int LDS_BYTES = 147456;

__device__ __forceinline__ unsigned pk2(float lo, float hi) { f32x2 v = {lo, hi}; bf16x2_t b = __builtin_convertvector(v, bf16x2_t); return __builtin_bit_cast(unsigned, b); }
__device__ __forceinline__ float bflo(unsigned u) { return __uint_as_float(u << 16); }
__device__ __forceinline__ float bfhi(unsigned u) { return __uint_as_float(u & 0xffff0000u); }
__device__ __forceinline__ float bf1(bf16_t h) { return __uint_as_float((unsigned)h << 16); }
__device__ __forceinline__ f32x4 unpack4(u32x2 u) { return (f32x4){bflo(u.x), bfhi(u.x), bflo(u.y), bfhi(u.y)}; }
__device__ __forceinline__ u32x2 pack4(f32x4 v) { u32x2 r; r.x = pk2(v[0], v[1]); r.y = pk2(v[2], v[3]); return r; }
__device__ __forceinline__ float wave_sum(float v) {
#pragma unroll
    for (int o = 1; o < 64; o <<= 1) v += __shfl_xor(v, o);
    return v;
}
__device__ __forceinline__ float sigmoidf_(float x) { return 1.0f / (1.0f + __expf(-x)); }
__device__ __forceinline__ float gelu_tanh(float x) { const float u = 1.5957691216057308f * (x + 0.044715f * x * x * x); return x / (1.0f + __expf(-u)); }
__device__ __forceinline__ float tanh_(float x) { return 1.0f - 2.0f / (1.0f + __expf(2.0f * x)); }

namespace pg8 {
constexpr int BM = 256, BK = 64, HALF = 128, HTB = HALF * BK * 2, STAGE_BYTES = 8 * HTB, NXCD = 8, WGM = 8;
__host__ __device__ __forceinline__ int lds_byte(int r, int c) { const int st = (r >> 4) * 2 + (c >> 5), rr = r & 15, cc = c & 31, ob = rr * 64 + cc * 2; return st * 1024 + (ob ^ (((ob >> 9) & 1) << 5)); }
__host__ __device__ __forceinline__ void stage_rc(int b, int& R, int& C) { const int st = b / 1024, sb = b % 1024, swz = sb ^ (((sb >> 9) & 1) << 5); R = (st >> 1) * 16 + swz / 64; C = (st & 1) * 32 + (swz % 64) / 2; }
struct Unit { int pm, pn; };
struct Gemm { const bf16_t* A; const bf16_t* Bt; int M, N, K, lda, ldb; };
struct StaticOrder {
    int nM, nN, nwg, G, c;
    __device__ void init(int M, int N, int G_, int c_) { nM = M / BM; nN = N / BM; nwg = nM * nN; G = G_; c = c_; }
    __device__ bool next(int i, Unit& u) const {
        const int L = i * G + c; if (L >= nwg) return false;
        int wgid = L; { const int q = nwg / NXCD, r = nwg % NXCD, xcd = wgid % NXCD, off = wgid / NXCD; wgid = (xcd < r ? xcd * (q + 1) : r * (q + 1) + (xcd - r) * q) + off; }
        const int nig = WGM * nN, gid = wgid / nig, fm = gid * WGM, gsz = (nM - fm) < WGM ? (nM - fm) : WGM;
        u.pm = fm + ((wgid % nig) % gsz); u.pn = (wgid % nig) / gsz; return true;
    }
};
template <class Epi>
__device__ __forceinline__ void gemm_phase(LAS unsigned char* lds, const Gemm g, const StaticOrder& S, const Epi& E) {
    int tid_ = threadIdx.x; asm volatile("" : "+v"(tid_));
    const int tid = tid_, wid = __builtin_amdgcn_readfirstlane(tid >> 6), lane = tid & 63, wr = wid >> 2, wc = wid & 3, fr = lane & 15, fq = lane >> 4;
    const int K = g.K, nt = K / BK;
    unsigned voffA[2], voffB[2];
#pragma unroll
    for (int i = 0; i < 2; ++i) { int R, C; stage_rc(tid * 16 + i * 8192, R, C); voffA[i] = (unsigned)(R * g.lda + C) * 2u; voffB[i] = (unsigned)(R * g.ldb + C) * 2u; }
    const size_t kstep = (size_t)(BK * 2);
    const size_t hsA = (size_t)HALF * g.lda * 2, hsB = (size_t)HALF * g.ldb * 2;
    const size_t tsA = 2 * hsA, tsB = 2 * hsB;
    const unsigned ldsw = (unsigned)wid * 1024u;
    const int aoff = lds_byte(wr * 64 + fr, fq * 8), boff = lds_byte(wc * 32 + fr, fq * 8);
#define PG8_SA(b, h) (((b) * 2 + (h)) * HTB)
#define PG8_SB(b, h) ((4 + (b) * 2 + (h)) * HTB)
#define PG8_STAGE(bufoff, gbase, voff) do { _Pragma("unroll") for (int _i = 0; _i < 2; ++_i) \
        __builtin_amdgcn_global_load_lds((const unsigned*)((const char*)(gbase) + (voff)[_i]), (LAS unsigned*)(lds + (bufoff) + ldsw + _i * 8192), 16, 0, 0); } while (0)
#define PG8_LDA(dst, b, h) do { _Pragma("unroll") for (int m = 0; m < 4; ++m) _Pragma("unroll") for (int k = 0; k < 2; ++k) dst[m][k] = *(const LAS bf16x8*)(lds + PG8_SA(b, h) + aoff + m * 2048 + k * 1024); } while (0)
#define PG8_LDB(dst, b, h) do { _Pragma("unroll") for (int n = 0; n < 2; ++n) _Pragma("unroll") for (int k = 0; k < 2; ++k) dst[n][k] = *(const LAS bf16x8*)(lds + PG8_SB(b, h) + boff + n * 2048 + k * 1024); } while (0)
#define PG8_MMA(ai, bj, At, Bt) do { __builtin_amdgcn_s_setprio(1); _Pragma("unroll") for (int m = 0; m < 4; ++m) _Pragma("unroll") for (int n = 0; n < 2; ++n) _Pragma("unroll") for (int k = 0; k < 2; ++k) \
        acc[ai][bj][m][n] = __builtin_amdgcn_mfma_f32_16x16x32_bf16(Bt[n][k], At[m][k], acc[ai][bj][m][n], 0, 0, 0); __builtin_amdgcn_s_setprio(0); } while (0)
#define PG8_WAIT_V(n) asm volatile("s_waitcnt vmcnt(" #n ")" ::: "memory")
#define PG8_WAIT_L(n) asm volatile("s_waitcnt lgkmcnt(" #n ")" ::: "memory")
#define PG8_BAR __builtin_amdgcn_s_barrier()
#define PG8_SCHED __builtin_amdgcn_sched_barrier(0)
    Unit cur, nxt; int ui = 0;
    if (!S.next(0, cur)) return;
    f32x4 acc[2][2][4][2];
#pragma unroll
    for (int a = 0; a < 2; ++a)
#pragma unroll
        for (int b = 0; b < 2; ++b)
#pragma unroll
            for (int m = 0; m < 4; ++m)
#pragma unroll
                for (int n = 0; n < 2; ++n) acc[a][b][m][n] = (f32x4){0.f, 0.f, 0.f, 0.f};
    bf16x8 At[4][2], B0[2][2], B1[2][2];
    const char* cA = (const char*)g.A + (size_t)cur.pm * tsA; const char* cB = (const char*)g.Bt + (size_t)cur.pn * tsB;
    PG8_STAGE(PG8_SB(0, 0), cB, voffB); PG8_STAGE(PG8_SB(0, 1), cB + hsB, voffB); PG8_STAGE(PG8_SA(0, 0), cA, voffA); PG8_STAGE(PG8_SA(0, 1), cA + hsA, voffA);
    if (wr == 1) PG8_BAR;
    PG8_WAIT_V(2); PG8_BAR;
    PG8_STAGE(PG8_SB(1, 0), cB + kstep, voffB); PG8_STAGE(PG8_SA(1, 0), cA + kstep, voffA); PG8_STAGE(PG8_SB(1, 1), cB + hsB + kstep, voffB);
    PG8_WAIT_V(6); PG8_BAR;
    for (;;) {
        const bool has_next = S.next(ui + 1, nxt);
        const char* nA = has_next ? (const char*)g.A + (size_t)nxt.pm * tsA : cA; const char* nB = has_next ? (const char*)g.Bt + (size_t)nxt.pn * tsB : cB;
#pragma unroll 1
        for (int t = 0; t < nt; t += 2) {
            const bool last = (t == nt - 2);
            const char* a1 = cA + (size_t)(t + 1) * kstep;
            const char* a2 = last ? nA : cA + (size_t)(t + 2) * kstep; const char* b2 = last ? nB : cB + (size_t)(t + 2) * kstep;
            const char* a3 = a2 + kstep; const char* b3 = b2 + kstep;
            PG8_LDB(B0, 0, 0); PG8_LDB(B1, 0, 1); PG8_SCHED; PG8_LDA(At, 0, 0); PG8_STAGE(PG8_SA(1, 1), a1 + hsA, voffA);
            PG8_WAIT_V(8); PG8_WAIT_L(0); PG8_BAR; PG8_MMA(0, 0, At, B0); PG8_MMA(0, 1, At, B1); PG8_BAR; PG8_SCHED;
            PG8_LDA(At, 0, 1); PG8_STAGE(PG8_SB(0, 0), b2, voffB); PG8_STAGE(PG8_SB(0, 1), b2 + hsB, voffB); PG8_STAGE(PG8_SA(0, 0), a2, voffA);
            PG8_WAIT_V(8); PG8_WAIT_L(0); PG8_BAR; PG8_MMA(1, 0, At, B0); PG8_MMA(1, 1, At, B1); PG8_BAR; PG8_SCHED;
            PG8_LDB(B0, 1, 0); PG8_LDB(B1, 1, 1); PG8_SCHED; PG8_LDA(At, 1, 0); PG8_STAGE(PG8_SA(0, 1), a2 + hsA, voffA);
            PG8_WAIT_V(8); PG8_WAIT_L(0); PG8_BAR; PG8_MMA(0, 0, At, B0); PG8_MMA(0, 1, At, B1); PG8_BAR; PG8_SCHED;
            PG8_LDA(At, 1, 1); PG8_STAGE(PG8_SB(1, 0), b3, voffB); PG8_STAGE(PG8_SB(1, 1), b3 + hsB, voffB); PG8_STAGE(PG8_SA(1, 0), a3, voffA);
            PG8_WAIT_V(8); PG8_WAIT_L(0); PG8_BAR; PG8_MMA(1, 0, At, B0); PG8_MMA(1, 1, At, B1); PG8_BAR; PG8_SCHED;
        }
        if (wr == 0) PG8_BAR;
        E(acc, cur, wr, wc, fr, fq);
        if (!has_next) break;
#pragma unroll
        for (int a = 0; a < 2; ++a)
#pragma unroll
            for (int b = 0; b < 2; ++b)
#pragma unroll
                for (int m = 0; m < 4; ++m)
#pragma unroll
                    for (int n = 0; n < 2; ++n) acc[a][b][m][n] = (f32x4){0.f, 0.f, 0.f, 0.f};
        cur = nxt; cA = nA; cB = nB; ++ui;
        if (wr == 1) PG8_BAR;
    }
    PG8_WAIT_V(0);
    PG8_BAR;
#undef PG8_SA
#undef PG8_SB
#undef PG8_STAGE
#undef PG8_LDA
#undef PG8_LDB
#undef PG8_MMA
#undef PG8_WAIT_V
#undef PG8_WAIT_L
#undef PG8_BAR
#undef PG8_SCHED
}
}
using pg8::Unit;

__device__ __forceinline__ float row_rstd16(const float* ssq, int row, int fq) {
    const unsigned o = (unsigned)(4 * fq) * T + row;
    float s = (ssq[o] + ssq[o + T]) + (ssq[o + 2 * T] + ssq[o + 3 * T]);
    s += __shfl_xor(s, 16); s += __shfl_xor(s, 32);
    return rsqrtf(s * (1.0f / 1024.0f) + RMS_EPS);
}

struct EpiSwiGLU {
    bf16_t* act; const float* ssq;
    __device__ __forceinline__ void operator()(const f32x4 (&acc)[2][2][4][2], const Unit& u, int wr, int wc, int fr, int fq) const {
        const int row0 = u.pm * 256 + wr * 64 + fr;
        const unsigned off0 = (unsigned)row0 * FF + u.pn * 128 + wc * 16 + fq * 4;
#pragma unroll
        for (int ai = 0; ai < 2; ++ai)
#pragma unroll
            for (int m = 0; m < 4; ++m) {
                const float rs = row_rstd16(ssq, row0 + ai * 128 + m * 16, fq);
#pragma unroll
                for (int bj = 0; bj < 2; ++bj) {
                    const f32x4 gt = acc[ai][bj][m][0] * rs, up = acc[ai][bj][m][1] * rs; f32x4 o;
#pragma unroll
                    for (int k = 0; k < 4; ++k) o[k] = gt[k] * up[k] / (1.0f + __expf(-gt[k]));
                    *(u32x2*)(act + (off0 + (unsigned)((ai * 128 + m * 16) * FF + bj * 64))) = pack4(o);
                }
                asm volatile("" ::: "memory");
            }
    }
};
struct EpiResid {
    const float* base; float* out; bf16_t* xb; float* ssq; float scale;
    __device__ __forceinline__ void operator()(const f32x4 (&acc)[2][2][4][2], const Unit& u, int wr, int wc, int fr, int fq) const {
        const int row0 = u.pm * 256 + wr * 64 + fr;
        const unsigned off0 = (unsigned)row0 * DM + u.pn * 256 + wc * 32 + fq * 4;
        const unsigned so = (unsigned)(u.pn * 4 + wc) * T + row0;
#pragma unroll
        for (int ai = 0; ai < 2; ++ai)
#pragma unroll
            for (int m = 0; m < 4; ++m) {
                float ss = 0.f;
#pragma unroll
                for (int bj = 0; bj < 2; ++bj)
#pragma unroll
                    for (int n = 0; n < 2; ++n) {
                        const unsigned o2 = off0 + (unsigned)((ai * 128 + m * 16) * DM + bj * 128 + n * 16);
                        const f32x4 v = *(const f32x4*)(base + o2) + acc[ai][bj][m][n] * scale;
                        *(f32x4*)(out + o2) = v; *(u32x2*)(xb + o2) = pack4(v);
                        ss += (v[0] * v[0] + v[1] * v[1]) + (v[2] * v[2] + v[3] * v[3]);
                    }
                ss += __shfl_xor(ss, 16); ss += __shfl_xor(ss, 32);
                if (fq == 0) ssq[so + (unsigned)(ai * 128 + m * 16)] = ss;
                asm volatile("" ::: "memory");
            }
    }
};
template <bool ODD> struct EpiZ {
    bf16_t* z; int ldz; const float* ssq; float* pq; float* pkv;
    __device__ __forceinline__ void operator()(const f32x4 (&acc)[2][2][4][2], const Unit& u, int wr, int wc, int fr, int fq) const {
        const int row0 = u.pm * 256 + wr * 64 + fr;
        const unsigned off0 = (unsigned)row0 * ldz + u.pn * 256 + wc * 32 + fq * 4;
#pragma unroll
        for (int ai = 0; ai < 2; ++ai)
#pragma unroll
            for (int m = 0; m < 4; ++m) {
                const int row = row0 + ai * 128 + m * 16;
                const float rs = row_rstd16(ssq, row, fq);
                float s0 = 0.f, s1 = 0.f;
#pragma unroll
                for (int bj = 0; bj < 2; ++bj)
#pragma unroll
                    for (int n = 0; n < 2; ++n) {
                        const f32x4 v = acc[ai][bj][m][n] * rs;
                        *(u32x2*)(z + (off0 + (unsigned)((ai * 128 + m * 16) * ldz + bj * 128 + n * 16))) = pack4(v);
                        const float q = (v[0] * v[0] + v[1] * v[1]) + (v[2] * v[2] + v[3] * v[3]);
                        if (bj == 0) s0 += q; else s1 += q;
                    }
                if (ODD) {
                    if (u.pn == 0) { float s = s0 + s1; s += __shfl_xor(s, 16); s += __shfl_xor(s, 32); if (fq == 0) pq[(unsigned)wc * T + row] = s; }
                    else if (u.pn == 1) { float s = s0; s += __shfl_xor(s, 16); s += __shfl_xor(s, 32); if (fq == 0) pkv[(unsigned)wc * T + row] = s; }
                }
                asm volatile("" ::: "memory");
            }
    }
};
struct EpiUp {
    bf16_t* q; bf16_t* kv; const float* pq; const float* pkv; const float* cosT; const float* sinT;
    __device__ __forceinline__ void operator()(const f32x4 (&acc)[2][2][4][2], const Unit& u, int wr, int wc, int fr, int fq) const {
        if (u.pn < 3) {
#pragma unroll
            for (int ai = 0; ai < 2; ++ai)
#pragma unroll
                for (int m = 0; m < 4; ++m) {
                    const int row = u.pm * 256 + ai * 128 + wr * 64 + m * 16 + fr;
                    const float s = (pq[(unsigned)row] + pq[(unsigned)(T + row)]) + (pq[(unsigned)(2 * T + row)] + pq[(unsigned)(3 * T + row)]);
                    const float rs = rsqrtf(s * (1.0f / 256.0f) + RMS_EPS) * QSCALE;
                    const int pos = row & (SEQ - 1);
#pragma unroll
                    for (int bj = 0; bj < 2; ++bj) {
                        f32x4 v0 = acc[ai][bj][m][0] * rs, v1 = acc[ai][bj][m][1] * rs;
                        const int G = u.pn * 8 + bj * 4 + wc;
                        if ((G % 3) == 2) {
                            const f32x4 c4 = *(const f32x4*)(cosT + (unsigned)(pos * 16 + fq * 4)), s4 = *(const f32x4*)(sinT + (unsigned)(pos * 16 + fq * 4));
                            const f32x4 o0 = v0 * c4 - v1 * s4, o1 = v0 * s4 + v1 * c4; v0 = o0; v1 = o1;
                        }
                        bf16_t* rp = q + (unsigned)(row * 768 + G * 32 + fq * 4);
                        *(u32x2*)(rp) = pack4(v0); *(u32x2*)(rp + 16) = pack4(v1);
                    }
                    asm volatile("" ::: "memory");
                }
        } else {
#pragma unroll
            for (int ai = 0; ai < 2; ++ai)
#pragma unroll
                for (int m = 0; m < 4; ++m) {
                    const int row = u.pm * 256 + ai * 128 + wr * 64 + m * 16 + fr;
                    const float s = (pkv[(unsigned)row] + pkv[(unsigned)(T + row)]) + (pkv[(unsigned)(2 * T + row)] + pkv[(unsigned)(3 * T + row)]);
                    const float rs = rsqrtf(s * (1.0f / 128.0f) + RMS_EPS);
#pragma unroll
                    for (int bj = 0; bj < 2; ++bj) {
                        const f32x4 v0 = acc[ai][bj][m][0] * rs, v1 = acc[ai][bj][m][1] * rs;
                        bf16_t* rp = kv + (unsigned)(row * 1024 + (u.pn - 3) * 256 + bj * 128 + wc * 32 + fq * 4);
                        *(u32x2*)(rp) = pack4(v0); *(u32x2*)(rp + 16) = pack4(v1);
                    }
                    asm volatile("" ::: "memory");
                }
        }
    }
};

template <int K> __device__ __forceinline__ const float* inp() {
    unsigned long long v;
    asm volatile("s_load_dwordx2 %0, %1, %2\n\ts_waitcnt lgkmcnt(0)" : "=s"(v) : "s"(__builtin_amdgcn_kernarg_segment_ptr()), "n"(K * 8) : "memory");
    return (const float*)v;
}
struct Args { const float* in[36]; float* out; unsigned char* ws; int ph_lo, ph_hi; };
struct Frame {
    LAS unsigned char* lds;
    int tid, lane, wave, G, bid;
    float* out; unsigned char* ws;
};

__device__ __forceinline__ void cvt_item(const float* W, int N, const float* gain, bf16_t* WT, int ldt, int kdst, int mode, LAS float* scr, int item, int lane) {
    const int nblk = N / 32, kb = item / nblk, nb = item % nblk, k0 = 64 * kb, n0 = 32 * nb;
#pragma unroll 8
    for (int i = 0; i < 32; ++i) { const int kk = 2 * i + (lane >> 5); const float gk = gain ? gain[k0 + kk] : 1.0f; scr[kk * 33 + (lane & 31)] = W[(size_t)(k0 + kk) * N + n0 + (lane & 31)] * gk; }
    asm volatile("s_waitcnt lgkmcnt(0)" ::: "memory");
    const int c = lane & 7;
#pragma unroll
    for (int j = 0; j < 4; ++j) {
        const int n = (lane >> 3) + 8 * j; const LAS float* s = scr + (8 * c) * 33 + n;
        u32x4 o; o.x = pk2(s[0 * 33], s[1 * 33]); o.y = pk2(s[2 * 33], s[3 * 33]); o.z = pk2(s[4 * 33], s[5 * 33]); o.w = pk2(s[6 * 33], s[7 * 33]);
        int nn = n0 + n;
        if (mode == 1) { const int which = nn >= FF ? 1 : 0, h = nn - which * FF; nn = 32 * (h >> 4) + 16 * which + (h & 15); }
        *(u32x4*)(WT + (size_t)nn * ldt + kdst + k0 + 8 * c) = o;
    }
    asm volatile("s_waitcnt lgkmcnt(0)" ::: "memory");
}
__device__ __forceinline__ void zero_fill16(unsigned char* base, int row_bytes_stride, int col_byte0, int chunks_per_row, int nrows, int gtid, int gthreads) {
    const int total = nrows * chunks_per_row;
    for (int i = gtid; i < total; i += gthreads) { const int r = i / chunks_per_row, c = i % chunks_per_row; *(u32x4*)(base + (size_t)r * row_bytes_stride + col_byte0 + c * 16) = (u32x4){0u, 0u, 0u, 0u}; }
}
__device__ __forceinline__ void convert_layer(const Frame& F, int l) {
    unsigned char* wb = F.ws + WS_WBUF0 + (size_t)(l & 1) * WBUF_BYTES;
    LAS float* scr = (LAS float*)(F.lds + F.wave * 16384);
    const int gw = F.bid * 8 + F.wave, NGW = F.G * 8;
    const int hl = l >> 1; const bool odd = l & 1;
    constexpr int I_IN = 16 * 176, I_OUT = 44 * 32, I_MO = 16 * 32;
    const int I_MI = odd ? 16 * 45 : 16 * 88;
    const int I_X = odd ? (4 * 24 + 2 * 32) : (16 + 16 + 32);
    const int total = 2 * I_IN + 2 * I_OUT + I_MI + I_MO + I_X;
    for (int it = gw; it < total; it += NGW) {
        int r = it;
        if (r < I_IN) { cvt_item(inp<2>() + (size_t)l * DM * 2 * FF, 2 * FF, inp<1>() + l * DM, (bf16_t*)(wb + WB_W1IN), DM, 0, 1, scr, r, F.lane); continue; } r -= I_IN;
        if (r < I_IN) { cvt_item(inp<6>() + (size_t)l * DM * 2 * FF, 2 * FF, inp<5>() + l * DM, (bf16_t*)(wb + WB_W2IN), DM, 0, 1, scr, r, F.lane); continue; } r -= I_IN;
        if (r < I_OUT) { cvt_item(inp<3>() + (size_t)l * FF * DM, DM, nullptr, (bf16_t*)(wb + WB_W1OUT), FF, 0, 0, scr, r, F.lane); continue; } r -= I_OUT;
        if (r < I_OUT) { cvt_item(inp<7>() + (size_t)l * FF * DM, DM, nullptr, (bf16_t*)(wb + WB_W2OUT), FF, 0, 0, scr, r, F.lane); continue; } r -= I_OUT;
        if (r < I_MI) {
            if (odd) cvt_item(inp<25>() + (size_t)hl * DM * PO, PO, inp<4>() + l * DM, (bf16_t*)(wb + WB_WMIN), DM, 0, 0, scr, r, F.lane);
            else cvt_item(inp<8>() + (size_t)hl * DM * PE, PE, inp<4>() + l * DM, (bf16_t*)(wb + WB_WMIN), DM, 0, 0, scr, r, F.lane);
            continue; } r -= I_MI;
        if (r < I_MO) { cvt_item((odd ? inp<26>() : inp<9>()) + (size_t)hl * DM * DM, DM, nullptr, (bf16_t*)(wb + WB_WMOUT), DM, 0, 0, scr, r, F.lane); continue; } r -= I_MO;
        if (odd) {
            if (r < 96) { cvt_item(inp<28>() + (size_t)hl * 256 * 768, 768, inp<27>() + hl * 256, (bf16_t*)(wb + WB_WX), 384, 0, 0, scr, r, F.lane); continue; } r -= 96;
            cvt_item(inp<30>() + (size_t)hl * 128 * 1024, 1024, inp<29>() + hl * 128, (bf16_t*)(wb + WB_WX) + (size_t)768 * 384, 384, 256, 0, scr, r, F.lane);
        } else {
            if (r < 16) { cvt_item(inp<16>() + (size_t)hl * 64 * 512, 512, nullptr, (bf16_t*)(wb + WB_WX), 64, 0, 0, scr, r, F.lane); continue; } r -= 16;
            if (r < 16) { cvt_item(inp<18>() + (size_t)hl * 64 * 512, 512, nullptr, (bf16_t*)(wb + WB_WX) + 512 * 64, 64, 0, 0, scr, r, F.lane); continue; } r -= 16;
            cvt_item(inp<19>() + (size_t)hl * 128 * 512, 512, nullptr, (bf16_t*)(wb + WB_WX) + 2 * 512 * 64, 128, 0, 0, scr, r, F.lane);
        }
    }
    if (odd) {
        const int gtid = F.bid * 512 + F.tid, gth = F.G * 512;
        zero_fill16(wb + WB_WMIN + (size_t)PO * DM * 2, DM * 2, 0, 128, POP - PO, gtid, gth);
        zero_fill16(wb + WB_WX, 384 * 2, 512, 16, 768, gtid, gth);
        zero_fill16(wb + WB_WX + (size_t)768 * 384 * 2, 384 * 2, 0, 32, 1024, gtid, gth);
    }
}

__device__ __forceinline__ void x_prologue(const Frame& F) {
    const float* x = inp<0>(); bf16_t* xb = (bf16_t*)(F.ws + WS_XB); float* ssq = (float*)(F.ws + WS_SSQ);
    const int gw = F.bid * 8 + F.wave, NGW = F.G * 8, lane = F.lane;
    for (int m = gw; m < T; m += NGW) {
        const f32x4* xr = (const f32x4*)(x + (size_t)m * DM) + lane;
        f32x4 v[4]; float s = 0.f;
#pragma unroll
        for (int j = 0; j < 4; ++j) { v[j] = xr[64 * j]; s += (v[j][0] * v[j][0] + v[j][1] * v[j][1]) + (v[j][2] * v[j][2] + v[j][3] * v[j][3]); }
        s = wave_sum(s);
        u32x2* o = (u32x2*)(xb + (size_t)m * DM) + lane;
#pragma unroll
        for (int j = 0; j < 4; ++j) o[64 * j] = pack4(v[j]);
        if (lane < 16) ssq[(size_t)lane * T + m] = (lane == 0) ? s : 0.f;
    }
    float* cosT = (float*)(F.ws + WS_COS); float* sinT = (float*)(F.ws + WS_SIN);
    for (int i = F.bid * 512 + F.tid; i < SEQ * 16; i += F.G * 512) {
        const int pos = i >> 4, k = i & 15;
        const float inv = exp2f(-(float)k * 0.8304820237218407f);
        const float ang = (float)pos * inv;
        const double rev = (double)ang * 0.15915494309189535;
        const float fr = (float)(rev - floor(rev));
        cosT[i] = __builtin_amdgcn_cosf(fr); sinT[i] = __builtin_amdgcn_sinf(fr);
    }
}
__device__ __forceinline__ void final_norm(const Frame& F) {
    const float* g = inp<35>(); float* x = F.out;
    const int gw = F.bid * 8 + F.wave, NGW = F.G * 8, lane = F.lane;
    for (int m = gw; m < T; m += NGW) {
        f32x4* xr = (f32x4*)(x + (size_t)m * DM) + lane;
        f32x4 v[4]; float s = 0.f;
#pragma unroll
        for (int j = 0; j < 4; ++j) { v[j] = xr[64 * j]; s += (v[j][0] * v[j][0] + v[j][1] * v[j][1]) + (v[j][2] * v[j][2] + v[j][3] * v[j][3]); }
        s = wave_sum(s);
        const float rs = rsqrtf(s * (1.0f / 1024.0f) + RMS_EPS);
#pragma unroll
        for (int j = 0; j < 4; ++j) { const f32x4 gg = *((const f32x4*)g + lane + 64 * j); xr[64 * j] = v[j] * rs * gg; }
    }
}

__device__ __forceinline__ void gsu_item(const Frame& F, int item, int e) {
    const int nb = item >> 2, g = item & 3, tok0 = nb * 128, lane = F.lane, wave = F.wave, fr = lane & 15, fq = lane >> 4;
    const bf16_t* z = (const bf16_t*)(F.ws + WS_ACT);
    bf16_t* ymix = (bf16_t*)(F.ws + WS_YMIX);
    const float* ws = inp<10>() + (size_t)(e * 4 + g) * 128 * 128; const float* bs = inp<11>() + (e * 4 + g) * 128;
    const float* lng = inp<12>() + e * 512; const float* lnb = inp<13>() + e * 512;
    LAS bf16_t* vn = (LAS bf16_t*)F.lds;
    for (int fi = 0; fi < 16; ++fi) {
        const int frame = wave * 16 + fi; const size_t tok = tok0 + frame;
        const u32x4 zr = *(const u32x4*)(z + tok * PE + 512 + lane * 8);
        float gv[8]; gv[0] = bflo(zr.x); gv[1] = bfhi(zr.x); gv[2] = bflo(zr.y); gv[3] = bfhi(zr.y); gv[4] = bflo(zr.z); gv[5] = bfhi(zr.z); gv[6] = bflo(zr.w); gv[7] = bfhi(zr.w);
        float s = 0.f;
#pragma unroll
        for (int k = 0; k < 8; ++k) { gv[k] = gelu_tanh(gv[k]); s += gv[k]; }
        const float mean = wave_sum(s) * (1.0f / 512.0f); float qv = 0.f;
#pragma unroll
        for (int k = 0; k < 8; ++k) { gv[k] -= mean; qv += gv[k] * gv[k]; }
        const float rstd = rsqrtf(wave_sum(qv) * (1.0f / 512.0f) + 1e-5f);
        if ((lane >> 4) == g) {
            const int cl = (lane & 15) * 8;
#pragma unroll
            for (int k = 0; k < 8; ++k) { const float o = gv[k] * rstd * lng[lane * 8 + k] + lnb[lane * 8 + k]; vn[(cl + k) * 136 + frame] = (bf16_t)(pk2(o, 0.f) & 0xffffu); }
        }
    }
    __syncthreads();
    const int i = wave * 16 + fr; const int nks = (wave < 4) ? 2 : 4;
    f32x4 acc[8];
#pragma unroll
    for (int ct = 0; ct < 8; ++ct) acc[ct] = (f32x4){0.f, 0.f, 0.f, 0.f};
    for (int ks = 0; ks < nks; ++ks) {
        const float* wp = ws + (size_t)i * 128 + ks * 32 + fq * 8;
        const f32x4 w0 = *(const f32x4*)wp, w1 = *(const f32x4*)(wp + 4);
        u32x4 wy; wy.x = pk2(w0[0], w0[1]); wy.y = pk2(w0[2], w0[3]); wy.z = pk2(w1[0], w1[1]); wy.w = pk2(w1[2], w1[3]);
        const bf16x8 Y = __builtin_bit_cast(bf16x8, wy);
#pragma unroll
        for (int ct = 0; ct < 8; ++ct) {
            const bf16x8 X = *(const LAS bf16x8*)(vn + (ct * 16 + fr) * 136 + ks * 32 + fq * 8);
            acc[ct] = __builtin_amdgcn_mfma_f32_16x16x32_bf16(X, Y, acc[ct], 0, 0, 0);
        }
    }
    const size_t tok = tok0 + i; const float bsv = bs[i];
#pragma unroll
    for (int ct = 0; ct < 8; ++ct) {
        const int c = g * 128 + ct * 16 + fq * 4;
        const f32x4 uz = unpack4(*(const u32x2*)(z + tok * PE + c)); f32x4 o;
#pragma unroll
        for (int k = 0; k < 4; ++k) o[k] = gelu_tanh(uz[k]) * (acc[ct][k] + bsv);
        *(u32x2*)(ymix + tok * DM + c) = pack4(o);
    }
    __syncthreads();
}

__device__ __forceinline__ void prep_item(const Frame& F, int item, int e, const unsigned char* wb) {
    const int tok0 = item * 32, b = tok0 / SEQ, t0 = tok0 % SEQ, lane = F.lane, h = F.wave, fr = lane & 15, fq = lane >> 4, tid = F.tid;
    const bf16_t* z = (const bf16_t*)(F.ws + WS_ACT);
    bf16_t* ymix = (bf16_t*)(F.ws + WS_YMIX); bf16_t* sc = (bf16_t*)(F.ws + WS_SC); float* cb = (float*)(F.ws + WS_CB);
    const float* mu = inp<14>() + e * PB; const float* w0p = inp<15>() + e * 512; const float* a0p = inp<17>() + e * 512;
    const float* kkp = inp<20>() + e * 512; const float* kap = inp<21>() + e * 512; const float* rkp = inp<22>() + e * 512;
    LAS bf16_t* At = (LAS bf16_t*)F.lds;
    {
        const int token = tid >> 4, chunk = tid & 15, t = t0 + token; const size_t tok = tok0 + token;
        const bf16_t* zp = z + tok * PE + 2560 + chunk * 16;
        const u32x4 c0 = *(const u32x4*)zp, c1 = *(const u32x4*)(zp + 8);
        u32x4 p0 = (u32x4){0u, 0u, 0u, 0u}, p1 = p0;
        if (t > 0) { p0 = *(const u32x4*)(zp - PE); p1 = *(const u32x4*)(zp - PE + 8); }
        float cv[16], pv[16];
#pragma unroll
        for (int k = 0; k < 4; ++k) { cv[2 * k] = bflo(c0[k]); cv[2 * k + 1] = bfhi(c0[k]); cv[8 + 2 * k] = bflo(c1[k]); cv[9 + 2 * k] = bfhi(c1[k]);
                                      pv[2 * k] = bflo(p0[k]); pv[2 * k + 1] = bfhi(p0[k]); pv[8 + 2 * k] = bflo(p1[k]); pv[9 + 2 * k] = bfhi(p1[k]); }
        const float* mup = mu + 1536 + chunk * 16;
#pragma unroll
        for (int k = 0; k < 16; ++k) { float mval = cv[k] + mup[k] * (pv[k] - cv[k]); if (chunk < 4) mval = tanh_(mval); else if (chunk >= 8) mval = sigmoidf_(mval); cv[k] = mval; }
        u32x4 o0, o1;
#pragma unroll
        for (int k = 0; k < 4; ++k) { o0[k] = pk2(cv[2 * k], cv[2 * k + 1]); o1[k] = pk2(cv[8 + 2 * k], cv[9 + 2 * k]); }
        *(LAS u32x4*)(At + token * 264 + chunk * 16) = o0; *(LAS u32x4*)(At + token * 264 + chunk * 16 + 8) = o1;
    }
    __syncthreads();
    const bf16_t* DUt = (const bf16_t*)(wb + WB_WX); const bf16_t* IUt = DUt + 512 * 64; const bf16_t* GUt = DUt + 2 * 512 * 64;
#pragma unroll 1
    for (int mt = 0; mt < 2; ++mt) {
        const LAS bf16_t* Ar = At + (mt * 16 + fr) * 264 + fq * 8;
        const int t = t0 + mt * 16 + fr; const size_t tok = tok0 + mt * 16 + fr; const bool hp = t > 0;
        f32x4 ev[4], av[4];
        {
            f32x4 acc[4];
#pragma unroll
            for (int nt = 0; nt < 4; ++nt) acc[nt] = (f32x4){0.f, 0.f, 0.f, 0.f};
#pragma unroll
            for (int ks = 0; ks < 2; ++ks) {
                const bf16x8 Yv = *(const LAS bf16x8*)(Ar + 0 + ks * 32);
#pragma unroll
                for (int nt = 0; nt < 4; ++nt) {
                    const bf16x8 X = *(const bf16x8*)(DUt + (size_t)(h * 64 + nt * 16 + fr) * 64 + ks * 32 + fq * 8);
                    acc[nt] = __builtin_amdgcn_mfma_f32_16x16x32_bf16(X, Yv, acc[nt], 0, 0, 0);
                }
            }
#pragma unroll
            for (int nt = 0; nt < 4; ++nt) {
                const f32x4 w0 = *(const f32x4*)(w0p + h * 64 + nt * 16 + fq * 4);
#pragma unroll
                for (int k = 0; k < 4; ++k) ev[nt][k] = 0.6065306597126334f / (1.0f + __expf(-(w0[k] + acc[nt][k])));
            }
        }
        {
            f32x4 acc[4];
#pragma unroll
            for (int nt = 0; nt < 4; ++nt) acc[nt] = (f32x4){0.f, 0.f, 0.f, 0.f};
#pragma unroll
            for (int ks = 0; ks < 2; ++ks) {
                const bf16x8 Yv = *(const LAS bf16x8*)(Ar + 64 + ks * 32);
#pragma unroll
                for (int nt = 0; nt < 4; ++nt) {
                    const bf16x8 X = *(const bf16x8*)(IUt + (size_t)(h * 64 + nt * 16 + fr) * 64 + ks * 32 + fq * 8);
                    acc[nt] = __builtin_amdgcn_mfma_f32_16x16x32_bf16(X, Yv, acc[nt], 0, 0, 0);
                }
            }
#pragma unroll
            for (int nt = 0; nt < 4; ++nt) {
                const f32x4 a0 = *(const f32x4*)(a0p + h * 64 + nt * 16 + fq * 4);
#pragma unroll
                for (int k = 0; k < 4; ++k) av[nt][k] = sigmoidf_(a0[k] + acc[nt][k]);
            }
        }
        {
            f32x4 acc[4];
#pragma unroll
            for (int nt = 0; nt < 4; ++nt) acc[nt] = (f32x4){0.f, 0.f, 0.f, 0.f};
#pragma unroll
            for (int ks = 0; ks < 4; ++ks) {
                const bf16x8 Yv = *(const LAS bf16x8*)(Ar + 128 + ks * 32);
#pragma unroll
                for (int nt = 0; nt < 4; ++nt) {
                    const bf16x8 X = *(const bf16x8*)(GUt + (size_t)(h * 64 + nt * 16 + fr) * 128 + ks * 32 + fq * 8);
                    acc[nt] = __builtin_amdgcn_mfma_f32_16x16x32_bf16(X, Yv, acc[nt], 0, 0, 0);
                }
            }
#pragma unroll
            for (int nt = 0; nt < 4; ++nt) *(u32x2*)(ymix + tok * DM + 512 + h * 64 + nt * 16 + fq * 4) = pack4(acc[nt]);
        }
        asm volatile("" ::: "memory");
        f32x4 rv[4], kv[4], kk[4]; float ssq = 0.f;
        bf16_t* sp = sc + ((size_t)(b * 8 + h) * SEQ + t) * 384;
#pragma unroll
        for (int nt = 0; nt < 4; ++nt) {
            const int cl = nt * 16 + fq * 4, c = h * 64 + cl;
            const bf16_t* zp = z + tok * PE + 1024 + c;
            const f32x4 cr = unpack4(*(const u32x2*)zp), ck = unpack4(*(const u32x2*)(zp + 512)), cvv = unpack4(*(const u32x2*)(zp + 1024));
            f32x4 pr = (f32x4){0.f, 0.f, 0.f, 0.f}, pk = pr, pvv = pr;
            if (hp) { pr = unpack4(*(const u32x2*)(zp - PE)); pk = unpack4(*(const u32x2*)(zp - PE + 512)); pvv = unpack4(*(const u32x2*)(zp - PE + 1024)); }
            const f32x4 mr = *(const f32x4*)(mu + c), mk = *(const f32x4*)(mu + 512 + c), mv = *(const f32x4*)(mu + 1024 + c);
            rv[nt] = cr + mr * (pr - cr); kv[nt] = ck + mk * (pk - ck);
            const f32x4 vv = cvv + mv * (pvv - cvv);
            *(u32x2*)(sp + 5 * 64 + cl) = pack4(vv);
            *(u32x2*)(sp + 4 * 64 + cl) = pack4(rv[nt]);
            *(u32x2*)(sp + 0 * 64 + cl) = pack4(ev[nt]);
            kk[nt] = kv[nt] * *(const f32x4*)(kkp + c);
            ssq += (kk[nt][0] * kk[nt][0] + kk[nt][1] * kk[nt][1]) + (kk[nt][2] * kk[nt][2] + kk[nt][3] * kk[nt][3]);
        }
        ssq += __shfl_xor(ssq, 16); ssq += __shfl_xor(ssq, 32);
        const float inv = 1.0f / fmaxf(sqrtf(ssq), 1e-12f);
        float cbp = 0.f;
#pragma unroll
        for (int nt = 0; nt < 4; ++nt) {
            const int cl = nt * 16 + fq * 4, c = h * 64 + cl;
            const f32x4 a = av[nt], kkn = kk[nt] * inv;
            const f32x4 ka = *(const f32x4*)(kap + c), rk = *(const f32x4*)(rkp + c);
            const f32x4 kp = kv[nt] * (1.0f + (a - 1.0f) * ka);
            const f32x4 pr = rv[nt] * kp * rk; cbp += (pr[0] + pr[1]) + (pr[2] + pr[3]);
            *(u32x2*)(sp + 1 * 64 + cl) = pack4(kp);
            *(u32x2*)(sp + 2 * 64 + cl) = pack4(-kkn);
            *(u32x2*)(sp + 3 * 64 + cl) = pack4(kkn * a);
        }
        cbp += __shfl_xor(cbp, 16); cbp += __shfl_xor(cbp, 32);
        if (fq == 0) cb[tok * 8 + h] = cbp;
    }
    __syncthreads();
}

template <int CTRL> __device__ __forceinline__ float dpp_f(float x) { return __int_as_float(__builtin_amdgcn_update_dpp(0, __float_as_int(x), CTRL, 0xF, 0xF, true)); }
__device__ __forceinline__ float red16(float x) {
    x += dpp_f<0x140>(x);
    x += dpp_f<0x141>(x);
    x += dpp_f<0xB1>(x);
    x += dpp_f<0x4E>(x);
    return x;
}
__device__ __forceinline__ void scan_item(const Frame& F, int item) {
    const int bh = item >> 2, rq = item & 3, b = bh >> 3, h = bh & 7, lane = F.lane, wave = F.wave;
    const bf16_t* sc = (const bf16_t*)(F.ws + WS_SC) + (size_t)bh * SEQ * 384;
    float* Y = (float*)(F.ws + WS_Y);
    LAS float* buf = (LAS float*)F.lds;
    constexpr int CH = 32, CHF = CH * 384;
    const int ltid = F.tid - 256;
    auto load_chunk = [&](int c, int bi) {
        const bf16_t* src = sc + (size_t)c * CH * 384;
        LAS float* dst = buf + bi * CHF;
#pragma unroll
        for (int p = 0; p < 6; ++p) {
            const int piece = ltid + p * 256;
            const u32x4 raw = *(const u32x4*)(src + piece * 8);
            float v[8]; v[0] = bflo(raw.x); v[1] = bfhi(raw.x); v[2] = bflo(raw.y); v[3] = bfhi(raw.y); v[4] = bflo(raw.z); v[5] = bfhi(raw.z); v[6] = bflo(raw.w); v[7] = bfhi(raw.w);
            const int vec = (piece % 48) >> 3;
            if (vec == 0) {
#pragma unroll
                for (int k = 0; k < 8; ++k) v[k] = __expf(-v[k]);
            }
            *(LAS f32x4*)(dst + piece * 8) = (f32x4){v[0], v[1], v[2], v[3]};
            *(LAS f32x4*)(dst + piece * 8 + 4) = (f32x4){v[4], v[5], v[6], v[7]};
        }
    };
    if (wave >= 4) load_chunk(0, 0);
    __syncthreads();
    const int rl = wave * 4 + (lane >> 4), row = rq * 16 + rl, c4 = (lane & 15) * 4;
    f32x4 s = (f32x4){0.f, 0.f, 0.f, 0.f};
    for (int c = 0; c < SEQ / CH; ++c) {
        if (wave >= 4) { if (c + 1 < SEQ / CH) load_chunk(c + 1, (c + 1) & 1); }
        else {
            const LAS float* bp = buf + (c & 1) * CHF;
            float* yp = Y + ((size_t)b * SEQ + c * CH) * 512 + h * 64 + row;
#pragma unroll 4
            for (int st = 0; st < CH; ++st) {
                const LAS float* p = bp + st * 384;
                const f32x4 w4 = *(const LAS f32x4*)(p + c4), k4 = *(const LAS f32x4*)(p + 64 + c4), a4 = *(const LAS f32x4*)(p + 128 + c4),
                            b4 = *(const LAS f32x4*)(p + 192 + c4), r4 = *(const LAS f32x4*)(p + 256 + c4);
                const float v = p[320 + row];
                float sa = (s[0] * a4[0] + s[1] * a4[1]) + (s[2] * a4[2] + s[3] * a4[3]);
                sa = red16(sa);
                s = s * w4 + (b4 * sa + k4 * v);
                float y = (s[0] * r4[0] + s[1] * r4[1]) + (s[2] * r4[2] + s[3] * r4[3]);
                y = red16(y);
                if ((lane & 15) == 0) yp[(size_t)st * 512] = y;
            }
        }
        __syncthreads();
    }
}
__device__ __forceinline__ void post_rows(const Frame& F, int e) {
    const float* Y = (const float*)(F.ws + WS_Y); const bf16_t* sc = (const bf16_t*)(F.ws + WS_SC); const float* cb = (const float*)(F.ws + WS_CB);
    bf16_t* ymix = (bf16_t*)(F.ws + WS_YMIX);
    const float* lg = inp<23>() + e * 512; const float* lb = inp<24>() + e * 512;
    const int gw = F.bid * 8 + F.wave, NGW = F.G * 8, lane = F.lane, hh = lane >> 3;
    for (int tok = gw; tok < T; tok += NGW) {
        const int b = tok / SEQ, t = tok % SEQ;
        const f32x4 y0 = *(const f32x4*)(Y + (size_t)tok * 512 + lane * 8), y1 = *(const f32x4*)(Y + (size_t)tok * 512 + lane * 8 + 4);
        float yv[8] = {y0[0], y0[1], y0[2], y0[3], y1[0], y1[1], y1[2], y1[3]};
        float s = 0.f;
#pragma unroll
        for (int k = 0; k < 8; ++k) s += yv[k];
        s += __shfl_xor(s, 1); s += __shfl_xor(s, 2); s += __shfl_xor(s, 4);
        const float mean = s * (1.0f / 64.0f); float qv = 0.f;
#pragma unroll
        for (int k = 0; k < 8; ++k) { yv[k] -= mean; qv += yv[k] * yv[k]; }
        qv += __shfl_xor(qv, 1); qv += __shfl_xor(qv, 2); qv += __shfl_xor(qv, 4);
        const float rstd = rsqrtf(qv * (1.0f / 64.0f) + 64e-5f);
        const u32x4 vr = *(const u32x4*)(sc + ((size_t)(b * 8 + hh) * SEQ + t) * 384 + 5 * 64 + (lane & 7) * 8);
        bf16_t* gp = ymix + (size_t)tok * DM + 512 + lane * 8;
        const u32x4 gr = *(const u32x4*)gp;
        const float cbv = cb[(size_t)tok * 8 + hh];
        float vv[8] = {bflo(vr.x), bfhi(vr.x), bflo(vr.y), bfhi(vr.y), bflo(vr.z), bfhi(vr.z), bflo(vr.w), bfhi(vr.w)};
        float gg[8] = {bflo(gr.x), bfhi(gr.x), bflo(gr.y), bfhi(gr.y), bflo(gr.z), bfhi(gr.z), bflo(gr.w), bfhi(gr.w)};
        float o[8];
#pragma unroll
        for (int k = 0; k < 8; ++k) o[k] = (yv[k] * rstd * lg[lane * 8 + k] + lb[lane * 8 + k] + cbv * vv[k]) * gg[k];
        u32x4 ow; ow.x = pk2(o[0], o[1]); ow.y = pk2(o[2], o[3]); ow.z = pk2(o[4], o[5]); ow.w = pk2(o[6], o[7]);
        *(u32x4*)gp = ow;
    }
}

__device__ __forceinline__ void conv_item(const Frame& F, int item, int o) {
    const int b = item >> 6, tt = item & 63, t0 = tt * 32, c = F.tid, lane = F.lane, wave = F.wave;
    const bf16_t* z = (const bf16_t*)(F.ws + WS_ACT);
    bf16_t* ymix = (bf16_t*)(F.ws + WS_YMIX);
    const float* cw = inp<31>() + (size_t)o * 31 * 512; const float* cbias = inp<32>() + o * 512;
    const float* lg = inp<33>() + o * 512; const float* lb = inp<34>() + o * 512;
    LAS float* co = (LAS float*)F.lds;
    const size_t tokb = (size_t)b * SEQ;
    float hv[62];
#pragma unroll
    for (int i = 0; i < 62; ++i) {
        const int t = t0 - 30 + i; float hval = 0.f;
        if (t >= 0) { const bf16_t* zp = z + (tokb + t) * POP + 416 + c; const float za = bf1(zp[0]), zg = bf1(zp[512]); hval = za * sigmoidf_(zg); }
        hv[i] = hval;
    }
    float wv[31];
#pragma unroll
    for (int k = 0; k < 31; ++k) wv[k] = cw[k * 512 + c];
    const float bias = cbias[c];
#pragma unroll
    for (int i = 0; i < 32; ++i) {
        float a = bias;
#pragma unroll
        for (int k = 0; k < 31; ++k) a += wv[k] * hv[i + k];
        co[i * 512 + c] = a;
    }
    {
        const int token = F.tid >> 4, i = F.tid & 15, t = t0 + token;
        const bf16_t* zp = z + (tokb + t) * POP + 384;
        const float x1 = bf1(zp[i]), x2 = bf1(zp[16 + i]);
        const float cs = ((const float*)(F.ws + WS_COS))[t * 16 + i], sn = ((const float*)(F.ws + WS_SIN))[t * 16 + i];
        bf16_t* kr = (bf16_t*)(F.ws + WS_SC + SC_KR) + (tokb + t) * 32;
        kr[i] = (bf16_t)(pk2(x1 * cs - x2 * sn, 0.f) & 0xffffu); kr[16 + i] = (bf16_t)(pk2(x1 * sn + x2 * cs, 0.f) & 0xffffu);
    }
    __syncthreads();
#pragma unroll
    for (int j = 0; j < 4; ++j) {
        const int ti = wave * 4 + j;
        const f32x4 v0 = *(const LAS f32x4*)(co + ti * 512 + lane * 8), v1 = *(const LAS f32x4*)(co + ti * 512 + lane * 8 + 4);
        float v[8] = {v0[0], v0[1], v0[2], v0[3], v1[0], v1[1], v1[2], v1[3]};
        float s = 0.f;
#pragma unroll
        for (int k = 0; k < 8; ++k) s += v[k];
        const float mean = wave_sum(s) * (1.0f / 512.0f); float qv = 0.f;
#pragma unroll
        for (int k = 0; k < 8; ++k) { v[k] -= mean; qv += v[k] * v[k]; }
        const float rstd = rsqrtf(wave_sum(qv) * (1.0f / 512.0f) + 1e-5f);
        float ov[8];
#pragma unroll
        for (int k = 0; k < 8; ++k) { const float y = v[k] * rstd * lg[lane * 8 + k] + lb[lane * 8 + k]; ov[k] = y * sigmoidf_(y); }
        u32x4 ow; ow.x = pk2(ov[0], ov[1]); ow.y = pk2(ov[2], ov[3]); ow.z = pk2(ov[4], ov[5]); ow.w = pk2(ov[6], ov[7]);
        *(u32x4*)(ymix + (tokb + t0 + ti) * DM + 512 + lane * 8) = ow;
    }
    __syncthreads();
}

constexpr int AT_KS = 104, AT_VS = 72, AT_KB = 64 * AT_KS * 2, AT_VB = 64 * AT_VS * 2, AT_BUF = AT_KB + AT_VB;
__device__ __forceinline__ void attn_unit(const Frame& F, int b, int h, int qb) {
    const int lane = F.lane, wave = F.wave, tid = F.tid, fr = lane & 15, fq = lane >> 4;
    const bf16_t* Q = (const bf16_t*)(F.ws + WS_SC + SC_Q); const bf16_t* KV = (const bf16_t*)(F.ws + WS_SC + SC_KV); const bf16_t* KR = (const bf16_t*)(F.ws + WS_SC + SC_KR);
    bf16_t* ymix = (bf16_t*)(F.ws + WS_YMIX);
    const size_t tokb = (size_t)b * SEQ;
    const int q0 = qb * 128 + wave * 16;
    const int ntb = 2 * qb + 2, ntw = 2 * qb + 1 + (wave >> 2);
    bf16x8 qf[3];
#pragma unroll
    for (int ks = 0; ks < 3; ++ks) qf[ks] = *(const bf16x8*)(Q + (tokb + q0 + fr) * 768 + h * 96 + ks * 32 + fq * 8);
    const int kidx0 = tid, kidx1 = tid + 512;
    const int vkey = tid >> 3, vch = tid & 7;
    u32x4 rk0, rk1 = (u32x4){0u, 0u, 0u, 0u}, rv;
    auto gload = [&](int j) {
        const size_t kt = tokb + (size_t)j * 64;
        { const int key = kidx0 / 12, ch = kidx0 % 12; rk0 = (ch < 8) ? *(const u32x4*)(KV + (kt + key) * 1024 + h * 128 + ch * 8) : *(const u32x4*)(KR + (kt + key) * 32 + (ch - 8) * 8); }
        if (kidx1 < 768) { const int key = kidx1 / 12, ch = kidx1 % 12; rk1 = (ch < 8) ? *(const u32x4*)(KV + (kt + key) * 1024 + h * 128 + ch * 8) : *(const u32x4*)(KR + (kt + key) * 32 + (ch - 8) * 8); }
        rv = *(const u32x4*)(KV + (kt + vkey) * 1024 + h * 128 + 64 + vch * 8);
    };
    auto lstore = [&](int bi) {
        LAS unsigned char* kb = F.lds + bi * AT_BUF; LAS bf16_t* vb = (LAS bf16_t*)(kb + AT_KB);
        { const int key = kidx0 / 12, ch = kidx0 % 12; *(LAS u32x4*)(kb + key * (AT_KS * 2) + ch * 16) = rk0; }
        if (kidx1 < 768) { const int key = kidx1 / 12, ch = kidx1 % 12; *(LAS u32x4*)(kb + key * (AT_KS * 2) + ch * 16) = rk1; }
#pragma unroll
        for (int k = 0; k < 4; ++k) { vb[(vch * 8 + 2 * k) * AT_VS + vkey] = (bf16_t)(rv[k] & 0xffffu); vb[(vch * 8 + 2 * k + 1) * AT_VS + vkey] = (bf16_t)(rv[k] >> 16); }
    };
    f32x4 o[4];
#pragma unroll
    for (int dt = 0; dt < 4; ++dt) o[dt] = (f32x4){0.f, 0.f, 0.f, 0.f};
    float mrun = -INFINITY, lsum = 0.f;
    gload(0);
    for (int j = 0; j < ntb; ++j) {
        lstore(j & 1);
        __syncthreads();
        if (j + 1 < ntb) gload(j + 1);
        if (j < ntw) {
            const LAS unsigned char* kb = F.lds + (j & 1) * AT_BUF; const LAS bf16_t* vb = (const LAS bf16_t*)(kb + AT_KB);
            f32x4 st[4];
#pragma unroll
            for (int kt = 0; kt < 4; ++kt) {
                st[kt] = (f32x4){0.f, 0.f, 0.f, 0.f};
#pragma unroll
                for (int ks = 0; ks < 3; ++ks) {
                    const bf16x8 X = *(const LAS bf16x8*)(kb + (kt * 16 + fr) * (AT_KS * 2) + (ks * 32 + fq * 8) * 2);
                    st[kt] = __builtin_amdgcn_mfma_f32_16x16x32_bf16(X, qf[ks], st[kt], 0, 0, 0);
                }
            }
            float mx = fmaxf(fmaxf(st[0][0], st[0][1]), fmaxf(st[0][2], st[0][3]));
#pragma unroll
            for (int kt = 1; kt < 4; ++kt) mx = fmaxf(mx, fmaxf(fmaxf(st[kt][0], st[kt][1]), fmaxf(st[kt][2], st[kt][3])));
            mx = fmaxf(mx, __shfl_xor(mx, 16)); mx = fmaxf(mx, __shfl_xor(mx, 32));
            const float mnew = fmaxf(mrun, mx), alpha = __builtin_amdgcn_exp2f(mrun - mnew);
            mrun = mnew;
            float ps = 0.f;
#pragma unroll
            for (int kt = 0; kt < 4; ++kt)
#pragma unroll
                for (int k = 0; k < 4; ++k) { st[kt][k] = __builtin_amdgcn_exp2f(st[kt][k] - mnew); ps += st[kt][k]; }
            lsum = lsum * alpha + ps;
#pragma unroll
            for (int dt = 0; dt < 4; ++dt) o[dt] = o[dt] * alpha;
#pragma unroll
            for (int g2 = 0; g2 < 2; ++g2) {
                u32x4 pw; pw.x = pk2(st[2 * g2][0], st[2 * g2][1]); pw.y = pk2(st[2 * g2][2], st[2 * g2][3]); pw.z = pk2(st[2 * g2 + 1][0], st[2 * g2 + 1][1]); pw.w = pk2(st[2 * g2 + 1][2], st[2 * g2 + 1][3]);
                const bf16x8 Yp = __builtin_bit_cast(bf16x8, pw);
#pragma unroll
                for (int dt = 0; dt < 4; ++dt) {
                    const LAS bf16_t* vp = vb + (dt * 16 + fr) * AT_VS + g2 * 32 + fq * 4;
                    const u32x2 lo = *(const LAS u32x2*)vp, hi = *(const LAS u32x2*)(vp + 16);
                    u32x4 xw; xw.x = lo.x; xw.y = lo.y; xw.z = hi.x; xw.w = hi.y;
                    o[dt] = __builtin_amdgcn_mfma_f32_16x16x32_bf16(__builtin_bit_cast(bf16x8, xw), Yp, o[dt], 0, 0, 0);
                }
            }
        }
    }
    lsum += __shfl_xor(lsum, 16); lsum += __shfl_xor(lsum, 32);
    const float il = 1.0f / lsum;
#pragma unroll
    for (int dt = 0; dt < 4; ++dt) *(u32x2*)(ymix + (tokb + q0 + fr) * DM + h * 64 + dt * 16 + fq * 4) = pack4(o[dt] * il);
    __syncthreads();
}

constexpr int NPHASE = 1 + 9 * DEPTH + 1;
__global__ void __launch_bounds__(512, 2) mk_fwd(Args args) {
    extern __shared__ __attribute__((aligned(16))) unsigned char lds_raw[];
    Frame F;
    F.lds = (LAS unsigned char*)lds_raw;
    F.tid = threadIdx.x; F.lane = F.tid & 63; F.wave = __builtin_amdgcn_readfirstlane(F.tid >> 6);
    F.G = gridDim.x; F.bid = blockIdx.x; F.out = args.out; F.ws = args.ws;
    const int lo = args.ph_lo, hi = args.ph_hi;
    cg::grid_group grid = cg::this_grid();
#define IN(k) (lo <= (k) && (k) < hi)
#define ENTER() do { int t_ = threadIdx.x; int b_ = blockIdx.x; asm volatile("" : "+v"(t_), "+s"(b_)); F.tid = t_; F.lane = t_ & 63; F.wave = __builtin_amdgcn_readfirstlane(t_ >> 6); F.bid = b_; } while (0)
#define SEAM(k) do { if (IN(k) && IN((k) + 1)) grid.sync(); } while (0)

    if (IN(0)) { ENTER(); if (PH(0)) { convert_layer(F, 0); x_prologue(F); } }
    SEAM(0);
    for (int l = 0; l < DEPTH; ++l) {
        const int p0 = 1 + 9 * l; const bool odd = l & 1; const int hl = l >> 1;
        unsigned char* ws = args.ws; asm volatile("" : "+s"(ws));
        F.ws = ws;
        float* ssq = (float*)(ws + WS_SSQ);
        bf16_t* xb = (bf16_t*)(ws + WS_XB); bf16_t* ymix = (bf16_t*)(ws + WS_YMIX); bf16_t* act = (bf16_t*)(ws + WS_ACT);
        const unsigned char* wb = ws + WS_WBUF0 + (size_t)(l & 1) * WBUF_BYTES;
        const float* xbase = (l == 0) ? inp<0>() : (const float*)args.out;
        if (IN(p0 + 0)) {
            ENTER();
            pg8::Gemm g{xb, (const bf16_t*)(wb + WB_W1IN), T, 2 * FF, DM, DM, DM}; pg8::StaticOrder S; S.init(T, 2 * FF, F.G, F.bid);
            EpiSwiGLU E{act, ssq}; if (PH(1)) pg8::gemm_phase(F.lds, g, S, E);
        }
        SEAM(p0 + 0);
        if (IN(p0 + 1)) {
            ENTER();
            pg8::Gemm g{act, (const bf16_t*)(wb + WB_W1OUT), T, DM, FF, FF, FF}; pg8::StaticOrder S; S.init(T, DM, F.G, F.bid);
            EpiResid E{xbase, args.out, xb, ssq, 0.5f}; if (PH(2)) pg8::gemm_phase(F.lds, g, S, E);
        }
        SEAM(p0 + 1);
        if (IN(p0 + 2)) {
            ENTER();
            if (odd) { pg8::Gemm g{xb, (const bf16_t*)(wb + WB_WMIN), T, POP, DM, DM, DM}; pg8::StaticOrder S; S.init(T, POP, F.G, F.bid);
                EpiZ<true> E{act, POP, ssq, (float*)(ws + WS_PQ), (float*)(ws + WS_PKV)}; if (PH(3)) pg8::gemm_phase(F.lds, g, S, E); }
            else { pg8::Gemm g{xb, (const bf16_t*)(wb + WB_WMIN), T, PE, DM, DM, DM}; pg8::StaticOrder S; S.init(T, PE, F.G, F.bid);
                EpiZ<false> E{act, PE, ssq, nullptr, nullptr}; if (PH(3)) pg8::gemm_phase(F.lds, g, S, E); }
        }
        SEAM(p0 + 2);
        if (IN(p0 + 3)) {
            ENTER();
            if (odd) {
                pg8::Gemm g{act, (const bf16_t*)(wb + WB_WX), T, 1792, 384, POP, 384}; pg8::StaticOrder S; S.init(T, 1792, F.G, F.bid);
                EpiUp E{(bf16_t*)(ws + WS_SC + SC_Q), (bf16_t*)(ws + WS_SC + SC_KV), (const float*)(ws + WS_PQ), (const float*)(ws + WS_PKV), (const float*)(ws + WS_COS), (const float*)(ws + WS_SIN)};
                if (PH(4)) pg8::gemm_phase(F.lds, g, S, E);
                __syncthreads();
                if (PH(11)) for (int it = F.bid; it < 512; it += F.G) conv_item(F, it, hl);
            } else {
                if (PH(5)) for (int it = F.bid; it < 512; it += F.G) prep_item(F, it, hl, wb);
                if (PH(6)) for (int it = F.bid; it < 512; it += F.G) gsu_item(F, it, hl);
            }
            if (PH(0) && l + 1 < DEPTH) { __syncthreads(); convert_layer(F, l + 1); }
        }
        SEAM(p0 + 3);
        if (IN(p0 + 4)) {
            ENTER();
            if (odd) {
                if (PH(7)) for (int it = F.bid; it < 512; it += F.G) {
                    const int bh = it & 63, pr = it >> 6;
                    attn_unit(F, bh >> 3, bh & 7, pr);
                    attn_unit(F, bh >> 3, bh & 7, 15 - pr);
                }
            } else {
                if (PH(8)) for (int it = F.bid; it < 256; it += F.G) scan_item(F, it);
            }
        }
        SEAM(p0 + 4);
        if (IN(p0 + 5)) { ENTER(); if (PH(9) && !odd) post_rows(F, hl); }
        if (!odd) SEAM(p0 + 5);
        if (IN(p0 + 6)) {
            ENTER();
            pg8::Gemm g{ymix, (const bf16_t*)(wb + WB_WMOUT), T, DM, DM, DM, DM}; pg8::StaticOrder S; S.init(T, DM, F.G, F.bid);
            EpiResid E{args.out, args.out, xb, ssq, 1.0f}; if (PH(2)) pg8::gemm_phase(F.lds, g, S, E);
        }
        SEAM(p0 + 6);
        if (IN(p0 + 7)) {
            ENTER();
            pg8::Gemm g{xb, (const bf16_t*)(wb + WB_W2IN), T, 2 * FF, DM, DM, DM}; pg8::StaticOrder S; S.init(T, 2 * FF, F.G, F.bid);
            EpiSwiGLU E{act, ssq}; if (PH(1)) pg8::gemm_phase(F.lds, g, S, E);
        }
        SEAM(p0 + 7);
        if (IN(p0 + 8)) {
            ENTER();
            pg8::Gemm g{act, (const bf16_t*)(wb + WB_W2OUT), T, DM, FF, FF, FF}; pg8::StaticOrder S; S.init(T, DM, F.G, F.bid);
            EpiResid E{args.out, args.out, xb, ssq, 0.5f}; if (PH(2)) pg8::gemm_phase(F.lds, g, S, E);
        }
        SEAM(p0 + 8);
    }
    if (IN(NPHASE - 1)) { ENTER(); if (PH(10)) final_norm(F); }
#undef IN
#undef SEAM
#undef ENTER
}

extern "C" void kernel_launch(void* const* d_in, const int* in_sizes, int n_in, void* d_out, int out_size, void* d_ws, size_t ws_size, hipStream_t stream) {
    static int grid = 0;
    if (grid == 0) {
        if (n_in != 36 || out_size != T * DM || ws_size < WS_END) { fprintf(stderr, "kernel_launch: unexpected shapes (n_in %d out %d ws %zu)\n", n_in, out_size, ws_size); grid = -1; return; }
        int dev = 0, cus = 0, per_cu = 0;
        (void)hipGetDevice(&dev); (void)hipDeviceGetAttribute(&cus, hipDeviceAttributeMultiprocessorCount, dev);
        (void)hipFuncSetAttribute((const void*)mk_fwd, hipFuncAttributeMaxDynamicSharedMemorySize, LDS_BYTES);
        (void)hipOccupancyMaxActiveBlocksPerMultiprocessor(&per_cu, (const void*)mk_fwd, 512, LDS_BYTES);
        if (per_cu < 1) per_cu = 1;
        grid = cus * per_cu; if (grid > 256) grid = 256; if (grid < 1) grid = 256;
        (void)hipGetLastError();
    }
    if (grid < 0) return;
    Args a{};
    for (int i = 0; i < 36; ++i) a.in[i] = (const float*)d_in[i];
    a.out = (float*)d_out; a.ws = (unsigned char*)d_ws;
#if MK_MULTI
    for (int p = 0; p < NPHASE; ++p) {
        if (p >= 1 && p < NPHASE - 1) { const int l = (p - 1) / 9, k = (p - 1) % 9; if ((l & 1) && k == 5) continue; }
        a.ph_lo = p; a.ph_hi = p + 1;
        hipLaunchKernelGGL(mk_fwd, dim3(grid), dim3(512), LDS_BYTES, stream, a);
    }
#else
    a.ph_lo = 0; a.ph_hi = NPHASE;
    void* kargs[] = {&a};
    hipError_t e = hipLaunchCooperativeKernel((const void*)mk_fwd, dim3(grid), dim3(512), kargs, LDS_BYTES, stream);
    if (e != hipSuccess) fprintf(stderr, "cooperative launch failed: %s (grid %d)\n", hipGetErrorString(e), grid);
#endif
}
```

```cpp
#include <hip/hip_runtime.h>
#include <hip/hip_cooperative_groups.h>
#include <cstdio>
#include <cstdint>
namespace cg = cooperative_groups;

#ifndef MK_MULTI
#define MK_MULTI 0
#endif

#define LAS __attribute__((address_space(3)))
typedef unsigned short bf16_t;
typedef short bf16x8 __attribute__((ext_vector_type(8)));
typedef float f32x4 __attribute__((ext_vector_type(4)));
typedef float f32x2 __attribute__((ext_vector_type(2)));
typedef unsigned u32x4 __attribute__((ext_vector_type(4)));
typedef unsigned u32x2 __attribute__((ext_vector_type(2)));
typedef __bf16 bf16x2_t __attribute__((ext_vector_type(2)));

constexpr int T = 16384, DM = 1024, FF = 2816, SEQ = 2048, NBATCH = 8, DEPTH = 4;
constexpr int PE = 2816, PO = 1440, POP = 1536;
constexpr int PB = 1792;
constexpr float RMS_EPS = 1e-6f;
constexpr float QSCALE = 0.10206207261596575f * 1.4426950408889634f;

constexpr size_t MiB = 1u << 20;
constexpr size_t WS_SSQ = 1 * MiB;
constexpr size_t WS_PQ = 2 * MiB;
constexpr size_t WS_PKV = 2 * MiB + 256 * 1024;
constexpr size_t WS_COS = 2 * MiB + 512 * 1024;
constexpr size_t WS_SIN = 2 * MiB + 640 * 1024;
constexpr size_t WS_CB = 3 * MiB;
constexpr size_t WS_WBUF0 = 4 * MiB, WBUF_BYTES = 42 * MiB;
constexpr size_t WS_XB = 88 * MiB;
constexpr size_t WS_YMIX = 120 * MiB;
constexpr size_t WS_ACT = 152 * MiB;
constexpr size_t WS_SC = 240 * MiB;
constexpr size_t WS_Y = 336 * MiB;
constexpr size_t WS_END = 368 * MiB;
constexpr size_t WB_W1IN = 0, WB_W1OUT = 11534336, WB_W2IN = 17301504, WB_W2OUT = 28835840, WB_WMIN = 34603008, WB_WMOUT = 40370176, WB_WX = 42467328;
constexpr size_t SC_Q = 0, SC_KV = 24 * MiB, SC_KR = 56 * MiB;

constexpr int LDS_BYTES = 147456;

__device__ __forceinline__ unsigned pk2(float lo, float hi) { f32x2 v = {lo, hi}; bf16x2_t b = __builtin_convertvector(v, bf16x2_t); return __builtin_bit_cast(unsigned, b); }
__device__ __forceinline__ float bflo(unsigned u) { return __uint_as_float(u << 16); }
__device__ __forceinline__ float bfhi(unsigned u) { return __uint_as_float(u & 0xffff0000u); }
__device__ __forceinline__ float bf1(bf16_t h) { return __uint_as_float((unsigned)h << 16); }
__device__ __forceinline__ f32x4 unpack4(u32x2 u) { return (f32x4){bflo(u.x), bfhi(u.x), bflo(u.y), bfhi(u.y)}; }
__device__ __forceinline__ u32x2 pack4(f32x4 v) { u32x2 r; r.x = pk2(v[0], v[1]); r.y = pk2(v[2], v[3]); return r; }
template <int CTRL> __device__ __forceinline__ float dpp_f(float x) { return __int_as_float(__builtin_amdgcn_update_dpp(0, __float_as_int(x), CTRL, 0xF, 0xF, true)); }
__device__ __forceinline__ float red16(float x) {
    x += dpp_f<0x140>(x);
    x += dpp_f<0x141>(x);
    x += dpp_f<0xB1>(x);
    x += dpp_f<0x4E>(x);
    return x;
}
__device__ __forceinline__ void st16_wt(void* p, u32x4 v) { asm volatile("global_store_dwordx4 %0, %1, off\n\ts_nop 1" :: "v"(p), "v"(v) : "memory"); }
__device__ __forceinline__ void st8_wt(void* p, u32x2 v) { asm volatile("global_store_dwordx2 %0, %1, off" :: "v"(p), "v"(v) : "memory"); }
__device__ __forceinline__ float wave_sum(float v) {
    v = red16(v);
    v += __shfl_xor(v, 16); v += __shfl_xor(v, 32);
    return v;
}
__device__ __forceinline__ float sigmoidf_(float x) { return __builtin_amdgcn_rcpf(1.0f + __expf(-x)); }
__device__ __forceinline__ float gelu_tanh(float x) { const float u = 1.5957691216057308f * (x + 0.044715f * x * x * x); return x * __builtin_amdgcn_rcpf(1.0f + __expf(-u)); }
__device__ __forceinline__ float tanh_(float x) { return 1.0f - 2.0f * __builtin_amdgcn_rcpf(1.0f + __expf(2.0f * x)); }

namespace pg8 {
constexpr int BM = 256, BK = 64, HALF = 128, HTB = HALF * BK * 2, STAGE_BYTES = 8 * HTB, NXCD = 8, WGM = 8;
__host__ __device__ __forceinline__ int lds_byte(int r, int c) { const int st = (r >> 4) * 2 + (c >> 5), rr = r & 15, cc = c & 31, ob = rr * 64 + cc * 2; return st * 1024 + (ob ^ (((ob >> 9) & 1) << 5)); }
__host__ __device__ __forceinline__ int perm32(int rho) { const int n = rho >> 4, i = rho & 15; return 8 * (i >> 2) + 4 * n + (i & 3); }
__host__ __device__ __forceinline__ void stage_rc(int b, int& R, int& C) { const int st = b / 1024, sb = b % 1024, swz = sb ^ (((sb >> 9) & 1) << 5); R = (st >> 1) * 16 + swz / 64; C = (st & 1) * 32 + (swz % 64) / 2; }
struct Unit { int pm, pn; };
struct Gemm { const bf16_t* A; const bf16_t* Bt; int M, N, K, lda, ldb; };
struct StaticOrder {
    int nM, nN, nwg, G, c;
    __device__ void init(int M, int N, int G_, int c_) { nM = M / BM; nN = N / BM; nwg = nM * nN; G = G_; c = c_; }
    __device__ bool next(int i, Unit& u) const {
        const int L = i * G + c; if (L >= nwg) return false;
        int wgid = L; { const int q = nwg / NXCD, r = nwg % NXCD, xcd = wgid % NXCD, off = wgid / NXCD; wgid = (xcd < r ? xcd * (q + 1) : r * (q + 1) + (xcd - r) * q) + off; }
        const int nig = WGM * nN, gid = wgid / nig, fm = gid * WGM, gsz = (nM - fm) < WGM ? (nM - fm) : WGM;
        u.pm = fm + ((wgid % nig) % gsz); u.pn = (wgid % nig) / gsz; return true;
    }
};
template <class Epi>
__device__ __forceinline__ void gemm_phase(LAS unsigned char* lds, const Gemm g, const StaticOrder& S, const Epi& E) {
    int tid_ = threadIdx.x; asm volatile("" : "+v"(tid_));
    const int tid = tid_, wid = __builtin_amdgcn_readfirstlane(tid >> 6), lane = tid & 63, wr = wid >> 2, wc = wid & 3, fr = lane & 15, fq = lane >> 4;
    const int K = g.K, nt = K / BK;
    unsigned voffA[2], voffB[2];
#pragma unroll
    for (int i = 0; i < 2; ++i) { int R, C; stage_rc(tid * 16 + i * 8192, R, C); const int Rb = Epi::PERM ? ((R & ~31) + perm32(R & 31)) : R; voffA[i] = (unsigned)(R * g.lda + C) * 2u; voffB[i] = (unsigned)(Rb * g.ldb + C) * 2u; }
    const size_t kstep = (size_t)(BK * 2);
    const size_t hsA = (size_t)HALF * g.lda * 2, hsB = (size_t)HALF * g.ldb * 2;
    const size_t tsA = 2 * hsA, tsB = 2 * hsB;
    const unsigned ldsw = (unsigned)wid * 1024u;
    const int aoff = lds_byte(wr * 64 + fr, fq * 8), boff = lds_byte(wc * 32 + fr, fq * 8);
#define PG8_SA(b, h) (((b) * 2 + (h)) * HTB)
#define PG8_SB(b, h) ((4 + (b) * 2 + (h)) * HTB)
#define PG8_STAGE(bufoff, gbase, voff) do { _Pragma("unroll") for (int _i = 0; _i < 2; ++_i) \
        __builtin_amdgcn_global_load_lds((const unsigned*)((const char*)(gbase) + (voff)[_i]), (LAS unsigned*)(lds + (bufoff) + ldsw + _i * 8192), 16, 0, 0); } while (0)
#define PG8_LDA(dst, b, h) do { _Pragma("unroll") for (int m = 0; m < 4; ++m) _Pragma("unroll") for (int k = 0; k < 2; ++k) dst[m][k] = *(const LAS bf16x8*)(lds + PG8_SA(b, h) + aoff + m * 2048 + k * 1024); } while (0)
#define PG8_LDB(dst, b, h) do { _Pragma("unroll") for (int n = 0; n < 2; ++n) _Pragma("unroll") for (int k = 0; k < 2; ++k) dst[n][k] = *(const LAS bf16x8*)(lds + PG8_SB(b, h) + boff + n * 2048 + k * 1024); } while (0)
#define PG8_MMA(ai, bj, At, Bt) do { __builtin_amdgcn_s_setprio(1); _Pragma("unroll") for (int m = 0; m < 4; ++m) _Pragma("unroll") for (int n = 0; n < 2; ++n) _Pragma("unroll") for (int k = 0; k < 2; ++k) \
        acc[ai][bj][m][n] = __builtin_amdgcn_mfma_f32_16x16x32_bf16(Bt[n][k], At[m][k], acc[ai][bj][m][n], 0, 0, 0); __builtin_amdgcn_s_setprio(0); } while (0)
#define PG8_WAIT_V(n) asm volatile("s_waitcnt vmcnt(" #n ")" ::: "memory")
#define PG8_WAIT_L(n) asm volatile("s_waitcnt lgkmcnt(" #n ")" ::: "memory")
#define PG8_BAR __builtin_amdgcn_s_barrier()
#define PG8_SCHED __builtin_amdgcn_sched_barrier(0)
    Unit cur, nxt; int ui = 0;
    if (!S.next(0, cur)) return;
    f32x4 acc[2][2][4][2];
#pragma unroll
    for (int a = 0; a < 2; ++a)
#pragma unroll
        for (int b = 0; b < 2; ++b)
#pragma unroll
            for (int m = 0; m < 4; ++m)
#pragma unroll
                for (int n = 0; n < 2; ++n) acc[a][b][m][n] = (f32x4){0.f, 0.f, 0.f, 0.f};
    bf16x8 At[4][2], B0[2][2], B1[2][2];
    const char* cA = (const char*)g.A + (size_t)cur.pm * tsA; const char* cB = (const char*)g.Bt + (size_t)cur.pn * tsB;
    PG8_STAGE(PG8_SB(0, 0), cB, voffB); PG8_STAGE(PG8_SB(0, 1), cB + hsB, voffB); PG8_STAGE(PG8_SA(0, 0), cA, voffA); PG8_STAGE(PG8_SA(0, 1), cA + hsA, voffA);
    if (wr == 1) PG8_BAR;
    PG8_WAIT_V(2); PG8_BAR;
    PG8_STAGE(PG8_SB(1, 0), cB + kstep, voffB); PG8_STAGE(PG8_SA(1, 0), cA + kstep, voffA); PG8_STAGE(PG8_SB(1, 1), cB + hsB + kstep, voffB);
    PG8_WAIT_V(6); PG8_BAR;
    for (;;) {
        const bool has_next = S.next(ui + 1, nxt);
        const char* nA = has_next ? (const char*)g.A + (size_t)nxt.pm * tsA : cA; const char* nB = has_next ? (const char*)g.Bt + (size_t)nxt.pn * tsB : cB;
#pragma unroll 1
        for (int t = 0; t < nt; t += 2) {
            const bool last = (t == nt - 2);
            const char* a1 = cA + (size_t)(t + 1) * kstep;
            const char* a2 = last ? nA : cA + (size_t)(t + 2) * kstep; const char* b2 = last ? nB : cB + (size_t)(t + 2) * kstep;
            const char* a3 = a2 + kstep; const char* b3 = b2 + kstep;
            PG8_LDB(B0, 0, 0); PG8_LDB(B1, 0, 1); PG8_SCHED; PG8_LDA(At, 0, 0); PG8_STAGE(PG8_SA(1, 1), a1 + hsA, voffA);
            PG8_WAIT_V(8); PG8_WAIT_L(0); PG8_BAR; PG8_MMA(0, 0, At, B0); PG8_MMA(0, 1, At, B1); PG8_BAR; PG8_SCHED;
            PG8_LDA(At, 0, 1); PG8_STAGE(PG8_SB(0, 0), b2, voffB); PG8_STAGE(PG8_SB(0, 1), b2 + hsB, voffB); PG8_STAGE(PG8_SA(0, 0), a2, voffA);
            PG8_WAIT_V(8); PG8_WAIT_L(0); PG8_BAR; PG8_MMA(1, 0, At, B0); PG8_MMA(1, 1, At, B1); PG8_BAR; PG8_SCHED;
            PG8_LDB(B0, 1, 0); PG8_LDB(B1, 1, 1); PG8_SCHED; PG8_LDA(At, 1, 0); PG8_STAGE(PG8_SA(0, 1), a2 + hsA, voffA);
            PG8_WAIT_V(8); PG8_WAIT_L(0); PG8_BAR; PG8_MMA(0, 0, At, B0); PG8_MMA(0, 1, At, B1); PG8_BAR; PG8_SCHED;
            PG8_LDA(At, 1, 1); PG8_STAGE(PG8_SB(1, 0), b3, voffB); PG8_STAGE(PG8_SB(1, 1), b3 + hsB, voffB); PG8_STAGE(PG8_SA(1, 0), a3, voffA);
            PG8_WAIT_V(8); PG8_WAIT_L(0); PG8_BAR; PG8_MMA(1, 0, At, B0); PG8_MMA(1, 1, At, B1); PG8_BAR; PG8_SCHED;
        }
        if (wr == 0) PG8_BAR;
        E(acc, cur, wr, wc, fr, fq);
        if (!has_next) break;
#pragma unroll
        for (int a = 0; a < 2; ++a)
#pragma unroll
            for (int b = 0; b < 2; ++b)
#pragma unroll
                for (int m = 0; m < 4; ++m)
#pragma unroll
                    for (int n = 0; n < 2; ++n) acc[a][b][m][n] = (f32x4){0.f, 0.f, 0.f, 0.f};
        cur = nxt; cA = nA; cB = nB; ++ui;
        if (wr == 1) PG8_BAR;
    }
    PG8_WAIT_V(0);
    PG8_BAR;
#undef PG8_SA
#undef PG8_SB
#undef PG8_STAGE
#undef PG8_LDA
#undef PG8_LDB
#undef PG8_MMA
#undef PG8_WAIT_V
#undef PG8_WAIT_L
#undef PG8_BAR
#undef PG8_SCHED
}
}
using pg8::Unit;

__device__ __forceinline__ void rows_rstd16(const float* ssq, int row0, int fq, float (&rs)[8]) {
    float p[8][4];
#pragma unroll
    for (int i = 0; i < 8; ++i) { const unsigned o = (unsigned)(4 * fq) * T + row0 + (i >> 2) * 128 + (i & 3) * 16;
#pragma unroll
        for (int k = 0; k < 4; ++k) p[i][k] = ssq[o + k * T]; }
#pragma unroll
    for (int i = 0; i < 8; ++i) { float s = (p[i][0] + p[i][1]) + (p[i][2] + p[i][3]); s += __shfl_xor(s, 16); s += __shfl_xor(s, 32); rs[i] = rsqrtf(s * (1.0f / 1024.0f) + RMS_EPS); }
}
__device__ __forceinline__ void rows_rstd4(const float* pp, int row0, int fq, float invw, float mul, float (&rs)[8]) {
    float p[8];
#pragma unroll
    for (int i = 0; i < 8; ++i) p[i] = pp[(unsigned)fq * T + (unsigned)(row0 + (i >> 2) * 128 + (i & 3) * 16)];
#pragma unroll
    for (int i = 0; i < 8; ++i) { float s = p[i]; s += __shfl_xor(s, 16); s += __shfl_xor(s, 32); rs[i] = rsqrtf(s * invw + RMS_EPS) * mul; }
}

struct EpiSwiGLU {
    static constexpr bool PERM = false;
    bf16_t* act; const float* ssq;
    __device__ __forceinline__ void operator()(const f32x4 (&acc)[2][2][4][2], const Unit& u, int wr, int wc, int fr, int fq) const {
        const int row0 = u.pm * 256 + wr * 64 + fr;
        const unsigned off0 = (unsigned)row0 * FF + u.pn * 128 + wc * 32 + fq * 8;
        float rsv[8]; rows_rstd16(ssq, row0, fq, rsv);
#pragma unroll
        for (int ai = 0; ai < 2; ++ai)
#pragma unroll
            for (int m = 0; m < 4; ++m) {
                const float rs = rsv[ai * 4 + m];
                u32x4 w;
#pragma unroll
                for (int bj = 0; bj < 2; ++bj) {
                    const f32x4 gt = acc[ai][bj][m][0] * rs, up = acc[ai][bj][m][1] * rs; f32x4 o;
#pragma unroll
                    for (int k = 0; k < 4; ++k) o[k] = gt[k] * up[k] * __builtin_amdgcn_rcpf(1.0f + __expf(-gt[k]));
                    const u32x2 pw = pack4(o); if (bj == 0) { w.x = pw.x; w.y = pw.y; } else { w.z = pw.x; w.w = pw.y; }
                }
                st16_wt(act + (off0 + (unsigned)((ai * 128 + m * 16) * FF)), w);
            }
    }
};
struct EpiResid {
    static constexpr bool PERM = true;
    bf16_t* xb; float* ssq; float scale;
    __device__ __forceinline__ void operator()(const f32x4 (&acc)[2][2][4][2], const Unit& u, int wr, int wc, int fr, int fq) const {
        const int row0 = u.pm * 256 + wr * 64 + fr;
        const unsigned off0 = (unsigned)row0 * DM + u.pn * 256 + wc * 32 + fq * 8;
        const unsigned so = (unsigned)(u.pn * 4 + wc) * T + row0;
#pragma unroll
        for (int ai = 0; ai < 2; ++ai) {
            u32x4 bv[4][2];
#pragma unroll
            for (int m = 0; m < 4; ++m)
#pragma unroll
                for (int bj = 0; bj < 2; ++bj) bv[m][bj] = *(const u32x4*)(xb + (off0 + (unsigned)((ai * 128 + m * 16) * DM + bj * 128)));
#pragma unroll
            for (int m = 0; m < 4; ++m) {
                float ss = 0.f;
#pragma unroll
                for (int bj = 0; bj < 2; ++bj) {
                    const unsigned o2 = off0 + (unsigned)((ai * 128 + m * 16) * DM + bj * 128);
                    const f32x4 v0 = unpack4((u32x2){bv[m][bj].x, bv[m][bj].y}) + acc[ai][bj][m][0] * scale;
                    const f32x4 v1 = unpack4((u32x2){bv[m][bj].z, bv[m][bj].w}) + acc[ai][bj][m][1] * scale;
                    const u32x2 p0 = pack4(v0), p1 = pack4(v1);
                    st16_wt(xb + o2, (u32x4){p0.x, p0.y, p1.x, p1.y});
                    ss += ((v0[0] * v0[0] + v0[1] * v0[1]) + (v0[2] * v0[2] + v0[3] * v0[3])) + ((v1[0] * v1[0] + v1[1] * v1[1]) + (v1[2] * v1[2] + v1[3] * v1[3]));
                }
                ss += __shfl_xor(ss, 16); ss += __shfl_xor(ss, 32);
                if (fq == 0) ssq[so + (unsigned)(ai * 128 + m * 16)] = ss;
            }
            asm volatile("" ::: "memory");
        }
    }
};
template <bool ODD> struct EpiZ {
    static constexpr bool PERM = true;
    bf16_t* z; int ldz; const float* ssq; float* pq; float* pkv;
    __device__ __forceinline__ void operator()(const f32x4 (&acc)[2][2][4][2], const Unit& u, int wr, int wc, int fr, int fq) const {
        const int row0 = u.pm * 256 + wr * 64 + fr;
        const unsigned off0 = (unsigned)row0 * ldz + u.pn * 256 + wc * 32 + fq * 8;
        float rsv[8]; rows_rstd16(ssq, row0, fq, rsv);
#pragma unroll
        for (int ai = 0; ai < 2; ++ai)
#pragma unroll
            for (int m = 0; m < 4; ++m) {
                const int row = row0 + ai * 128 + m * 16;
                const float rs = rsv[ai * 4 + m];
                float s0 = 0.f, s1 = 0.f;
#pragma unroll
                for (int bj = 0; bj < 2; ++bj) {
                    const f32x4 v0 = acc[ai][bj][m][0] * rs, v1 = acc[ai][bj][m][1] * rs;
                    const u32x2 p0 = pack4(v0), p1 = pack4(v1);
                    st16_wt(z + (off0 + (unsigned)((ai * 128 + m * 16) * ldz + bj * 128)), (u32x4){p0.x, p0.y, p1.x, p1.y});
                    const float q = ((v0[0] * v0[0] + v0[1] * v0[1]) + (v0[2] * v0[2] + v0[3] * v0[3])) + ((v1[0] * v1[0] + v1[1] * v1[1]) + (v1[2] * v1[2] + v1[3] * v1[3]));
                    if (bj == 0) s0 += q; else s1 += q;
                }
                if (ODD) {
                    if (u.pn == 0) { float s = s0 + s1; s += __shfl_xor(s, 16); s += __shfl_xor(s, 32); if (fq == 0) pq[(unsigned)wc * T + row] = s; }
                    else if (u.pn == 1) { float s = s0; s += __shfl_xor(s, 16); s += __shfl_xor(s, 32); if (fq == 0) pkv[(unsigned)wc * T + row] = s; }
                }
            }
    }
};
struct EpiUp {
    static constexpr bool PERM = true;
    bf16_t* q; bf16_t* kv; const float* pq; const float* pkv; const float* cosT; const float* sinT;
    __device__ __forceinline__ void operator()(const f32x4 (&acc)[2][2][4][2], const Unit& u, int wr, int wc, int fr, int fq) const {
        const int row0 = u.pm * 256 + wr * 64 + fr;
        float rsv[8];
        if (u.pn < 3) {
            rows_rstd4(pq, row0, fq, 1.0f / 256.0f, QSCALE, rsv);
#pragma unroll
            for (int bj = 0; bj < 2; ++bj) {
                const int G = u.pn * 8 + bj * 4 + wc;
                const bool rope = (G % 3) == 2;
#pragma unroll
                for (int ai = 0; ai < 2; ++ai)
#pragma unroll
                    for (int m = 0; m < 4; ++m) {
                        const int row = row0 + ai * 128 + m * 16; const float rs = rsv[ai * 4 + m];
                        f32x4 v0 = acc[ai][bj][m][0] * rs, v1 = acc[ai][bj][m][1] * rs;
                        if (rope) {
                            const int pos = row & (SEQ - 1);
                            const f32x4 c4 = *(const f32x4*)(cosT + (unsigned)(pos * 16 + fq * 4)), s4 = *(const f32x4*)(sinT + (unsigned)(pos * 16 + fq * 4));
                            const f32x4 o0 = v0 * c4 - v1 * s4, o1 = v0 * s4 + v1 * c4; v0 = o0; v1 = o1;
                        }
                        const u32x2 p0 = pack4(v0), p1 = pack4(v1);
                        st16_wt(q + (unsigned)(row * 768 + G * 32 + fq * 8), (u32x4){p0.x, p0.y, p1.x, p1.y});
                    }
            }
        } else {
            rows_rstd4(pkv, row0, fq, 1.0f / 128.0f, 1.0f, rsv);
#pragma unroll
            for (int ai = 0; ai < 2; ++ai)
#pragma unroll
                for (int m = 0; m < 4; ++m) {
                    const int row = row0 + ai * 128 + m * 16; const float rs = rsv[ai * 4 + m];
#pragma unroll
                    for (int bj = 0; bj < 2; ++bj) {
                        const u32x2 p0 = pack4(acc[ai][bj][m][0] * rs), p1 = pack4(acc[ai][bj][m][1] * rs);
                        st16_wt(kv + (unsigned)(row * 1024 + (u.pn - 3) * 256 + bj * 128 + wc * 32 + fq * 8), (u32x4){p0.x, p0.y, p1.x, p1.y});
                    }
                }
        }
    }
};

#define XB_TMO      128
#define XB_XCNT(j)  (256  + 64 * (j))
#define XB_XSUB(j)  (1280 + 64 * (j))
#define XB_XGEN(j)  (2304 + 64 * (j))
#define XB_TOP      3328
#define XB_TOPGEN   3392
#define XCD_BAR_WORDS 3456
#define XB_LSUB(j)  (3456 + 64 * (j))
#define XB_LGEN(j)  (4480 + 64 * (j))
#define XB_SPIN_CAP (1u << 18)
__device__ __forceinline__ unsigned xb_ld(unsigned* p)              { return __hip_atomic_load(p, __ATOMIC_RELAXED, __HIP_MEMORY_SCOPE_AGENT); }
__device__ __forceinline__ unsigned xb_add(unsigned* p, unsigned v) { return __hip_atomic_fetch_add(p, v, __ATOMIC_RELAXED, __HIP_MEMORY_SCOPE_AGENT); }
__device__ __forceinline__ unsigned xb_xcc_id() { return (unsigned)__builtin_amdgcn_s_getreg((3 << 11) | 20) & 0xFu; }
#define XB_SPIN(cond, bar) do { unsigned _sp = 0; while (cond) { __builtin_amdgcn_s_sleep(1); \
    if ((++_sp & 255u) == 0u) { if (xb_ld(&(bar)[XB_TMO])) break; if (_sp > XB_SPIN_CAP) { atomicAdd(&(bar)[XB_TMO], 1u); break; } } } } while (0)
struct XcdBarrier { unsigned* bar; unsigned x; volatile LAS unsigned* st; };
__device__ __forceinline__ XcdBarrier xcd_barrier_post(unsigned* bar, volatile LAS unsigned* st) {
    XcdBarrier b; b.bar = bar; b.x = xb_xcc_id(); b.st = st;
    if (threadIdx.x == 0) st[3] = xb_add(&bar[XB_XCNT(b.x)], 1u);
    return b;
}
__device__ __forceinline__ void xcd_barrier_complete(unsigned* bar, unsigned x, unsigned& nloc, unsigned& nx, unsigned& regular) {
    const unsigned G = gridDim.x * gridDim.y * gridDim.z;
    unsigned sum, cnt, mine, sp = 0u;
    for (;;) {
        sum = 0u; cnt = 0u; mine = 0u;
#pragma unroll
        for (unsigned j = 0; j < 16; ++j) { const unsigned c = xb_ld(&bar[XB_XCNT(j)]); sum += c; cnt += (c > 0u) ? 1u : 0u; mine = (j == x) ? c : mine; }
        if (sum == G) break;
        __builtin_amdgcn_s_sleep(1);
        if ((++sp & 255u) == 0u) { if (xb_ld(&bar[XB_TMO])) break; if (sp > XB_SPIN_CAP) { atomicAdd(&bar[XB_TMO], 1u); break; } }
    }
    nloc = mine > 0u ? mine : 1u; nx = cnt > 0u ? cnt : 1u;
    unsigned reg = (G == 256u) ? 1u : 0u;
#pragma unroll
    for (unsigned j = 0; j < 16; ++j) { const unsigned c = xb_ld(&bar[XB_XCNT(j)]); if (c != (j < 8u ? 32u : 0u)) reg = 0u; }
    regular = reg;
}
__device__ __forceinline__ void xcd_barrier(const XcdBarrier& b) {
    asm volatile("s_waitcnt vmcnt(0)" ::: "memory");
    __syncthreads();
    if (threadIdx.x == 0) {
        unsigned* bar = b.bar;
        __builtin_amdgcn_s_waitcnt(0);
        unsigned nloc = b.st[0], nx = b.st[1];
        if (nloc == 0u) { unsigned reg_; xcd_barrier_complete(bar, b.x, nloc, nx, reg_); b.st[0] = nloc; b.st[1] = nx; b.st[2] = reg_; }
        const unsigned old = xb_add(&bar[XB_XSUB(b.x)], 1u);
        const unsigned gen = old / nloc;
        if (old + 1u == (gen + 1u) * nloc) {
            __builtin_amdgcn_fence(__ATOMIC_RELEASE, "agent");
            asm volatile("s_waitcnt vmcnt(0)" ::: "memory");
            const unsigned og = xb_add(&bar[XB_TOP], 1u);
            const unsigned tg = og / nx;
            if (og + 1u == (tg + 1u) * nx) xb_add(&bar[XB_TOPGEN], 1u);
            else XB_SPIN(xb_ld(&bar[XB_TOPGEN]) == tg, bar);
            __builtin_amdgcn_fence(__ATOMIC_ACQUIRE, "agent");
            xb_add(&bar[XB_XGEN(b.x)], 1u);
            asm volatile("s_waitcnt vmcnt(0)" ::: "memory");
        } else {
            XB_SPIN(xb_ld(&bar[XB_XGEN(b.x)]) == gen, bar);
            __builtin_amdgcn_fence(__ATOMIC_ACQUIRE, "agent");
            asm volatile("s_waitcnt vmcnt(0)" ::: "memory");
        }
    }
    __syncthreads();
}
__device__ __forceinline__ void xcd_local_barrier(const XcdBarrier& b) {
    asm volatile("s_waitcnt vmcnt(0)" ::: "memory");
    __syncthreads();
    if (threadIdx.x == 0) {
        unsigned* bar = b.bar;
        __builtin_amdgcn_s_waitcnt(0);
        const unsigned nloc = b.st[0];
        const unsigned old = xb_add(&bar[XB_LSUB(b.x)], 1u);
        const unsigned gen = old / nloc;
        if (old + 1u == (gen + 1u) * nloc) xb_add(&bar[XB_LGEN(b.x)], 1u);
        else XB_SPIN(xb_ld(&bar[XB_LGEN(b.x)]) == gen, bar);
        __builtin_amdgcn_fence(__ATOMIC_ACQUIRE, "agent");
        asm volatile("s_waitcnt vmcnt(0)" ::: "memory");
    }
    __syncthreads();
}
template <int K> __device__ __forceinline__ const float* inp() {
    unsigned long long v;
    const unsigned long long kp_ = (unsigned long long)__builtin_amdgcn_kernarg_segment_ptr();
    const unsigned long long kps_ = ((unsigned long long)(unsigned)__builtin_amdgcn_readfirstlane((int)(unsigned)(kp_ >> 32)) << 32) | (unsigned)__builtin_amdgcn_readfirstlane((int)(unsigned)kp_);
    asm volatile("s_load_dwordx2 %0, %1, %2\n\ts_waitcnt lgkmcnt(0)" : "=s"(v) : "s"(kps_), "n"(K * 8) : "memory");
    return (const float*)(const __attribute__((address_space(1))) float*)v;
}
struct Args { const float* in[36]; float* out; unsigned char* ws; int ph_lo, ph_hi; };
struct Frame {
    LAS unsigned char* lds;
    int tid, lane, wave, G, bid;
    float* out; unsigned char* ws;
};

struct CvtDesc { const float* W; const float* gain; bf16_t* WT; int N, ldt, kdst, mode, item; };
__device__ __forceinline__ void cvt_load(const CvtDesc& d, int lane, f32x4 (&v)[8], float (&g)[8]) {
    const int nblk = d.N / 32, kb = d.item / nblk, nb = d.item % nblk, k0 = 64 * kb, n0 = 32 * nb;
    const int kq = lane >> 3, nq = (lane & 7) * 4;
#pragma unroll
    for (int i = 0; i < 8; ++i) v[i] = *(const f32x4*)(d.W + (size_t)(k0 + i * 8 + kq) * d.N + n0 + nq);
#pragma unroll
    for (int i = 0; i < 8; ++i) g[i] = d.gain ? d.gain[k0 + i * 8 + kq] : 1.0f;
}
__device__ __forceinline__ void cvt_finish(const CvtDesc& d, int lane, LAS float* scr, const f32x4 (&v)[8], const float (&g)[8]) {
    const int nblk = d.N / 32, kb = d.item / nblk, nb = d.item % nblk, k0 = 64 * kb, n0 = 32 * nb;
    const int kq = lane >> 3, nq = (lane & 7) * 4;
#pragma unroll
    for (int i = 0; i < 8; ++i) { const int kk = i * 8 + kq; const float gk = g[i]; LAS float* dd = scr + kk * 33 + nq; dd[0] = v[i][0] * gk; dd[1] = v[i][1] * gk; dd[2] = v[i][2] * gk; dd[3] = v[i][3] * gk; }
    asm volatile("s_waitcnt lgkmcnt(0)" ::: "memory");
    const int c = lane & 7;
#pragma unroll
    for (int j = 0; j < 4; ++j) {
        const int n = (lane >> 3) + 8 * j; const LAS float* sp_ = scr + (8 * c) * 33 + n;
        u32x4 o; o.x = pk2(sp_[0 * 33], sp_[1 * 33]); o.y = pk2(sp_[2 * 33], sp_[3 * 33]); o.z = pk2(sp_[4 * 33], sp_[5 * 33]); o.w = pk2(sp_[6 * 33], sp_[7 * 33]);
        int nn = n0 + n;
        if (d.mode == 1) { const int which = nn >= FF ? 1 : 0, h = nn - which * FF, hl = h & 127; nn = 256 * (h >> 7) + 128 * ((hl >> 2) & 1) + 32 * (hl >> 5) + 16 * which + 4 * ((hl >> 3) & 3) + (hl & 3); }
        if (d.mode == 2) { const int hd = nn / 96, dd = nn % 96; if (dd >= 64) { const int r_ = dd - 64, n_ = r_ >> 4, i_ = r_ & 15; nn = hd * 96 + 64 + 8 * (i_ >> 2) + 4 * n_ + (i_ & 3); } }
        st16_wt(d.WT + (size_t)nn * d.ldt + d.kdst + k0 + 8 * c, o);
    }
    asm volatile("s_waitcnt lgkmcnt(0)" ::: "memory");
}
__device__ __forceinline__ void zero_fill16(unsigned char* base, int row_bytes_stride, int col_byte0, int chunks_per_row, int nrows, int gtid, int gthreads) {
    const int total = nrows * chunks_per_row;
    unsigned zz = 0u; asm volatile("" : "+v"(zz));
    const u32x4 z4 = (u32x4){zz, zz, zz, zz};
    for (int i = gtid; i < total; i += gthreads) { const int r = i / chunks_per_row, c = i % chunks_per_row; st16_wt(base + (size_t)r * row_bytes_stride + col_byte0 + c * 16, z4); }
}
__device__ __forceinline__ void convert_layer(const Frame& F, int l, int part, int nparts, int vb, int nvb) {
    unsigned char* wb = F.ws + WS_WBUF0 + (size_t)(l & 1) * WBUF_BYTES;
    LAS float* scr = (LAS float*)(F.lds + F.wave * 16384);
    const int gw = vb * 8 + F.wave, NGW = nvb * 8;
    const int hl = l >> 1; const bool odd = l & 1;
    constexpr int I_IN = 16 * 176, I_OUT = 44 * 32, I_MO = 16 * 32;
    const int I_MI = odd ? 16 * 45 : 16 * 88;
    const int I_X = odd ? (4 * 24 + 2 * 32) : (16 + 16 + 32);
    const int total = 2 * I_IN + 2 * I_OUT + I_MI + I_MO + I_X;
    const int it_lo = (int)((long)total * part / nparts), it_hi = (int)((long)total * (part + 1) / nparts);
    auto desc = [&](int it) -> CvtDesc {
        CvtDesc d; d.kdst = 0; d.mode = 0; d.gain = nullptr;
        int r = it;
        if (r < I_IN) { d.W = inp<2>() + (size_t)l * DM * 2 * FF; d.N = 2 * FF; d.gain = inp<1>() + l * DM; d.WT = (bf16_t*)(wb + WB_W1IN); d.ldt = DM; d.mode = 1; d.item = r; return d; } r -= I_IN;
        if (r < I_IN) { d.W = inp<6>() + (size_t)l * DM * 2 * FF; d.N = 2 * FF; d.gain = inp<5>() + l * DM; d.WT = (bf16_t*)(wb + WB_W2IN); d.ldt = DM; d.mode = 1; d.item = r; return d; } r -= I_IN;
        if (r < I_OUT) { d.W = inp<3>() + (size_t)l * FF * DM; d.N = DM; d.WT = (bf16_t*)(wb + WB_W1OUT); d.ldt = FF; d.item = r; return d; } r -= I_OUT;
        if (r < I_OUT) { d.W = inp<7>() + (size_t)l * FF * DM; d.N = DM; d.WT = (bf16_t*)(wb + WB_W2OUT); d.ldt = FF; d.item = r; return d; } r -= I_OUT;
        if (r < I_MI) {
            if (odd) { d.W = inp<25>() + (size_t)hl * DM * PO; d.N = PO; } else { d.W = inp<8>() + (size_t)hl * DM * PE; d.N = PE; }
            d.gain = inp<4>() + l * DM; d.WT = (bf16_t*)(wb + WB_WMIN); d.ldt = DM; d.item = r; return d; } r -= I_MI;
        if (r < I_MO) { d.W = (odd ? inp<26>() : inp<9>()) + (size_t)hl * DM * DM; d.N = DM; d.WT = (bf16_t*)(wb + WB_WMOUT); d.ldt = DM; d.item = r; return d; } r -= I_MO;
        if (odd) {
            if (r < 96) { d.W = inp<28>() + (size_t)hl * 256 * 768; d.N = 768; d.gain = inp<27>() + hl * 256; d.WT = (bf16_t*)(wb + WB_WX); d.ldt = 384; d.mode = 2; d.item = r; return d; } r -= 96;
            d.W = inp<30>() + (size_t)hl * 128 * 1024; d.N = 1024; d.gain = inp<29>() + hl * 128; d.WT = (bf16_t*)(wb + WB_WX) + (size_t)768 * 384; d.ldt = 384; d.kdst = 256; d.item = r; return d;
        }
        if (r < 16) { d.W = inp<16>() + (size_t)hl * 64 * 512; d.N = 512; d.WT = (bf16_t*)(wb + WB_WX); d.ldt = 64; d.item = r; return d; } r -= 16;
        if (r < 16) { d.W = inp<18>() + (size_t)hl * 64 * 512; d.N = 512; d.WT = (bf16_t*)(wb + WB_WX) + 512 * 64; d.ldt = 64; d.item = r; return d; } r -= 16;
        d.W = inp<19>() + (size_t)hl * 128 * 512; d.N = 512; d.WT = (bf16_t*)(wb + WB_WX) + 2 * 512 * 64; d.ldt = 128; d.item = r; return d;
    };
    {
        int it = it_lo + gw;
        if (it < it_hi) {
            CvtDesc d0 = desc(it), d1 = d0; f32x4 va[8], vc[8]; float ga[8], gc[8];
            cvt_load(d0, F.lane, va, ga);
            for (;;) {
                const int it1 = it + NGW; const bool h1 = it1 < it_hi;
                if (h1) { d1 = desc(it1); cvt_load(d1, F.lane, vc, gc); }
                cvt_finish(d0, F.lane, scr, va, ga);
                if (!h1) break;
                const int it2 = it1 + NGW; const bool h2 = it2 < it_hi;
                if (h2) { d0 = desc(it2); cvt_load(d0, F.lane, va, ga); }
                cvt_finish(d1, F.lane, scr, vc, gc);
                if (!h2) break;
                it = it2;
            }
        }
    }
    if (odd && part == 0) {
        const int gtid = vb * 512 + F.tid, gth = nvb * 512;
        zero_fill16(wb + WB_WMIN + (size_t)PO * DM * 2, DM * 2, 0, 128, POP - PO, gtid, gth);
        zero_fill16(wb + WB_WX, 384 * 2, 512, 16, 768, gtid, gth);
        zero_fill16(wb + WB_WX + (size_t)768 * 384 * 2, 384 * 2, 0, 32, 1024, gtid, gth);
    }
}

__device__ __forceinline__ void x_prologue(const Frame& F) {
    const float* x = inp<0>(); bf16_t* xb = (bf16_t*)(F.ws + WS_XB); float* ssq = (float*)(F.ws + WS_SSQ);
    const int gw = F.bid * 8 + F.wave, NGW = F.G * 8, lane = F.lane;
    for (int m = gw; m < T; m += NGW) {
        const f32x4* xr = (const f32x4*)(x + (size_t)m * DM) + lane;
        f32x4 v[4]; float s = 0.f;
#pragma unroll
        for (int j = 0; j < 4; ++j) { v[j] = xr[64 * j]; s += (v[j][0] * v[j][0] + v[j][1] * v[j][1]) + (v[j][2] * v[j][2] + v[j][3] * v[j][3]); }
        s = wave_sum(s);
        u32x2* o = (u32x2*)(xb + (size_t)m * DM) + lane;
#pragma unroll
        for (int j = 0; j < 4; ++j) st8_wt(o + 64 * j, pack4(v[j]));
        if (lane < 16) ssq[(size_t)lane * T + m] = (lane == 0) ? s : 0.f;
    }
    float* cosT = (float*)(F.ws + WS_COS); float* sinT = (float*)(F.ws + WS_SIN);
    for (int i = F.bid * 512 + F.tid; i < SEQ * 16; i += F.G * 512) {
        const int pos = i >> 4, k = i & 15;
        const float inv = exp2f(-(float)k * 0.8304820237218407f);
        const float ang = (float)pos * inv;
        const double rev = (double)ang * 0.15915494309189535;
        const float fr = (float)(rev - floor(rev));
        cosT[i] = __builtin_amdgcn_cosf(fr); sinT[i] = __builtin_amdgcn_sinf(fr);
    }
}
__device__ __forceinline__ void final_norm(const Frame& F) {
    const float* g = inp<35>(); float* x = F.out; const bf16_t* xb = (const bf16_t*)(F.ws + WS_XB);
    const int gw = F.bid * 8 + F.wave, NGW = F.G * 8, lane = F.lane;
    for (int m = gw; m < T; m += NGW) {
        f32x4* xr = (f32x4*)(x + (size_t)m * DM) + lane;
        const u32x2* br = (const u32x2*)(xb + (size_t)m * DM) + lane;
        f32x4 v[4]; float s = 0.f;
#pragma unroll
        for (int j = 0; j < 4; ++j) { v[j] = unpack4(br[64 * j]); s += (v[j][0] * v[j][0] + v[j][1] * v[j][1]) + (v[j][2] * v[j][2] + v[j][3] * v[j][3]); }
        s = wave_sum(s);
        const float rs = rsqrtf(s * (1.0f / 1024.0f) + RMS_EPS);
#pragma unroll
        for (int j = 0; j < 4; ++j) { const f32x4 gg = *((const f32x4*)g + lane + 64 * j); xr[64 * j] = v[j] * rs * gg; }
    }
}

__device__ __forceinline__ void gsu_item(const Frame& F, int item, int e) {
    const int nb = item >> 2, g = item & 3, tok0 = nb * 128, lane = F.lane, wave = F.wave, fr = lane & 15, fq = lane >> 4;
    const bf16_t* z = (const bf16_t*)(F.ws + WS_ACT);
    bf16_t* ymix = (bf16_t*)(F.ws + WS_YMIX);
    const float* ws = inp<10>() + (size_t)(e * 4 + g) * 128 * 128; const float* bs = inp<11>() + (e * 4 + g) * 128;
    const float* lng = inp<12>() + e * 512; const float* lnb = inp<13>() + e * 512;
    LAS bf16_t* vn = (LAS bf16_t*)F.lds;
    u32x4 zrs[16];
#pragma unroll
    for (int fi = 0; fi < 16; ++fi) zrs[fi] = *(const u32x4*)(z + (size_t)(tok0 + wave * 16 + fi) * PE + 512 + lane * 8);
    float lgv[8], lbv[8];
#pragma unroll
    for (int k = 0; k < 8; ++k) { lgv[k] = lng[lane * 8 + k]; lbv[k] = lnb[lane * 8 + k]; }
#pragma unroll
    for (int fi = 0; fi < 16; ++fi) {
        const int frame = wave * 16 + fi;
        const u32x4 zr = zrs[fi];
        float gv[8]; gv[0] = bflo(zr.x); gv[1] = bfhi(zr.x); gv[2] = bflo(zr.y); gv[3] = bfhi(zr.y); gv[4] = bflo(zr.z); gv[5] = bfhi(zr.z); gv[6] = bflo(zr.w); gv[7] = bfhi(zr.w);
        float s = 0.f;
#pragma unroll
        for (int k = 0; k < 8; ++k) { gv[k] = gelu_tanh(gv[k]); s += gv[k]; }
        const float mean = wave_sum(s) * (1.0f / 512.0f); float qv = 0.f;
#pragma unroll
        for (int k = 0; k < 8; ++k) { gv[k] -= mean; qv += gv[k] * gv[k]; }
        const float rstd = rsqrtf(wave_sum(qv) * (1.0f / 512.0f) + 1e-5f);
        if ((lane >> 4) == g) {
            const int cl = (lane & 15) * 8;
#pragma unroll
            for (int k = 0; k < 8; ++k) { const float o = gv[k] * rstd * lgv[k] + lbv[k]; vn[(cl + k) * 136 + frame] = (bf16_t)(pk2(o, 0.f) & 0xffffu); }
        }
    }
    __syncthreads();
    const int i = wave * 16 + fr; const int nks = (wave < 4) ? 2 : 4;
    f32x4 acc[8];
#pragma unroll
    for (int ct = 0; ct < 8; ++ct) acc[ct] = (f32x4){0.f, 0.f, 0.f, 0.f};
    for (int ks = 0; ks < nks; ++ks) {
        const float* wp = ws + (size_t)i * 128 + ks * 32 + fq * 8;
        const f32x4 w0 = *(const f32x4*)wp, w1 = *(const f32x4*)(wp + 4);
        u32x4 wy; wy.x = pk2(w0[0], w0[1]); wy.y = pk2(w0[2], w0[3]); wy.z = pk2(w1[0], w1[1]); wy.w = pk2(w1[2], w1[3]);
        const bf16x8 Y = __builtin_bit_cast(bf16x8, wy);
#pragma unroll
        for (int ct = 0; ct < 8; ++ct) {
            const bf16x8 X = *(const LAS bf16x8*)(vn + (ct * 16 + fr) * 136 + ks * 32 + fq * 8);
            acc[ct] = __builtin_amdgcn_mfma_f32_16x16x32_bf16(X, Y, acc[ct], 0, 0, 0);
        }
    }
    const size_t tok = tok0 + i; const float bsv = bs[i];
#pragma unroll
    for (int ct = 0; ct < 8; ++ct) {
        const int c = g * 128 + ct * 16 + fq * 4;
        const f32x4 uz = unpack4(*(const u32x2*)(z + tok * PE + c)); f32x4 o;
#pragma unroll
        for (int k = 0; k < 4; ++k) o[k] = gelu_tanh(uz[k]) * (acc[ct][k] + bsv);
        st8_wt(ymix + tok * DM + c, pack4(o));
    }
    __syncthreads();
}

__device__ __forceinline__ void prep_item(const Frame& F, int item, int e, const unsigned char* wb) {
    const int tok0 = item * 32, b = tok0 / SEQ, t0 = tok0 % SEQ, lane = F.lane, h = F.wave, fr = lane & 15, fq = lane >> 4, tid = F.tid;
    const bf16_t* z = (const bf16_t*)(F.ws + WS_ACT);
    bf16_t* ymix = (bf16_t*)(F.ws + WS_YMIX); bf16_t* sc = (bf16_t*)(F.ws + WS_SC); float* cb = (float*)(F.ws + WS_CB);
    const float* mu = inp<14>() + e * PB; const float* w0p = inp<15>() + e * 512; const float* a0p = inp<17>() + e * 512;
    const float* kkp = inp<20>() + e * 512; const float* kap = inp<21>() + e * 512; const float* rkp = inp<22>() + e * 512;
    LAS bf16_t* At = (LAS bf16_t*)F.lds;
    LAS float* PRM = (LAS float*)(F.lds + 32768);
    {
        PRM[0 * 512 + tid] = mu[tid]; PRM[1 * 512 + tid] = mu[512 + tid]; PRM[2 * 512 + tid] = mu[1024 + tid];
        PRM[3 * 512 + tid] = kkp[tid]; PRM[4 * 512 + tid] = kap[tid]; PRM[5 * 512 + tid] = rkp[tid];
        PRM[6 * 512 + tid] = w0p[tid]; PRM[7 * 512 + tid] = a0p[tid];
    }
    {
        const int token = tid >> 4, chunk = tid & 15, t = t0 + token; const size_t tok = tok0 + token;
        const bf16_t* zp = z + tok * PE + 2560 + chunk * 16;
        const u32x4 c0 = *(const u32x4*)zp, c1 = *(const u32x4*)(zp + 8);
        const bf16_t* zq = (t > 0) ? zp - PE : zp;
        u32x4 p0 = *(const u32x4*)zq, p1 = *(const u32x4*)(zq + 8);
        if (t == 0) { p0 = (u32x4){0u, 0u, 0u, 0u}; p1 = p0; }
        float cv[16], pv[16];
#pragma unroll
        for (int k = 0; k < 4; ++k) { cv[2 * k] = bflo(c0[k]); cv[2 * k + 1] = bfhi(c0[k]); cv[8 + 2 * k] = bflo(c1[k]); cv[9 + 2 * k] = bfhi(c1[k]);
                                      pv[2 * k] = bflo(p0[k]); pv[2 * k + 1] = bfhi(p0[k]); pv[8 + 2 * k] = bflo(p1[k]); pv[9 + 2 * k] = bfhi(p1[k]); }
        const f32x4* mup = (const f32x4*)(mu + 1536 + chunk * 16);
        const f32x4 m0 = mup[0], m1 = mup[1], m2 = mup[2], m3 = mup[3];
        const float mv_[16] = {m0[0], m0[1], m0[2], m0[3], m1[0], m1[1], m1[2], m1[3], m2[0], m2[1], m2[2], m2[3], m3[0], m3[1], m3[2], m3[3]};
#pragma unroll
        for (int k = 0; k < 16; ++k) cv[k] = cv[k] + mv_[k] * (pv[k] - cv[k]);
        if (chunk < 4) {
#pragma unroll
            for (int k = 0; k < 16; ++k) cv[k] = tanh_(cv[k]);
        } else if (chunk >= 8) {
#pragma unroll
            for (int k = 0; k < 16; ++k) cv[k] = sigmoidf_(cv[k]);
        }
        u32x4 o0, o1;
#pragma unroll
        for (int k = 0; k < 4; ++k) { o0[k] = pk2(cv[2 * k], cv[2 * k + 1]); o1[k] = pk2(cv[8 + 2 * k], cv[9 + 2 * k]); }
        *(LAS u32x4*)(At + token * 264 + chunk * 16) = o0; *(LAS u32x4*)(At + token * 264 + chunk * 16 + 8) = o1;
    }
    __syncthreads();
    const bf16_t* DUt = (const bf16_t*)(wb + WB_WX); const bf16_t* IUt = DUt + 512 * 64; const bf16_t* GUt = DUt + 2 * 512 * 64;
#pragma unroll
    for (int mt = 0; mt < 2; ++mt) {
        const LAS bf16_t* Ar = At + (mt * 16 + fr) * 264 + fq * 8;
        const int t = t0 + mt * 16 + fr; const size_t tok = tok0 + mt * 16 + fr; const bool hp = t > 0;
        f32x4 ev[4], av[4];
        {
            f32x4 acc[4];
#pragma unroll
            for (int nt = 0; nt < 4; ++nt) acc[nt] = (f32x4){0.f, 0.f, 0.f, 0.f};
#pragma unroll
            for (int ks = 0; ks < 2; ++ks) {
                const bf16x8 Yv = *(const LAS bf16x8*)(Ar + 0 + ks * 32);
#pragma unroll
                for (int nt = 0; nt < 4; ++nt) {
                    const bf16x8 X = *(const bf16x8*)(DUt + (size_t)(h * 64 + 32 * (nt >> 1) + 8 * (fr >> 2) + 4 * (nt & 1) + (fr & 3)) * 64 + ks * 32 + fq * 8);
                    acc[nt] = __builtin_amdgcn_mfma_f32_16x16x32_bf16(X, Yv, acc[nt], 0, 0, 0);
                }
            }
#pragma unroll
            for (int nt = 0; nt < 4; ++nt) {
                const f32x4 w0 = *(const LAS f32x4*)(PRM + 6 * 512 + h * 64 + 32 * (nt >> 1) + 8 * fq + 4 * (nt & 1));
#pragma unroll
                for (int k = 0; k < 4; ++k) ev[nt][k] = 0.6065306597126334f * __builtin_amdgcn_rcpf(1.0f + __expf(-(w0[k] + acc[nt][k])));
            }
        }
        {
            f32x4 acc[4];
#pragma unroll
            for (int nt = 0; nt < 4; ++nt) acc[nt] = (f32x4){0.f, 0.f, 0.f, 0.f};
#pragma unroll
            for (int ks = 0; ks < 2; ++ks) {
                const bf16x8 Yv = *(const LAS bf16x8*)(Ar + 64 + ks * 32);
#pragma unroll
                for (int nt = 0; nt < 4; ++nt) {
                    const bf16x8 X = *(const bf16x8*)(IUt + (size_t)(h * 64 + 32 * (nt >> 1) + 8 * (fr >> 2) + 4 * (nt & 1) + (fr & 3)) * 64 + ks * 32 + fq * 8);
                    acc[nt] = __builtin_amdgcn_mfma_f32_16x16x32_bf16(X, Yv, acc[nt], 0, 0, 0);
                }
            }
#pragma unroll
            for (int nt = 0; nt < 4; ++nt) {
                const f32x4 a0 = *(const LAS f32x4*)(PRM + 7 * 512 + h * 64 + 32 * (nt >> 1) + 8 * fq + 4 * (nt & 1));
#pragma unroll
                for (int k = 0; k < 4; ++k) av[nt][k] = sigmoidf_(a0[k] + acc[nt][k]);
            }
        }
        {
            f32x4 acc[4];
#pragma unroll
            for (int nt = 0; nt < 4; ++nt) acc[nt] = (f32x4){0.f, 0.f, 0.f, 0.f};
#pragma unroll
            for (int ks = 0; ks < 4; ++ks) {
                const bf16x8 Yv = *(const LAS bf16x8*)(Ar + 128 + ks * 32);
#pragma unroll
                for (int nt = 0; nt < 4; ++nt) {
                    const bf16x8 X = *(const bf16x8*)(GUt + (size_t)(h * 64 + 32 * (nt >> 1) + 8 * (fr >> 2) + 4 * (nt & 1) + (fr & 3)) * 128 + ks * 32 + fq * 8);
                    acc[nt] = __builtin_amdgcn_mfma_f32_16x16x32_bf16(X, Yv, acc[nt], 0, 0, 0);
                }
            }
#pragma unroll
            for (int a2 = 0; a2 < 2; ++a2) { const u32x2 p0 = pack4(acc[2 * a2]), p1 = pack4(acc[2 * a2 + 1]);
                st16_wt(ymix + tok * DM + 512 + h * 64 + 32 * a2 + 8 * fq, (u32x4){p0.x, p0.y, p1.x, p1.y}); }
        }
        f32x4 rv[4], kv[4], kk[4]; float ssq = 0.f;
        bf16_t* sp = sc + ((size_t)(b * 8 + h) * SEQ + t) * 384;
#define PK8(lo4, hi4) ({ const u32x2 p0_ = pack4(lo4), p1_ = pack4(hi4); (u32x4){p0_.x, p0_.y, p1_.x, p1_.y}; })
#pragma unroll
        for (int a2 = 0; a2 < 2; ++a2) {
            const int cl = 32 * a2 + 8 * fq, c = h * 64 + cl;
            const bf16_t* zp = z + tok * PE + 1024 + c;
            const u32x4 zr = *(const u32x4*)zp, zk = *(const u32x4*)(zp + 512), zv = *(const u32x4*)(zp + 1024);
            const bf16_t* zq = hp ? zp - PE : zp; const float hm = hp ? 1.0f : 0.0f;
            const u32x4 qr = *(const u32x4*)zq, qk = *(const u32x4*)(zq + 512), qv = *(const u32x4*)(zq + 1024);
            f32x4 vv[2];
#pragma unroll
            for (int hh = 0; hh < 2; ++hh) {
                const int nt = 2 * a2 + hh, c4 = c + 4 * hh;
                const f32x4 cr = unpack4(hh ? (u32x2){zr.z, zr.w} : (u32x2){zr.x, zr.y}), ck = unpack4(hh ? (u32x2){zk.z, zk.w} : (u32x2){zk.x, zk.y}), cvv = unpack4(hh ? (u32x2){zv.z, zv.w} : (u32x2){zv.x, zv.y});
                const f32x4 pr = unpack4(hh ? (u32x2){qr.z, qr.w} : (u32x2){qr.x, qr.y}) * hm, pk = unpack4(hh ? (u32x2){qk.z, qk.w} : (u32x2){qk.x, qk.y}) * hm, pvv = unpack4(hh ? (u32x2){qv.z, qv.w} : (u32x2){qv.x, qv.y}) * hm;
                const f32x4 mr = *(const LAS f32x4*)(PRM + c4), mk = *(const LAS f32x4*)(PRM + 512 + c4), mv = *(const LAS f32x4*)(PRM + 1024 + c4);
                rv[nt] = cr + mr * (pr - cr); kv[nt] = ck + mk * (pk - ck); vv[hh] = cvv + mv * (pvv - cvv);
                kk[nt] = kv[nt] * *(const LAS f32x4*)(PRM + 3 * 512 + c4);
                ssq += (kk[nt][0] * kk[nt][0] + kk[nt][1] * kk[nt][1]) + (kk[nt][2] * kk[nt][2] + kk[nt][3] * kk[nt][3]);
            }
            st16_wt(sp + 5 * 64 + cl, PK8(vv[0], vv[1]));
            st16_wt(sp + 4 * 64 + cl, PK8(rv[2 * a2], rv[2 * a2 + 1]));
            st16_wt(sp + 0 * 64 + cl, PK8(ev[2 * a2], ev[2 * a2 + 1]));
        }
        ssq += __shfl_xor(ssq, 16); ssq += __shfl_xor(ssq, 32);
        const float inv = 1.0f / fmaxf(sqrtf(ssq), 1e-12f);
        float cbp = 0.f;
#pragma unroll
        for (int a2 = 0; a2 < 2; ++a2) {
            const int cl = 32 * a2 + 8 * fq, c = h * 64 + cl;
            f32x4 kp[2], nk[2], nb[2];
#pragma unroll
            for (int hh = 0; hh < 2; ++hh) {
                const int nt = 2 * a2 + hh, c4 = c + 4 * hh;
                const f32x4 a = av[nt], kkn = kk[nt] * inv;
                const f32x4 ka = *(const LAS f32x4*)(PRM + 4 * 512 + c4), rk = *(const LAS f32x4*)(PRM + 5 * 512 + c4);
                kp[hh] = kv[nt] * (1.0f + (a - 1.0f) * ka);
                const f32x4 pr = rv[nt] * kp[hh] * rk; cbp += (pr[0] + pr[1]) + (pr[2] + pr[3]);
                nk[hh] = -kkn; nb[hh] = kkn * a;
            }
            st16_wt(sp + 1 * 64 + cl, PK8(kp[0], kp[1]));
            st16_wt(sp + 2 * 64 + cl, PK8(nk[0], nk[1]));
            st16_wt(sp + 3 * 64 + cl, PK8(nb[0], nb[1]));
        }
#undef PK8
        cbp += __shfl_xor(cbp, 16); cbp += __shfl_xor(cbp, 32);
        if (fq == 0) cb[tok * 8 + h] = cbp;
    }
    __syncthreads();
}

__device__ __forceinline__ void red16x2(float& a, float& b) {
    a += dpp_f<0x140>(a); b += dpp_f<0x140>(b);
    a += dpp_f<0x141>(a); b += dpp_f<0x141>(b);
    a += dpp_f<0xB1>(a);  b += dpp_f<0xB1>(b);
    a += dpp_f<0x4E>(a);  b += dpp_f<0x4E>(b);
}
__device__ __forceinline__ void red16x4(float& a, float& b, float& c, float& d) {
    a += dpp_f<0x140>(a); b += dpp_f<0x140>(b); c += dpp_f<0x140>(c); d += dpp_f<0x140>(d);
    a += dpp_f<0x141>(a); b += dpp_f<0x141>(b); c += dpp_f<0x141>(c); d += dpp_f<0x141>(d);
    a += dpp_f<0xB1>(a);  b += dpp_f<0xB1>(b);  c += dpp_f<0xB1>(c);  d += dpp_f<0xB1>(d);
    a += dpp_f<0x4E>(a);  b += dpp_f<0x4E>(b);  c += dpp_f<0x4E>(c);  d += dpp_f<0x4E>(d);
}
__device__ __forceinline__ void scan_item(const Frame& F, int item) {
    const int bh = item >> 2, rq = item & 3, b = bh >> 3, h = bh & 7, lane = F.lane, wave = F.wave;
    const bf16_t* sc = (const bf16_t*)(F.ws + WS_SC) + (size_t)bh * SEQ * 384;
    float* Y = (float*)(F.ws + WS_Y);
    LAS float* buf = (LAS float*)F.lds;
    constexpr int CH = 32, NP = CH / 2, PSTR = 712, CHF = NP * PSTR;
    const int ltid = F.tid - 256;
    const int lpair = ltid >> 4, lsub = ltid & 15;
    u32x2 raw0[6], raw1[6];
#define SCAN_GL(c) do { const bf16_t* src_ = sc + ((size_t)(c) * CH + 2 * lpair) * 384 + lsub * 4; \
        _Pragma("unroll") for (int p = 0; p < 6; ++p) { raw0[p] = *(const u32x2*)(src_ + p * 64); raw1[p] = *(const u32x2*)(src_ + 384 + p * 64); } } while (0)
#define SCAN_LW(bi) do { LAS float* pp_ = buf + (bi) * CHF + lpair * PSTR; LAS float* dst_ = pp_ + lsub * 4; \
        f32x4 e0_ = unpack4(raw0[0]), k0_ = unpack4(raw0[1]), a0_ = unpack4(raw0[2]), b0_ = unpack4(raw0[3]), r0_ = unpack4(raw0[4]), v0_ = unpack4(raw0[5]); \
        f32x4 e1_ = unpack4(raw1[0]), k1_ = unpack4(raw1[1]), a1_ = unpack4(raw1[2]), b1_ = unpack4(raw1[3]), r1_ = unpack4(raw1[4]), v1_ = unpack4(raw1[5]); \
        f32x4 w0_, w1_; _Pragma("unroll") for (int k = 0; k < 4; ++k) { w0_[k] = __expf(-e0_[k]); w1_[k] = __expf(-e1_[k]); } \
        const f32x4 ba_ = b0_ * a1_, ka_ = k0_ * a1_, br_ = b0_ * r0_, kr_ = k0_ * r0_; \
        float s0_ = (ba_[0] + ba_[1]) + (ba_[2] + ba_[3]), s1_ = (ka_[0] + ka_[1]) + (ka_[2] + ka_[3]), s2_ = (br_[0] + br_[1]) + (br_[2] + br_[3]), s3_ = (kr_[0] + kr_[1]) + (kr_[2] + kr_[3]); \
        red16x4(s0_, s1_, s2_, s3_); \
        *(LAS f32x4*)(dst_) = a0_; *(LAS f32x4*)(dst_ + 64) = w0_ * a1_; *(LAS f32x4*)(dst_ + 128) = w0_ * r0_; *(LAS f32x4*)(dst_ + 192) = r1_; \
        *(LAS f32x4*)(dst_ + 256) = w0_ * w1_; *(LAS f32x4*)(dst_ + 320) = b0_ * w1_; *(LAS f32x4*)(dst_ + 384) = k0_ * w1_; *(LAS f32x4*)(dst_ + 448) = b1_; \
        *(LAS f32x4*)(dst_ + 512) = k1_; *(LAS f32x4*)(dst_ + 576) = v0_; *(LAS f32x4*)(dst_ + 640) = v1_; \
        if (lsub == 0) *(LAS f32x4*)(pp_ + 704) = (f32x4){s0_, s1_, s2_, s3_}; } while (0)
    if (wave >= 4) { SCAN_GL(0); SCAN_LW(0); SCAN_GL(1); }
    __syncthreads();
    const int l16 = lane & 15, rl = wave * 4 + (lane >> 4), row = rq * 16 + rl, c4 = l16 * 4;
    f32x2 s01 = (f32x2){0.f, 0.f}, s23 = s01;
    f32x4 rprev = (f32x4){0.f, 0.f, 0.f, 0.f};
    float ykeep = 0.f;
    LAS float* ybuf = buf + 2 * CHF;
    LAS float* ywr = ybuf + l16 * 16 + rl;
    float* yflush = Y + ((size_t)b * SEQ + (ltid >> 2)) * 512 + h * 64 + rq * 16 + (ltid & 3) * 4;
#define SCAN_FLUSH(f) do { if (ltid < 128) { const f32x4 yv_ = *(const LAS f32x4*)(ybuf + ((f) & 3) * 512 + (ltid >> 2) * 16 + (ltid & 3) * 4); st16_wt(yflush + (size_t)(f) * 32 * 512, __builtin_bit_cast(u32x4, yv_)); } } while (0)
#define DOT4(x) ({ f32x2 p_ = s01 * (f32x2){(x)[0], (x)[1]}; p_ = __builtin_elementwise_fma(s23, (f32x2){(x)[2], (x)[3]}, p_); p_[0] + p_[1]; })
#define LDP(P, q) const f32x4 P##a = *(const LAS f32x4*)((q) + c4), P##wa = *(const LAS f32x4*)((q) + 64 + c4), P##wr = *(const LAS f32x4*)((q) + 128 + c4), P##r1 = *(const LAS f32x4*)((q) + 192 + c4), \
        P##ww = *(const LAS f32x4*)((q) + 256 + c4), P##bw = *(const LAS f32x4*)((q) + 320 + c4), P##kw = *(const LAS f32x4*)((q) + 384 + c4), P##b1 = *(const LAS f32x4*)((q) + 448 + c4), \
        P##k1 = *(const LAS f32x4*)((q) + 512 + c4), P##sc = *(const LAS f32x4*)((q) + 704); const float P##v0 = (q)[576 + row], P##v1 = (q)[640 + row]
    for (int c = 0; c < SEQ / CH; ++c) {
        if (wave >= 4) { if (c + 1 < SEQ / CH) { SCAN_LW((c + 1) & 1); if (c + 2 < SEQ / CH) SCAN_GL(c + 2); } if (c >= 2) SCAN_FLUSH(c - 2); }
        else {
            const LAS float* bp = buf + (c & 1) * CHF;
            f32x4 Ca, Cwa, Cwr, Cr1, Cww, Cbw, Ckw, Cb1, Ck1, Csc; float Cv0, Cv1;
            { LDP(T, bp); Ca = Ta; Cwa = Twa; Cwr = Twr; Cr1 = Tr1; Cww = Tww; Cbw = Tbw; Ckw = Tkw; Cb1 = Tb1; Ck1 = Tk1; Csc = Tsc; Cv0 = Tv0; Cv1 = Tv1; }
#pragma unroll 1
            for (int hb = 0; hb < 2; ++hb) {
#pragma unroll
                for (int i = 0; i < 8; ++i) {
                    const int p = hb * 8 + i;
                    const LAS float* qn = bp + ((p + 1 < NP) ? (p + 1) : (NP - 1)) * PSTR;
                    LDP(N, qn);
                    float d0 = DOT4(rprev), d1 = DOT4(Ca), d2 = DOT4(Cwa), d3 = DOT4(Cwr);
                    red16x4(d0, d1, d2, d3);
                    ykeep = (l16 == ((2 * i + 15) & 15)) ? d0 : ykeep;
                    if (i == 0) { const int blk = 2 * c + hb - 1; if (blk >= 0) ywr[((blk >> 1) & 3) * 512 + (blk & 1) * 256] = ykeep; }
                    const float sa0 = d1;
                    const float yt = __builtin_fmaf(sa0, Csc[2], __builtin_fmaf(Cv0, Csc[3], d3));
                    ykeep = (l16 == (2 * i)) ? yt : ykeep;
                    const float sa1 = __builtin_fmaf(sa0, Csc[0], __builtin_fmaf(Cv0, Csc[1], d2));
                    const f32x2 a0v = (f32x2){sa0, sa0}, a1v = (f32x2){sa1, sa1}, v0v = (f32x2){Cv0, Cv0}, v1v = (f32x2){Cv1, Cv1};
                    f32x2 t01 = (f32x2){Ckw[0], Ckw[1]} * v0v, t23 = (f32x2){Ckw[2], Ckw[3]} * v0v;
                    t01 = __builtin_elementwise_fma((f32x2){Cbw[0], Cbw[1]}, a0v, t01); t23 = __builtin_elementwise_fma((f32x2){Cbw[2], Cbw[3]}, a0v, t23);
                    t01 = __builtin_elementwise_fma((f32x2){Ck1[0], Ck1[1]}, v1v, t01); t23 = __builtin_elementwise_fma((f32x2){Ck1[2], Ck1[3]}, v1v, t23);
                    t01 = __builtin_elementwise_fma((f32x2){Cb1[0], Cb1[1]}, a1v, t01); t23 = __builtin_elementwise_fma((f32x2){Cb1[2], Cb1[3]}, a1v, t23);
                    s01 = __builtin_elementwise_fma(s01, (f32x2){Cww[0], Cww[1]}, t01); s23 = __builtin_elementwise_fma(s23, (f32x2){Cww[2], Cww[3]}, t23);
                    rprev = Cr1;
                    Ca = Na; Cwa = Nwa; Cwr = Nwr; Cr1 = Nr1; Cww = Nww; Cbw = Nbw; Ckw = Nkw; Cb1 = Nb1; Ck1 = Nk1; Csc = Nsc; Cv0 = Nv0; Cv1 = Nv1;
                }
            }
        }
        __syncthreads();
    }
    if (wave < 4) {
        float d0 = DOT4(rprev), z1 = 0.f, z2 = 0.f, z3 = 0.f; red16x4(d0, z1, z2, z3);
        ykeep = (l16 == 15) ? d0 : ykeep;
        ywr[3 * 512 + 256] = ykeep;
    }
    __syncthreads();
    if (wave >= 4) { SCAN_FLUSH(SEQ / CH - 2); SCAN_FLUSH(SEQ / CH - 1); }
    __syncthreads();
#undef SCAN_FLUSH
#undef SCAN_GL
#undef SCAN_LW
#undef DOT4
#undef LDP
}
__device__ __forceinline__ void post_rows(const Frame& F, int e) {
    const float* Y = (const float*)(F.ws + WS_Y); const bf16_t* sc = (const bf16_t*)(F.ws + WS_SC); const float* cb = (const float*)(F.ws + WS_CB);
    bf16_t* ymix = (bf16_t*)(F.ws + WS_YMIX);
    const float* lg = inp<23>() + e * 512; const float* lb = inp<24>() + e * 512;
    const int lane = F.lane, hh = lane >> 3;
    for (int tl = (F.bid >> 3) * 8 + F.wave; tl < SEQ; tl += F.G) {
        const int tok = (F.bid & 7) * SEQ + tl;
        const int b = tok / SEQ, t = tok % SEQ;
        const f32x4 y0 = *(const f32x4*)(Y + (size_t)tok * 512 + lane * 8), y1 = *(const f32x4*)(Y + (size_t)tok * 512 + lane * 8 + 4);
        float yv[8] = {y0[0], y0[1], y0[2], y0[3], y1[0], y1[1], y1[2], y1[3]};
        float s = 0.f;
#pragma unroll
        for (int k = 0; k < 8; ++k) s += yv[k];
        s += __shfl_xor(s, 1); s += __shfl_xor(s, 2); s += __shfl_xor(s, 4);
        const float mean = s * (1.0f / 64.0f); float qv = 0.f;
#pragma unroll
        for (int k = 0; k < 8; ++k) { yv[k] -= mean; qv += yv[k] * yv[k]; }
        qv += __shfl_xor(qv, 1); qv += __shfl_xor(qv, 2); qv += __shfl_xor(qv, 4);
        const float rstd = rsqrtf(qv * (1.0f / 64.0f) + 64e-5f);
        const u32x4 vr = *(const u32x4*)(sc + ((size_t)(b * 8 + hh) * SEQ + t) * 384 + 5 * 64 + (lane & 7) * 8);
        bf16_t* gp = ymix + (size_t)tok * DM + 512 + lane * 8;
        const u32x4 gr = *(const u32x4*)gp;
        const float cbv = cb[(size_t)tok * 8 + hh];
        float vv[8] = {bflo(vr.x), bfhi(vr.x), bflo(vr.y), bfhi(vr.y), bflo(vr.z), bfhi(vr.z), bflo(vr.w), bfhi(vr.w)};
        float gg[8] = {bflo(gr.x), bfhi(gr.x), bflo(gr.y), bfhi(gr.y), bflo(gr.z), bfhi(gr.z), bflo(gr.w), bfhi(gr.w)};
        float o[8];
#pragma unroll
        for (int k = 0; k < 8; ++k) o[k] = (yv[k] * rstd * lg[lane * 8 + k] + lb[lane * 8 + k] + cbv * vv[k]) * gg[k];
        u32x4 ow; ow.x = pk2(o[0], o[1]); ow.y = pk2(o[2], o[3]); ow.z = pk2(o[4], o[5]); ow.w = pk2(o[6], o[7]);
        st16_wt(gp, ow);
    }
}

__device__ __forceinline__ void conv_item(const Frame& F, int item, int o) {
    const int b = item >> 6, tt = item & 63, t0 = tt * 32, c = F.tid, lane = F.lane, wave = F.wave;
    const bf16_t* z = (const bf16_t*)(F.ws + WS_ACT);
    bf16_t* ymix = (bf16_t*)(F.ws + WS_YMIX);
    const float* cw = inp<31>() + (size_t)o * 31 * 512; const float* cbias = inp<32>() + o * 512;
    const float* lg = inp<33>() + o * 512; const float* lb = inp<34>() + o * 512;
    LAS float* co = (LAS float*)F.lds;
    const size_t tokb = (size_t)b * SEQ;
    float hv[62];
#pragma unroll
    for (int i = 0; i < 62; ++i) {
        const int t = t0 - 30 + i; float hval = 0.f;
        if (t >= 0) { const bf16_t* zp = z + (tokb + t) * POP + 416 + c; const float za = bf1(zp[0]), zg = bf1(zp[512]); hval = za * sigmoidf_(zg); }
        hv[i] = hval;
    }
    float wv[31];
#pragma unroll
    for (int k = 0; k < 31; ++k) wv[k] = cw[k * 512 + c];
    const float bias = cbias[c];
#pragma unroll
    for (int i = 0; i < 32; ++i) {
        float a = bias;
#pragma unroll
        for (int k = 0; k < 31; ++k) a += wv[k] * hv[i + k];
        co[i * 512 + c] = a;
    }
    {
        const int token = F.tid >> 4, i = F.tid & 15, t = t0 + token;
        const bf16_t* zp = z + (tokb + t) * POP + 384;
        const float x1 = bf1(zp[i]), x2 = bf1(zp[16 + i]);
        const float cs = ((const float*)(F.ws + WS_COS))[t * 16 + i], sn = ((const float*)(F.ws + WS_SIN))[t * 16 + i];
        bf16_t* kr = (bf16_t*)(F.ws + WS_SC + SC_KR) + (tokb + t) * 32;
        const int kp_ = 8 * (i >> 2) + (i & 3);
        kr[kp_] = (bf16_t)(pk2(x1 * cs - x2 * sn, 0.f) & 0xffffu); kr[kp_ + 4] = (bf16_t)(pk2(x1 * sn + x2 * cs, 0.f) & 0xffffu);
    }
    __syncthreads();
#pragma unroll
    for (int j = 0; j < 4; ++j) {
        const int ti = wave * 4 + j;
        const f32x4 v0 = *(const LAS f32x4*)(co + ti * 512 + lane * 8), v1 = *(const LAS f32x4*)(co + ti * 512 + lane * 8 + 4);
        float v[8] = {v0[0], v0[1], v0[2], v0[3], v1[0], v1[1], v1[2], v1[3]};
        float s = 0.f;
#pragma unroll
        for (int k = 0; k < 8; ++k) s += v[k];
        const float mean = wave_sum(s) * (1.0f / 512.0f); float qv = 0.f;
#pragma unroll
        for (int k = 0; k < 8; ++k) { v[k] -= mean; qv += v[k] * v[k]; }
        const float rstd = rsqrtf(wave_sum(qv) * (1.0f / 512.0f) + 1e-5f);
        float ov[8];
#pragma unroll
        for (int k = 0; k < 8; ++k) { const float y = v[k] * rstd * lg[lane * 8 + k] + lb[lane * 8 + k]; ov[k] = y * sigmoidf_(y); }
        u32x4 ow; ow.x = pk2(ov[0], ov[1]); ow.y = pk2(ov[2], ov[3]); ow.z = pk2(ov[4], ov[5]); ow.w = pk2(ov[6], ov[7]);
        st16_wt(ymix + (tokb + t0 + ti) * DM + 512 + lane * 8, ow);
    }
    __syncthreads();
}

constexpr int AT_KS = 104, AT_VS = 80, AT_KB = 64 * AT_KS * 2, AT_VB = 64 * AT_VS * 2, AT_BUF = AT_KB + AT_VB;
typedef short v4i16_t __attribute__((ext_vector_type(4)));
__device__ __forceinline__ void attn_unit(const Frame& F, int b, int h, int qb) {
    const int lane = F.lane, wave = F.wave, tid = F.tid, fr = lane & 15, fq = lane >> 4;
    const bf16_t* Q = (const bf16_t*)(F.ws + WS_SC + SC_Q); const bf16_t* KV = (const bf16_t*)(F.ws + WS_SC + SC_KV); const bf16_t* KR = (const bf16_t*)(F.ws + WS_SC + SC_KR);
    bf16_t* ymix = (bf16_t*)(F.ws + WS_YMIX);
    const size_t tokb = (size_t)b * SEQ;
    const int q0 = qb * 256 + wave * 32;
    const int ntb = 4 * qb + 4, ntw = 4 * qb + 1 + (wave >> 1);
    bf16x8 qf[2][3];
#pragma unroll
    for (int mt = 0; mt < 2; ++mt)
#pragma unroll
        for (int ks = 0; ks < 3; ++ks) qf[mt][ks] = *(const bf16x8*)(Q + (tokb + q0 + mt * 16 + fr) * 768 + h * 96 + ks * 32 + fq * 8);
    const int key0 = tid / 12, ch0 = tid % 12, key1 = (tid + 512) / 12, ch1 = (tid + 512) % 12;
    const bool has1 = tid < 256;
    const int vkey = tid >> 3, vch = tid & 7;
    const bf16_t* ksrc0 = (ch0 < 8) ? KV + (tokb + key0) * 1024 + h * 128 + ch0 * 8 : KR + (tokb + key0) * 32 + (ch0 - 8) * 8;
    const bf16_t* ksrc1 = (ch1 < 8) ? KV + (tokb + key1) * 1024 + h * 128 + ch1 * 8 : KR + (tokb + key1) * 32 + (ch1 - 8) * 8;
    const int kstr0 = (ch0 < 8) ? 64 * 1024 : 64 * 32, kstr1 = (ch1 < 8) ? 64 * 1024 : 64 * 32;
    const bf16_t* vsrc = KV + (tokb + vkey) * 1024 + h * 128 + 64 + vch * 8;
    const unsigned kdst0 = key0 * (AT_KS * 2) + ch0 * 16, kdst1 = key1 * (AT_KS * 2) + ch1 * 16;
    u32x4 rk0[2], rk1[2], rv[2];
#pragma unroll
    for (int k = 0; k < 2; ++k) { rk0[k] = (u32x4){0u, 0u, 0u, 0u}; rk1[k] = rk0[k]; rv[k] = rk0[k]; }
#define AT_GLOAD(j, st) do { rk0[st] = *(const u32x4*)(ksrc0 + (size_t)(j) * kstr0); if (has1) rk1[st] = *(const u32x4*)(ksrc1 + (size_t)(j) * kstr1); rv[st] = *(const u32x4*)(vsrc + (size_t)(j) * 64 * 1024); } while (0)
#define AT_LSTORE(bi, st) do { LAS unsigned char* kb_ = F.lds + (bi) * AT_BUF; LAS bf16_t* vb_ = (LAS bf16_t*)(kb_ + AT_KB); \
        *(LAS u32x4*)(kb_ + kdst0) = rk0[st]; if (has1) *(LAS u32x4*)(kb_ + kdst1) = rk1[st]; \
        *(LAS u32x4*)(vb_ + vkey * AT_VS + vch * 8) = rv[st]; } while (0)
    f32x4 o[2][4];
#pragma unroll
    for (int mt = 0; mt < 2; ++mt)
#pragma unroll
        for (int dt = 0; dt < 4; ++dt) o[mt][dt] = (f32x4){0.f, 0.f, 0.f, 0.f};
    float mrun[2] = {-INFINITY, -INFINITY}, lsum[2] = {0.f, 0.f};
#pragma unroll
    for (int k = 0; k < 2; ++k) AT_GLOAD(k, k);
    for (int j0 = 0; j0 < ntb; j0 += 2) {
#pragma unroll
      for (int kk = 0; kk < 2; ++kk) {
        const int j = j0 + kk;
        AT_LSTORE(j & 1, kk);
        __syncthreads();
        if (j + 2 < ntb) AT_GLOAD(j + 2, kk);
        if (j < ntw) {
            const LAS unsigned char* kb = F.lds + (j & 1) * AT_BUF; const LAS bf16_t* vb = (const LAS bf16_t*)(kb + AT_KB);
            f32x4 st[2][4];
#pragma unroll
            for (int kt = 0; kt < 4; ++kt) {
                st[0][kt] = (f32x4){0.f, 0.f, 0.f, 0.f}; st[1][kt] = st[0][kt];
#pragma unroll
                for (int ks = 0; ks < 3; ++ks) {
                    const bf16x8 X = *(const LAS bf16x8*)(kb + (kt * 16 + fr) * (AT_KS * 2) + (ks * 32 + fq * 8) * 2);
                    st[0][kt] = __builtin_amdgcn_mfma_f32_16x16x32_bf16(X, qf[0][ks], st[0][kt], 0, 0, 0);
                    st[1][kt] = __builtin_amdgcn_mfma_f32_16x16x32_bf16(X, qf[1][ks], st[1][kt], 0, 0, 0);
                }
            }
            bf16x8 Yp[2][2];
#pragma unroll
            for (int mt = 0; mt < 2; ++mt) {
                float mx = fmaxf(fmaxf(st[mt][0][0], st[mt][0][1]), fmaxf(st[mt][0][2], st[mt][0][3]));
#pragma unroll
                for (int kt = 1; kt < 4; ++kt) mx = fmaxf(mx, fmaxf(fmaxf(st[mt][kt][0], st[mt][kt][1]), fmaxf(st[mt][kt][2], st[mt][kt][3])));
                mx = fmaxf(mx, __shfl_xor(mx, 16)); mx = fmaxf(mx, __shfl_xor(mx, 32));
                const float mnew = fmaxf(mrun[mt], mx), alpha = __builtin_amdgcn_exp2f(mrun[mt] - mnew);
                mrun[mt] = mnew;
                float ps = 0.f;
#pragma unroll
                for (int kt = 0; kt < 4; ++kt)
#pragma unroll
                    for (int k = 0; k < 4; ++k) { st[mt][kt][k] = __builtin_amdgcn_exp2f(st[mt][kt][k] - mnew); ps += st[mt][kt][k]; }
                lsum[mt] = lsum[mt] * alpha + ps;
#pragma unroll
                for (int dt = 0; dt < 4; ++dt) o[mt][dt] = o[mt][dt] * alpha;
#pragma unroll
                for (int g2 = 0; g2 < 2; ++g2) {
                    u32x4 pw; pw.x = pk2(st[mt][2 * g2][0], st[mt][2 * g2][1]); pw.y = pk2(st[mt][2 * g2][2], st[mt][2 * g2][3]); pw.z = pk2(st[mt][2 * g2 + 1][0], st[mt][2 * g2 + 1][1]); pw.w = pk2(st[mt][2 * g2 + 1][2], st[mt][2 * g2 + 1][3]);
                    Yp[mt][g2] = __builtin_bit_cast(bf16x8, pw);
                }
            }
#pragma unroll
            for (int g2 = 0; g2 < 2; ++g2)
#pragma unroll
                for (int dt = 0; dt < 4; ++dt) {
                    const LAS bf16_t* vp = vb + (g2 * 32 + fq * 4 + (fr >> 2)) * AT_VS + 32 * (dt >> 1) + 8 * (fr & 3) + 4 * (dt & 1);
                    const v4i16_t lo = __builtin_amdgcn_ds_read_tr16_b64_v4i16((LAS v4i16_t*)vp), hi = __builtin_amdgcn_ds_read_tr16_b64_v4i16((LAS v4i16_t*)(vp + 16 * AT_VS));
                    const bf16x8 Xv = (bf16x8){lo[0], lo[1], lo[2], lo[3], hi[0], hi[1], hi[2], hi[3]};
                    o[0][dt] = __builtin_amdgcn_mfma_f32_16x16x32_bf16(Xv, Yp[0][g2], o[0][dt], 0, 0, 0);
                    o[1][dt] = __builtin_amdgcn_mfma_f32_16x16x32_bf16(Xv, Yp[1][g2], o[1][dt], 0, 0, 0);
                }
        }
      }
    }
#undef AT_GLOAD
#undef AT_LSTORE
#pragma unroll
    for (int mt = 0; mt < 2; ++mt) {
        float ls = lsum[mt]; ls += __shfl_xor(ls, 16); ls += __shfl_xor(ls, 32);
        const float il = 1.0f / ls;
#pragma unroll
        for (int a2 = 0; a2 < 2; ++a2) { const u32x2 p0 = pack4(o[mt][2 * a2] * il), p1 = pack4(o[mt][2 * a2 + 1] * il);
            st16_wt(ymix + (tokb + q0 + mt * 16 + fr) * DM + h * 64 + 32 * a2 + 8 * fq, (u32x4){p0.x, p0.y, p1.x, p1.y}); }
    }
    __syncthreads();
}

constexpr int NPHASE = 1 + 9 * DEPTH + 1;
__global__ void __launch_bounds__(512, 2) mk_fwd(Args args) {
    extern __shared__ __attribute__((aligned(16))) unsigned char lds_raw[];
    Frame F;
    F.lds = (LAS unsigned char*)lds_raw;
    F.tid = threadIdx.x; F.lane = F.tid & 63; F.wave = __builtin_amdgcn_readfirstlane(F.tid >> 6);
    F.G = gridDim.x; F.bid = blockIdx.x; F.out = args.out; F.ws = args.ws;
    const int lo = args.ph_lo, hi = args.ph_hi;
    cg::grid_group grid = cg::this_grid();
    volatile LAS unsigned* bst = (volatile LAS unsigned*)(F.lds + 135168);
    if (threadIdx.x < 8) bst[threadIdx.x] = 0u;
    __syncthreads();
    XcdBarrier xbar = xcd_barrier_post((unsigned*)args.ws, bst);
    int vbid = blockIdx.x; bool regular = false;
#define IN(k) (lo <= (k) && (k) < hi)
#define ENTER() do { int t_ = threadIdx.x; int b_ = vbid; asm volatile("" : "+v"(t_), "+s"(b_)); F.tid = t_; F.lane = t_ & 63; F.wave = __builtin_amdgcn_readfirstlane(t_ >> 6); F.bid = b_; } while (0)
#define SEAM(k) do { if (IN(k) && IN((k) + 1)) { if (regular && (k) != 0 && (((k) - 1) % 9) != 8) xcd_local_barrier(xbar); else xcd_barrier(xbar); } } while (0)

    if (lo > hi) grid.sync();
    if (IN(0)) { ENTER(); { convert_layer(F, 0, 0, 1, F.bid, F.G); x_prologue(F); } }
    SEAM(0);
    if (IN(0) && IN(1)) {
        const unsigned reg_ = bst[2], rank_ = bst[3];
        regular = __builtin_amdgcn_readfirstlane((int)reg_) != 0;
        if (regular) vbid = __builtin_amdgcn_readfirstlane((int)(rank_ * 8u + xbar.x));
    }
    for (int l = 0; l < DEPTH; ++l) {
        const int p0 = 1 + 9 * l; const bool odd = l & 1; const int hl = l >> 1;
        size_t z0 = 0; asm volatile("" : "+s"(z0));
        unsigned char* ws = args.ws + z0;
        F.ws = ws;
        float* ssq = (float*)(ws + WS_SSQ);
        bf16_t* xb = (bf16_t*)(ws + WS_XB); bf16_t* ymix = (bf16_t*)(ws + WS_YMIX); bf16_t* act = (bf16_t*)(ws + WS_ACT);
        const unsigned char* wb = ws + WS_WBUF0 + (size_t)(l & 1) * WBUF_BYTES;
        if (IN(p0 + 0)) {
            ENTER();
            pg8::Gemm g{xb, (const bf16_t*)(wb + WB_W1IN), T, 2 * FF, DM, DM, DM}; pg8::StaticOrder S; S.init(T, 2 * FF, F.G, F.bid);
            EpiSwiGLU E{act, ssq}; pg8::gemm_phase(F.lds, g, S, E);
            ENTER();
            if (l + 1 < DEPTH) {
                const int nfull = ((T / 256) * (2 * FF / 256)) % F.G;
                if (nfull == 0) { __syncthreads(); convert_layer(F, l + 1, 0, 2, F.bid, F.G); }
                else if (F.bid >= nfull) { __syncthreads(); convert_layer(F, l + 1, 0, 2, F.bid - nfull, F.G - nfull); }
            }
        }
        SEAM(p0 + 0);
        if (IN(p0 + 1)) {
            ENTER();
            pg8::Gemm g{act, (const bf16_t*)(wb + WB_W1OUT), T, DM, FF, FF, FF}; pg8::StaticOrder S; S.init(T, DM, F.G, F.bid);
            EpiResid E{xb, ssq, 0.5f}; pg8::gemm_phase(F.lds, g, S, E);
        }
        SEAM(p0 + 1);
        if (IN(p0 + 2)) {
            ENTER();
            if (odd) { pg8::Gemm g{xb, (const bf16_t*)(wb + WB_WMIN), T, POP, DM, DM, DM}; pg8::StaticOrder S; S.init(T, POP, F.G, F.bid);
                EpiZ<true> E{act, POP, ssq, (float*)(ws + WS_PQ), (float*)(ws + WS_PKV)}; pg8::gemm_phase(F.lds, g, S, E); }
            else { pg8::Gemm g{xb, (const bf16_t*)(wb + WB_WMIN), T, PE, DM, DM, DM}; pg8::StaticOrder S; S.init(T, PE, F.G, F.bid);
                EpiZ<false> E{act, PE, ssq, nullptr, nullptr}; pg8::gemm_phase(F.lds, g, S, E); }
        }
        SEAM(p0 + 2);
        if (IN(p0 + 3)) {
            ENTER();
            if (odd) {
                pg8::Gemm g{act, (const bf16_t*)(wb + WB_WX), T, 1792, 384, POP, 384}; pg8::StaticOrder S; S.init(T, 1792, F.G, F.bid);
                EpiUp E{(bf16_t*)(ws + WS_SC + SC_Q), (bf16_t*)(ws + WS_SC + SC_KV), (const float*)(ws + WS_PQ), (const float*)(ws + WS_PKV), (const float*)(ws + WS_COS), (const float*)(ws + WS_SIN)};
                pg8::gemm_phase(F.lds, g, S, E);
                __syncthreads();
                ENTER();
                for (int j = F.bid >> 3; j < 64; j += F.G >> 3) conv_item(F, (F.bid & 7) * 64 + j, hl);
            } else {
                for (int j = F.bid >> 3; j < 64; j += F.G >> 3) prep_item(F, (F.bid & 7) * 64 + j, hl, wb);
                for (int j = F.bid >> 3; j < 64; j += F.G >> 3) gsu_item(F, (F.bid & 7) * 64 + j, hl);
            }
        }
        SEAM(p0 + 3);
        if (IN(p0 + 4)) {
            ENTER();
            if (odd) {
                for (int j = F.bid >> 3; j < 32; j += F.G >> 3) {
                    const int bh = (F.bid & 7) * 8 + (j & 7), pr = j >> 3;
                    attn_unit(F, bh >> 3, bh & 7, pr);
                    attn_unit(F, bh >> 3, bh & 7, 7 - pr);
                }
            } else {
                for (int j = F.bid >> 3; j < 32; j += F.G >> 3) scan_item(F, (F.bid & 7) * 32 + j);
            }
        }
        SEAM(p0 + 4);
        if (IN(p0 + 5)) { ENTER(); if (!odd) post_rows(F, hl); }
        if (!odd) SEAM(p0 + 5);
        if (IN(p0 + 6)) {
            ENTER();
            pg8::Gemm g{ymix, (const bf16_t*)(wb + WB_WMOUT), T, DM, DM, DM, DM}; pg8::StaticOrder S; S.init(T, DM, F.G, F.bid);
            EpiResid E{xb, ssq, 1.0f}; pg8::gemm_phase(F.lds, g, S, E);
        }
        SEAM(p0 + 6);
        if (IN(p0 + 7)) {
            ENTER();
            pg8::Gemm g{xb, (const bf16_t*)(wb + WB_W2IN), T, 2 * FF, DM, DM, DM}; pg8::StaticOrder S; S.init(T, 2 * FF, F.G, F.bid);
            EpiSwiGLU E{act, ssq}; pg8::gemm_phase(F.lds, g, S, E);
            ENTER();
            if (l + 1 < DEPTH) {
                const int nfull = ((T / 256) * (2 * FF / 256)) % F.G;
                if (nfull == 0) { __syncthreads(); convert_layer(F, l + 1, 1, 2, F.bid, F.G); }
                else if (F.bid >= nfull) { __syncthreads(); convert_layer(F, l + 1, 1, 2, F.bid - nfull, F.G - nfull); }
            }
        }
        SEAM(p0 + 7);
        if (IN(p0 + 8)) {
            ENTER();
            pg8::Gemm g{act, (const bf16_t*)(wb + WB_W2OUT), T, DM, FF, FF, FF}; pg8::StaticOrder S; S.init(T, DM, F.G, F.bid);
            EpiResid E{xb, ssq, 0.5f}; pg8::gemm_phase(F.lds, g, S, E);
        }
        SEAM(p0 + 8);
    }
    if (IN(NPHASE - 1)) { ENTER(); final_norm(F); }
#undef IN
#undef SEAM
#undef ENTER
}

extern "C" void kernel_launch(void* const* d_in, const int* in_sizes, int n_in, void* d_out, int out_size, void* d_ws, size_t ws_size, hipStream_t stream) {
    static int grid = 0;
    if (grid == 0) {
        if (n_in != 36 || out_size != T * DM || ws_size < WS_END) { fprintf(stderr, "kernel_launch: unexpected shapes (n_in %d out %d ws %zu)\n", n_in, out_size, ws_size); grid = -1; return; }
        int dev = 0, cus = 0, per_cu = 0;
        (void)hipGetDevice(&dev); (void)hipDeviceGetAttribute(&cus, hipDeviceAttributeMultiprocessorCount, dev);
        (void)hipFuncSetAttribute((const void*)mk_fwd, hipFuncAttributeMaxDynamicSharedMemorySize, LDS_BYTES);
        (void)hipOccupancyMaxActiveBlocksPerMultiprocessor(&per_cu, (const void*)mk_fwd, 512, LDS_BYTES);
        if (per_cu < 1) per_cu = 1;
        grid = cus * per_cu; if (grid > 256) grid = 256; if (grid < 1) grid = 256;
        (void)hipGetLastError();
    }
    if (grid < 0) return;
    (void)hipMemsetAsync(d_ws, 0, 32768, stream);
    Args a{};
    for (int i = 0; i < 36; ++i) a.in[i] = (const float*)d_in[i];
    a.out = (float*)d_out; a.ws = (unsigned char*)d_ws;
#if MK_MULTI
    for (int p = 0; p < NPHASE; ++p) {
        if (p >= 1 && p < NPHASE - 1) { const int l = (p - 1) / 9, k = (p - 1) % 9; if ((l & 1) && k == 5) continue; }
        a.ph_lo = p; a.ph_hi = p + 1;
        hipLaunchKernelGGL(mk_fwd, dim3(grid), dim3(512), LDS_BYTES, stream, a);
    }
#else
    a.ph_lo = 0; a.ph_hi = NPHASE;
    void* kargs[] = {&a};
    hipError_t e = hipLaunchCooperativeKernel((const void*)mk_fwd, dim3(grid), dim3(512), kargs, LDS_BYTES, stream);
    if (e != hipSuccess) fprintf(stderr, "cooperative launch failed: %s (grid %d)\n", hipGetErrorString(e), grid);
#endif
}
```

```cpp
#include <hip/hip_runtime.h>
#include <hip/hip_cooperative_groups.h>
#include <cstdio>
#include <cstdint>
namespace cg = cooperative_groups;

#ifndef MK_MULTI
#define MK_MULTI 0
#endif

#define LAS __attribute__((address_space(3)))
typedef unsigned short bf16_t;
typedef short bf16x8 __attribute__((ext_vector_type(8)));
typedef float f32x4 __attribute__((ext_vector_type(4)));
typedef float f32x2 __attribute__((ext_vector_type(2)));
typedef unsigned u32x4 __attribute__((ext_vector_type(4)));
typedef unsigned u32x2 __attribute__((ext_vector_type(2)));
typedef __bf16 bf16x2_t __attribute__((ext_vector_type(2)));

constexpr int T = 16384, DM = 1024, FF = 2816, SEQ = 2048, NBATCH = 8, DEPTH = 4;
constexpr int PE = 2816, PO = 1440, POP = 1536;
constexpr int PB = 1792;
constexpr float RMS_EPS = 1e-6f;
constexpr float QSCALE = 0.10206207261596575f * 1.4426950408889634f;

constexpr size_t MiB = 1u << 20;
constexpr size_t WS_SSQ = 1 * MiB;
constexpr size_t WS_PQ = 2 * MiB;
constexpr size_t WS_PKV = 2 * MiB + 256 * 1024;
constexpr size_t WS_COS = 2 * MiB + 512 * 1024;
constexpr size_t WS_SIN = 2 * MiB + 640 * 1024;
constexpr size_t WS_CB = 3 * MiB;
constexpr size_t WS_WBUF0 = 4 * MiB, WBUF_BYTES = 42 * MiB;
constexpr size_t WS_XB = 88 * MiB;
constexpr size_t WS_YMIX = 120 * MiB;
constexpr size_t WS_ACT = 152 * MiB;
constexpr size_t WS_SC = 240 * MiB;
constexpr size_t WS_Y = 336 * MiB;
constexpr size_t WS_END = 368 * MiB;
constexpr size_t WB_W1IN = 0, WB_W1OUT = 11534336, WB_W2IN = 17301504, WB_W2OUT = 28835840, WB_WMIN = 34603008, WB_WMOUT = 40370176, WB_WX = 42467328;
constexpr size_t SC_Q = 0, SC_KV = 24 * MiB, SC_KR = 56 * MiB;

constexpr int LDS_BYTES = 147456;

__device__ __forceinline__ unsigned pk2(float lo, float hi) { f32x2 v = {lo, hi}; bf16x2_t b = __builtin_convertvector(v, bf16x2_t); return __builtin_bit_cast(unsigned, b); }
__device__ __forceinline__ float bflo(unsigned u) { return __uint_as_float(u << 16); }
__device__ __forceinline__ float bfhi(unsigned u) { return __uint_as_float(u & 0xffff0000u); }
__device__ __forceinline__ float bf1(bf16_t h) { return __uint_as_float((unsigned)h << 16); }
__device__ __forceinline__ f32x4 unpack4(u32x2 u) { return (f32x4){bflo(u.x), bfhi(u.x), bflo(u.y), bfhi(u.y)}; }
__device__ __forceinline__ u32x2 pack4(f32x4 v) { u32x2 r; r.x = pk2(v[0], v[1]); r.y = pk2(v[2], v[3]); return r; }
template <int CTRL> __device__ __forceinline__ float dpp_f(float x) { return __int_as_float(__builtin_amdgcn_update_dpp(0, __float_as_int(x), CTRL, 0xF, 0xF, true)); }
__device__ __forceinline__ float red16(float x) {
    x += dpp_f<0x140>(x);
    x += dpp_f<0x141>(x);
    x += dpp_f<0xB1>(x);
    x += dpp_f<0x4E>(x);
    return x;
}
__device__ __forceinline__ void st16_wt(void* p, u32x4 v) { asm volatile("global_store_dwordx4 %0, %1, off\n\ts_nop 1" :: "v"(p), "v"(v) : "memory"); }
__device__ __forceinline__ void st8_wt(void* p, u32x2 v) { asm volatile("global_store_dwordx2 %0, %1, off" :: "v"(p), "v"(v) : "memory"); }
__device__ __forceinline__ float wave_sum(float v) {
    v = red16(v);
    v += __shfl_xor(v, 16); v += __shfl_xor(v, 32);
    return v;
}
__device__ __forceinline__ float sigmoidf_(float x) { return __builtin_amdgcn_rcpf(1.0f + __expf(-x)); }
__device__ __forceinline__ float gelu_tanh(float x) { const float u = 1.5957691216057308f * (x + 0.044715f * x * x * x); return x * __builtin_amdgcn_rcpf(1.0f + __expf(-u)); }
__device__ __forceinline__ float tanh_(float x) { return 1.0f - 2.0f * __builtin_amdgcn_rcpf(1.0f + __expf(2.0f * x)); }

namespace pg8 {
constexpr int BM = 256, BK = 64, HALF = 128, HTB = HALF * BK * 2, STAGE_BYTES = 8 * HTB, NXCD = 8, WGM = 8;
__host__ __device__ __forceinline__ int lds_byte(int r, int c) { const int st = (r >> 4) * 2 + (c >> 5), rr = r & 15, cc = c & 31, ob = rr * 64 + cc * 2; return st * 1024 + (ob ^ (((ob >> 9) & 1) << 5)); }
__host__ __device__ __forceinline__ int perm32(int rho) { const int n = rho >> 4, i = rho & 15; return 8 * (i >> 2) + 4 * n + (i & 3); }
__host__ __device__ __forceinline__ void stage_rc(int b, int& R, int& C) { const int st = b / 1024, sb = b % 1024, swz = sb ^ (((sb >> 9) & 1) << 5); R = (st >> 1) * 16 + swz / 64; C = (st & 1) * 32 + (swz % 64) / 2; }
struct Unit { int pm, pn; };
struct Gemm { const bf16_t* A; const bf16_t* Bt; int M, N, K, lda, ldb; };
struct StaticOrder {
    int nM, nN, nwg, G, c;
    __device__ void init(int M, int N, int G_, int c_) { nM = M / BM; nN = N / BM; nwg = nM * nN; G = G_; c = c_; }
    __device__ bool next(int i, Unit& u) const {
        const int L = i * G + c; if (L >= nwg) return false;
        int wgid = L; { const int q = nwg / NXCD, r = nwg % NXCD, xcd = wgid % NXCD, off = wgid / NXCD; wgid = (xcd < r ? xcd * (q + 1) : r * (q + 1) + (xcd - r) * q) + off; }
        const int nig = WGM * nN, gid = wgid / nig, fm = gid * WGM, gsz = (nM - fm) < WGM ? (nM - fm) : WGM;
        u.pm = fm + ((wgid % nig) % gsz); u.pn = (wgid % nig) / gsz; return true;
    }
};
template <class Epi>
__device__ __forceinline__ void gemm_phase(LAS unsigned char* lds, const Gemm g, const StaticOrder& S, const Epi& E) {
    int tid_ = threadIdx.x; asm volatile("" : "+v"(tid_));
    const int tid = tid_, wid = __builtin_amdgcn_readfirstlane(tid >> 6), lane = tid & 63, wr = wid >> 2, wc = wid & 3, fr = lane & 15, fq = lane >> 4;
    const int K = g.K, nt = K / BK;
    unsigned voffA[2], voffB[2];
#pragma unroll
    for (int i = 0; i < 2; ++i) { int R, C; stage_rc(tid * 16 + i * 8192, R, C); const int Rb = Epi::PERM ? ((R & ~31) + perm32(R & 31)) : R; voffA[i] = (unsigned)(R * g.lda + C) * 2u; voffB[i] = (unsigned)(Rb * g.ldb + C) * 2u; }
    const size_t kstep = (size_t)(BK * 2);
    const size_t hsA = (size_t)HALF * g.lda * 2, hsB = (size_t)HALF * g.ldb * 2;
    const size_t tsA = 2 * hsA, tsB = 2 * hsB;
    const unsigned ldsw = (unsigned)wid * 1024u;
    const int aoff = lds_byte(wr * 64 + fr, fq * 8), boff = lds_byte(wc * 32 + fr, fq * 8);
#define PG8_SA(b, h) (((b) * 2 + (h)) * HTB)
#define PG8_SB(b, h) ((4 + (b) * 2 + (h)) * HTB)
#define PG8_STAGE(bufoff, gbase, voff) do { _Pragma("unroll") for (int _i = 0; _i < 2; ++_i) \
        __builtin_amdgcn_global_load_lds((const unsigned*)((const char*)(gbase) + (voff)[_i]), (LAS unsigned*)(lds + (bufoff) + ldsw + _i * 8192), 16, 0, 0); } while (0)
#define PG8_LDA(dst, b, h) do { _Pragma("unroll") for (int m = 0; m < 4; ++m) _Pragma("unroll") for (int k = 0; k < 2; ++k) dst[m][k] = *(const LAS bf16x8*)(lds + PG8_SA(b, h) + aoff + m * 2048 + k * 1024); } while (0)
#define PG8_LDB(dst, b, h) do { _Pragma("unroll") for (int n = 0; n < 2; ++n) _Pragma("unroll") for (int k = 0; k < 2; ++k) dst[n][k] = *(const LAS bf16x8*)(lds + PG8_SB(b, h) + boff + n * 2048 + k * 1024); } while (0)
#define PG8_MMA(ai, bj, At, Bt) do { __builtin_amdgcn_s_setprio(1); _Pragma("unroll") for (int m = 0; m < 4; ++m) _Pragma("unroll") for (int n = 0; n < 2; ++n) _Pragma("unroll") for (int k = 0; k < 2; ++k) \
        acc[ai][bj][m][n] = __builtin_amdgcn_mfma_f32_16x16x32_bf16(Bt[n][k], At[m][k], acc[ai][bj][m][n], 0, 0, 0); __builtin_amdgcn_s_setprio(0); } while (0)
#define PG8_WAIT_V(n) asm volatile("s_waitcnt vmcnt(" #n ")" ::: "memory")
#define PG8_WAIT_L(n) asm volatile("s_waitcnt lgkmcnt(" #n ")" ::: "memory")
#define PG8_BAR __builtin_amdgcn_s_barrier()
#define PG8_SCHED __builtin_amdgcn_sched_barrier(0)
    Unit cur, nxt; int ui = 0;
    if (!S.next(0, cur)) return;
    f32x4 acc[2][2][4][2];
#pragma unroll
    for (int a = 0; a < 2; ++a)
#pragma unroll
        for (int b = 0; b < 2; ++b)
#pragma unroll
            for (int m = 0; m < 4; ++m)
#pragma unroll
                for (int n = 0; n < 2; ++n) acc[a][b][m][n] = (f32x4){0.f, 0.f, 0.f, 0.f};
    bf16x8 At[4][2], B0[2][2], B1[2][2];
    const char* cA = (const char*)g.A + (size_t)cur.pm * tsA; const char* cB = (const char*)g.Bt + (size_t)cur.pn * tsB;
    PG8_STAGE(PG8_SB(0, 0), cB, voffB); PG8_STAGE(PG8_SB(0, 1), cB + hsB, voffB); PG8_STAGE(PG8_SA(0, 0), cA, voffA); PG8_STAGE(PG8_SA(0, 1), cA + hsA, voffA);
    if (wr == 1) PG8_BAR;
    PG8_WAIT_V(2); PG8_BAR;
    PG8_STAGE(PG8_SB(1, 0), cB + kstep, voffB); PG8_STAGE(PG8_SA(1, 0), cA + kstep, voffA); PG8_STAGE(PG8_SB(1, 1), cB + hsB + kstep, voffB);
    PG8_WAIT_V(6); PG8_BAR;
    for (;;) {
        const bool has_next = S.next(ui + 1, nxt);
        const char* nA = has_next ? (const char*)g.A + (size_t)nxt.pm * tsA : cA; const char* nB = has_next ? (const char*)g.Bt + (size_t)nxt.pn * tsB : cB;
#pragma unroll 1
        for (int t = 0; t < nt; t += 2) {
            const bool last = (t == nt - 2);
            const char* a1 = cA + (size_t)(t + 1) * kstep;
            const char* a2 = last ? nA : cA + (size_t)(t + 2) * kstep; const char* b2 = last ? nB : cB + (size_t)(t + 2) * kstep;
            const char* a3 = a2 + kstep; const char* b3 = b2 + kstep;
            PG8_LDB(B0, 0, 0); PG8_LDB(B1, 0, 1); PG8_SCHED; PG8_LDA(At, 0, 0); PG8_STAGE(PG8_SA(1, 1), a1 + hsA, voffA);
            PG8_WAIT_V(8); PG8_WAIT_L(0); PG8_BAR; PG8_MMA(0, 0, At, B0); PG8_MMA(0, 1, At, B1); PG8_BAR; PG8_SCHED;
            PG8_LDA(At, 0, 1); PG8_STAGE(PG8_SB(0, 0), b2, voffB); PG8_STAGE(PG8_SB(0, 1), b2 + hsB, voffB); PG8_STAGE(PG8_SA(0, 0), a2, voffA);
            PG8_WAIT_V(8); PG8_WAIT_L(0); PG8_BAR; PG8_MMA(1, 0, At, B0); PG8_MMA(1, 1, At, B1); PG8_BAR; PG8_SCHED;
            PG8_LDB(B0, 1, 0); PG8_LDB(B1, 1, 1); PG8_SCHED; PG8_LDA(At, 1, 0); PG8_STAGE(PG8_SA(0, 1), a2 + hsA, voffA);
            PG8_WAIT_V(8); PG8_WAIT_L(0); PG8_BAR; PG8_MMA(0, 0, At, B0); PG8_MMA(0, 1, At, B1); PG8_BAR; PG8_SCHED;
            PG8_LDA(At, 1, 1); PG8_STAGE(PG8_SB(1, 0), b3, voffB); PG8_STAGE(PG8_SB(1, 1), b3 + hsB, voffB); PG8_STAGE(PG8_SA(1, 0), a3, voffA);
            PG8_WAIT_V(8); PG8_WAIT_L(0); PG8_BAR; PG8_MMA(1, 0, At, B0); PG8_MMA(1, 1, At, B1); PG8_BAR; PG8_SCHED;
        }
        if (wr == 0) PG8_BAR;
        E(acc, cur, wr, wc, fr, fq);
        if (!has_next) break;
#pragma unroll
        for (int a = 0; a < 2; ++a)
#pragma unroll
            for (int b = 0; b < 2; ++b)
#pragma unroll
                for (int m = 0; m < 4; ++m)
#pragma unroll
                    for (int n = 0; n < 2; ++n) acc[a][b][m][n] = (f32x4){0.f, 0.f, 0.f, 0.f};
        cur = nxt; cA = nA; cB = nB; ++ui;
        if (wr == 1) PG8_BAR;
    }
    PG8_WAIT_V(0);
    PG8_BAR;
#undef PG8_SA
#undef PG8_SB
#undef PG8_STAGE
#undef PG8_LDA
#undef PG8_LDB
#undef PG8_MMA
#undef PG8_WAIT_V
#undef PG8_WAIT_L
#undef PG8_BAR
#undef PG8_SCHED
}
}
using pg8::Unit;

__device__ __forceinline__ void rows_rstd16(const float* ssq, int row0, int fq, float (&rs)[8]) {
    float p[8][4];
#pragma unroll
    for (int i = 0; i < 8; ++i) { const unsigned o = (unsigned)(4 * fq) * T + row0 + (i >> 2) * 128 + (i & 3) * 16;
#pragma unroll
        for (int k = 0; k < 4; ++k) p[i][k] = ssq[o + k * T]; }
#pragma unroll
    for (int i = 0; i < 8; ++i) { float s = (p[i][0] + p[i][1]) + (p[i][2] + p[i][3]); s += __shfl_xor(s, 16); s += __shfl_xor(s, 32); rs[i] = rsqrtf(s * (1.0f / 1024.0f) + RMS_EPS); }
}
__device__ __forceinline__ void rows_rstd4(const float* pp, int row0, int fq, float invw, float mul, float (&rs)[8]) {
    float p[8];
#pragma unroll
    for (int i = 0; i < 8; ++i) p[i] = pp[(unsigned)fq * T + (unsigned)(row0 + (i >> 2) * 128 + (i & 3) * 16)];
#pragma unroll
    for (int i = 0; i < 8; ++i) { float s = p[i]; s += __shfl_xor(s, 16); s += __shfl_xor(s, 32); rs[i] = rsqrtf(s * invw + RMS_EPS) * mul; }
}

struct EpiSwiGLU {
    static constexpr bool PERM = false;
    bf16_t* act; const float* ssq;
    __device__ __forceinline__ void operator()(const f32x4 (&acc)[2][2][4][2], const Unit& u, int wr, int wc, int fr, int fq) const {
        const int row0 = u.pm * 256 + wr * 64 + fr;
        const unsigned off0 = (unsigned)row0 * FF + u.pn * 128 + wc * 32 + fq * 8;
        float rsv[8]; rows_rstd16(ssq, row0, fq, rsv);
#pragma unroll
        for (int ai = 0; ai < 2; ++ai)
#pragma unroll
            for (int m = 0; m < 4; ++m) {
                const float rs = rsv[ai * 4 + m];
                u32x4 w;
#pragma unroll
                for (int bj = 0; bj < 2; ++bj) {
                    const f32x4 gt = acc[ai][bj][m][0] * rs, up = acc[ai][bj][m][1] * rs; f32x4 o;
#pragma unroll
                    for (int k = 0; k < 4; ++k) o[k] = gt[k] * up[k] * __builtin_amdgcn_rcpf(1.0f + __expf(-gt[k]));
                    const u32x2 pw = pack4(o); if (bj == 0) { w.x = pw.x; w.y = pw.y; } else { w.z = pw.x; w.w = pw.y; }
                }
                st16_wt(act + (off0 + (unsigned)((ai * 128 + m * 16) * FF)), w);
            }
    }
};
struct EpiResid {
    static constexpr bool PERM = true;
    bf16_t* xb; float* ssq; float scale;
    __device__ __forceinline__ void operator()(const f32x4 (&acc)[2][2][4][2], const Unit& u, int wr, int wc, int fr, int fq) const {
        const int row0 = u.pm * 256 + wr * 64 + fr;
        const unsigned off0 = (unsigned)row0 * DM + u.pn * 256 + wc * 32 + fq * 8;
        const unsigned so = (unsigned)(u.pn * 4 + wc) * T + row0;
#pragma unroll
        for (int ai = 0; ai < 2; ++ai) {
            u32x4 bv[4][2];
#pragma unroll
            for (int m = 0; m < 4; ++m)
#pragma unroll
                for (int bj = 0; bj < 2; ++bj) bv[m][bj] = *(const u32x4*)(xb + (off0 + (unsigned)((ai * 128 + m * 16) * DM + bj * 128)));
#pragma unroll
            for (int m = 0; m < 4; ++m) {
                float ss = 0.f;
#pragma unroll
                for (int bj = 0; bj < 2; ++bj) {
                    const unsigned o2 = off0 + (unsigned)((ai * 128 + m * 16) * DM + bj * 128);
                    const f32x4 v0 = unpack4((u32x2){bv[m][bj].x, bv[m][bj].y}) + acc[ai][bj][m][0] * scale;
                    const f32x4 v1 = unpack4((u32x2){bv[m][bj].z, bv[m][bj].w}) + acc[ai][bj][m][1] * scale;
                    const u32x2 p0 = pack4(v0), p1 = pack4(v1);
                    st16_wt(xb + o2, (u32x4){p0.x, p0.y, p1.x, p1.y});
                    ss += ((v0[0] * v0[0] + v0[1] * v0[1]) + (v0[2] * v0[2] + v0[3] * v0[3])) + ((v1[0] * v1[0] + v1[1] * v1[1]) + (v1[2] * v1[2] + v1[3] * v1[3]));
                }
                ss += __shfl_xor(ss, 16); ss += __shfl_xor(ss, 32);
                if (fq == 0) ssq[so + (unsigned)(ai * 128 + m * 16)] = ss;
            }
            asm volatile("" ::: "memory");
        }
    }
};
template <bool ODD> struct EpiZ {
    static constexpr bool PERM = true;
    bf16_t* z; int ldz; const float* ssq; float* pq; float* pkv;
    __device__ __forceinline__ void operator()(const f32x4 (&acc)[2][2][4][2], const Unit& u, int wr, int wc, int fr, int fq) const {
        const int row0 = u.pm * 256 + wr * 64 + fr;
        const unsigned off0 = (unsigned)row0 * ldz + u.pn * 256 + wc * 32 + fq * 8;
        float rsv[8]; rows_rstd16(ssq, row0, fq, rsv);
#pragma unroll
        for (int ai = 0; ai < 2; ++ai)
#pragma unroll
            for (int m = 0; m < 4; ++m) {
                const int row = row0 + ai * 128 + m * 16;
                const float rs = rsv[ai * 4 + m];
                float s0 = 0.f, s1 = 0.f;
#pragma unroll
                for (int bj = 0; bj < 2; ++bj) {
                    const f32x4 v0 = acc[ai][bj][m][0] * rs, v1 = acc[ai][bj][m][1] * rs;
                    const u32x2 p0 = pack4(v0), p1 = pack4(v1);
                    st16_wt(z + (off0 + (unsigned)((ai * 128 + m * 16) * ldz + bj * 128)), (u32x4){p0.x, p0.y, p1.x, p1.y});
                    const float q = ((v0[0] * v0[0] + v0[1] * v0[1]) + (v0[2] * v0[2] + v0[3] * v0[3])) + ((v1[0] * v1[0] + v1[1] * v1[1]) + (v1[2] * v1[2] + v1[3] * v1[3]));
                    if (bj == 0) s0 += q; else s1 += q;
                }
                if (ODD) {
                    if (u.pn == 0) { float s = s0 + s1; s += __shfl_xor(s, 16); s += __shfl_xor(s, 32); if (fq == 0) pq[(unsigned)wc * T + row] = s; }
                    else if (u.pn == 1) { float s = s0; s += __shfl_xor(s, 16); s += __shfl_xor(s, 32); if (fq == 0) pkv[(unsigned)wc * T + row] = s; }
                }
            }
    }
};
struct EpiUp {
    static constexpr bool PERM = true;
    bf16_t* q; bf16_t* kv; const float* pq; const float* pkv; const float* cosT; const float* sinT;
    __device__ __forceinline__ void operator()(const f32x4 (&acc)[2][2][4][2], const Unit& u, int wr, int wc, int fr, int fq) const {
        const int row0 = u.pm * 256 + wr * 64 + fr;
        float rsv[8];
        if (u.pn < 3) {
            rows_rstd4(pq, row0, fq, 1.0f / 256.0f, QSCALE, rsv);
#pragma unroll
            for (int bj = 0; bj < 2; ++bj) {
                const int G = u.pn * 8 + bj * 4 + wc;
                const bool rope = (G % 3) == 2;
#pragma unroll
                for (int ai = 0; ai < 2; ++ai)
#pragma unroll
                    for (int m = 0; m < 4; ++m) {
                        const int row = row0 + ai * 128 + m * 16; const float rs = rsv[ai * 4 + m];
                        f32x4 v0 = acc[ai][bj][m][0] * rs, v1 = acc[ai][bj][m][1] * rs;
                        if (rope) {
                            const int pos = row & (SEQ - 1);
                            const f32x4 c4 = *(const f32x4*)(cosT + (unsigned)(pos * 16 + fq * 4)), s4 = *(const f32x4*)(sinT + (unsigned)(pos * 16 + fq * 4));
                            const f32x4 o0 = v0 * c4 - v1 * s4, o1 = v0 * s4 + v1 * c4; v0 = o0; v1 = o1;
                        }
                        const u32x2 p0 = pack4(v0), p1 = pack4(v1);
                        st16_wt(q + (unsigned)(row * 768 + G * 32 + fq * 8), (u32x4){p0.x, p0.y, p1.x, p1.y});
                    }
            }
        } else {
            rows_rstd4(pkv, row0, fq, 1.0f / 128.0f, 1.0f, rsv);
#pragma unroll
            for (int ai = 0; ai < 2; ++ai)
#pragma unroll
                for (int m = 0; m < 4; ++m) {
                    const int row = row0 + ai * 128 + m * 16; const float rs = rsv[ai * 4 + m];
#pragma unroll
                    for (int bj = 0; bj < 2; ++bj) {
                        const u32x2 p0 = pack4(acc[ai][bj][m][0] * rs), p1 = pack4(acc[ai][bj][m][1] * rs);
                        st16_wt(kv + (unsigned)(row * 1024 + (u.pn - 3) * 256 + bj * 128 + wc * 32 + fq * 8), (u32x4){p0.x, p0.y, p1.x, p1.y});
                    }
                }
        }
    }
};

#define XB_TMO      128
#define XB_XCNT(j)  (256  + 64 * (j))
#define XB_XSUB(j)  (1280 + 64 * (j))
#define XB_XGEN(j)  (2304 + 64 * (j))
#define XB_TOP      3328
#define XB_TOPGEN   3392
#define XCD_BAR_WORDS 3456
#define XB_LSUB(j)  (3456 + 64 * (j))
#define XB_LGEN(j)  (4480 + 64 * (j))
#define XB_SPIN_CAP (1u << 18)
__device__ __forceinline__ unsigned xb_ld(unsigned* p)              { return __hip_atomic_load(p, __ATOMIC_RELAXED, __HIP_MEMORY_SCOPE_AGENT); }
__device__ __forceinline__ unsigned xb_add(unsigned* p, unsigned v) { return __hip_atomic_fetch_add(p, v, __ATOMIC_RELAXED, __HIP_MEMORY_SCOPE_AGENT); }
__device__ __forceinline__ unsigned xb_xcc_id() { return (unsigned)__builtin_amdgcn_s_getreg((3 << 11) | 20) & 0xFu; }
#define XB_SPIN(cond, bar) do { unsigned _sp = 0; while (cond) { __builtin_amdgcn_s_sleep(1); \
    if ((++_sp & 255u) == 0u) { if (xb_ld(&(bar)[XB_TMO])) break; if (_sp > XB_SPIN_CAP) { atomicAdd(&(bar)[XB_TMO], 1u); break; } } } } while (0)
struct XcdBarrier { unsigned* bar; unsigned x; volatile LAS unsigned* st; };
__device__ __forceinline__ XcdBarrier xcd_barrier_post(unsigned* bar, volatile LAS unsigned* st) {
    XcdBarrier b; b.bar = bar; b.x = xb_xcc_id(); b.st = st;
    if (threadIdx.x == 0) st[3] = xb_add(&bar[XB_XCNT(b.x)], 1u);
    return b;
}
__device__ __forceinline__ void xcd_barrier_complete(unsigned* bar, unsigned x, unsigned& nloc, unsigned& nx, unsigned& regular) {
    const unsigned G = gridDim.x * gridDim.y * gridDim.z;
    unsigned sum, cnt, mine, sp = 0u;
    for (;;) {
        sum = 0u; cnt = 0u; mine = 0u;
#pragma unroll
        for (unsigned j = 0; j < 16; ++j) { const unsigned c = xb_ld(&bar[XB_XCNT(j)]); sum += c; cnt += (c > 0u) ? 1u : 0u; mine = (j == x) ? c : mine; }
        if (sum == G) break;
        __builtin_amdgcn_s_sleep(1);
        if ((++sp & 255u) == 0u) { if (xb_ld(&bar[XB_TMO])) break; if (sp > XB_SPIN_CAP) { atomicAdd(&bar[XB_TMO], 1u); break; } }
    }
    nloc = mine > 0u ? mine : 1u; nx = cnt > 0u ? cnt : 1u;
    unsigned reg = (G == 256u) ? 1u : 0u;
#pragma unroll
    for (unsigned j = 0; j < 16; ++j) { const unsigned c = xb_ld(&bar[XB_XCNT(j)]); if (c != (j < 8u ? 32u : 0u)) reg = 0u; }
    regular = reg;
}
__device__ __forceinline__ void xcd_barrier(const XcdBarrier& b) {
    asm volatile("s_waitcnt vmcnt(0)" ::: "memory");
    __syncthreads();
    if (threadIdx.x == 0) {
        unsigned* bar = b.bar;
        __builtin_amdgcn_s_waitcnt(0);
        unsigned nloc = b.st[0], nx = b.st[1];
        if (nloc == 0u) { unsigned reg_; xcd_barrier_complete(bar, b.x, nloc, nx, reg_); b.st[0] = nloc; b.st[1] = nx; b.st[2] = reg_; }
        const unsigned old = xb_add(&bar[XB_XSUB(b.x)], 1u);
        const unsigned gen = old / nloc;
        if (old + 1u == (gen + 1u) * nloc) {
            __builtin_amdgcn_fence(__ATOMIC_RELEASE, "agent");
            asm volatile("s_waitcnt vmcnt(0)" ::: "memory");
            const unsigned og = xb_add(&bar[XB_TOP], 1u);
            const unsigned tg = og / nx;
            if (og + 1u == (tg + 1u) * nx) xb_add(&bar[XB_TOPGEN], 1u);
            else XB_SPIN(xb_ld(&bar[XB_TOPGEN]) == tg, bar);
            __builtin_amdgcn_fence(__ATOMIC_ACQUIRE, "agent");
            xb_add(&bar[XB_XGEN(b.x)], 1u);
            asm volatile("s_waitcnt vmcnt(0)" ::: "memory");
        } else {
            XB_SPIN(xb_ld(&bar[XB_XGEN(b.x)]) == gen, bar);
            __builtin_amdgcn_fence(__ATOMIC_ACQUIRE, "agent");
            asm volatile("s_waitcnt vmcnt(0)" ::: "memory");
        }
    }
    __syncthreads();
}
__device__ __forceinline__ void xcd_local_barrier(const XcdBarrier& b) {
    asm volatile("s_waitcnt vmcnt(0)" ::: "memory");
    __syncthreads();
    if (threadIdx.x == 0) {
        unsigned* bar = b.bar;
        __builtin_amdgcn_s_waitcnt(0);
        const unsigned nloc = b.st[0];
        const unsigned old = xb_add(&bar[XB_LSUB(b.x)], 1u);
        const unsigned gen = old / nloc;
        if (old + 1u == (gen + 1u) * nloc) xb_add(&bar[XB_LGEN(b.x)], 1u);
        else XB_SPIN(xb_ld(&bar[XB_LGEN(b.x)]) == gen, bar);
        __builtin_amdgcn_fence(__ATOMIC_ACQUIRE, "agent");
        asm volatile("s_waitcnt vmcnt(0)" ::: "memory");
    }
    __syncthreads();
}
template <int K> __device__ __forceinline__ const float* inp() {
    unsigned long long v;
    const unsigned long long kp_ = (unsigned long long)__builtin_amdgcn_kernarg_segment_ptr();
    const unsigned long long kps_ = ((unsigned long long)(unsigned)__builtin_amdgcn_readfirstlane((int)(unsigned)(kp_ >> 32)) << 32) | (unsigned)__builtin_amdgcn_readfirstlane((int)(unsigned)kp_);
    asm volatile("s_load_dwordx2 %0, %1, %2\n\ts_waitcnt lgkmcnt(0)" : "=s"(v) : "s"(kps_), "n"(K * 8) : "memory");
    return (const float*)(const __attribute__((address_space(1))) float*)v;
}
struct Args { const float* in[36]; float* out; unsigned char* ws; int ph_lo, ph_hi; };
struct Frame {
    LAS unsigned char* lds;
    int tid, lane, wave, G, bid;
    float* out; unsigned char* ws;
};

struct CvtDesc { const float* W; const float* gain; bf16_t* WT; int N, ldt, kdst, mode, item; };
__device__ __forceinline__ void cvt_load(const CvtDesc& d, int lane, f32x4 (&v)[8], float (&g)[8]) {
    const int nblk = d.N / 32, kb = d.item / nblk, nb = d.item % nblk, k0 = 64 * kb, n0 = 32 * nb;
    const int kq = lane >> 3, nq = (lane & 7) * 4;
#pragma unroll
    for (int i = 0; i < 8; ++i) v[i] = *(const f32x4*)(d.W + (size_t)(k0 + i * 8 + kq) * d.N + n0 + nq);
#pragma unroll
    for (int i = 0; i < 8; ++i) g[i] = d.gain ? d.gain[k0 + i * 8 + kq] : 1.0f;
}
__device__ __forceinline__ void cvt_finish(const CvtDesc& d, int lane, LAS float* scr, const f32x4 (&v)[8], const float (&g)[8]) {
    const int nblk = d.N / 32, kb = d.item / nblk, nb = d.item % nblk, k0 = 64 * kb, n0 = 32 * nb;
    const int kq = lane >> 3, nq = (lane & 7) * 4;
#pragma unroll
    for (int i = 0; i < 8; ++i) { const int kk = i * 8 + kq; const float gk = g[i]; LAS float* dd = scr + kk * 33 + nq; dd[0] = v[i][0] * gk; dd[1] = v[i][1] * gk; dd[2] = v[i][2] * gk; dd[3] = v[i][3] * gk; }
    asm volatile("s_waitcnt lgkmcnt(0)" ::: "memory");
    const int c = lane & 7;
#pragma unroll
    for (int j = 0; j < 4; ++j) {
        const int n = (lane >> 3) + 8 * j; const LAS float* sp_ = scr + (8 * c) * 33 + n;
        u32x4 o; o.x = pk2(sp_[0 * 33], sp_[1 * 33]); o.y = pk2(sp_[2 * 33], sp_[3 * 33]); o.z = pk2(sp_[4 * 33], sp_[5 * 33]); o.w = pk2(sp_[6 * 33], sp_[7 * 33]);
        int nn = n0 + n;
        if (d.mode == 1) { const int which = nn >= FF ? 1 : 0, h = nn - which * FF, hl = h & 127; nn = 256 * (h >> 7) + 128 * ((hl >> 2) & 1) + 32 * (hl >> 5) + 16 * which + 4 * ((hl >> 3) & 3) + (hl & 3); }
        if (d.mode == 2) { const int hd = nn / 96, dd = nn % 96; if (dd >= 64) { const int r_ = dd - 64, n_ = r_ >> 4, i_ = r_ & 15; nn = hd * 96 + 64 + 8 * (i_ >> 2) + 4 * n_ + (i_ & 3); } }
        st16_wt(d.WT + (size_t)nn * d.ldt + d.kdst + k0 + 8 * c, o);
    }
    asm volatile("s_waitcnt lgkmcnt(0)" ::: "memory");
}
__device__ __forceinline__ void zero_fill16(unsigned char* base, int row_bytes_stride, int col_byte0, int chunks_per_row, int nrows, int gtid, int gthreads) {
    const int total = nrows * chunks_per_row;
    unsigned zz = 0u; asm volatile("" : "+v"(zz));
    const u32x4 z4 = (u32x4){zz, zz, zz, zz};
    for (int i = gtid; i < total; i += gthreads) { const int r = i / chunks_per_row, c = i % chunks_per_row; st16_wt(base + (size_t)r * row_bytes_stride + col_byte0 + c * 16, z4); }
}
__device__ __forceinline__ void convert_layer(const Frame& F, int l, int part, int nparts, int vb, int nvb) {
    unsigned char* wb = F.ws + WS_WBUF0 + (size_t)(l & 1) * WBUF_BYTES;
    LAS float* scr = (LAS float*)(F.lds + F.wave * 16384);
    const int gw = vb * 8 + F.wave, NGW = nvb * 8;
    const int hl = l >> 1; const bool odd = l & 1;
    constexpr int I_IN = 16 * 176, I_OUT = 44 * 32, I_MO = 16 * 32;
    const int I_MI = odd ? 16 * 45 : 16 * 88;
    const int I_X = odd ? (4 * 24 + 2 * 32) : (16 + 16 + 32);
    const int total = 2 * I_IN + 2 * I_OUT + I_MI + I_MO + I_X;
    const int it_lo = (int)((long)total * part / nparts), it_hi = (int)((long)total * (part + 1) / nparts);
    auto desc = [&](int it) -> CvtDesc {
        CvtDesc d; d.kdst = 0; d.mode = 0; d.gain = nullptr;
        int r = it;
        if (r < I_IN) { d.W = inp<2>() + (size_t)l * DM * 2 * FF; d.N = 2 * FF; d.gain = inp<1>() + l * DM; d.WT = (bf16_t*)(wb + WB_W1IN); d.ldt = DM; d.mode = 1; d.item = r; return d; } r -= I_IN;
        if (r < I_IN) { d.W = inp<6>() + (size_t)l * DM * 2 * FF; d.N = 2 * FF; d.gain = inp<5>() + l * DM; d.WT = (bf16_t*)(wb + WB_W2IN); d.ldt = DM; d.mode = 1; d.item = r; return d; } r -= I_IN;
        if (r < I_OUT) { d.W = inp<3>() + (size_t)l * FF * DM; d.N = DM; d.WT = (bf16_t*)(wb + WB_W1OUT); d.ldt = FF; d.item = r; return d; } r -= I_OUT;
        if (r < I_OUT) { d.W = inp<7>() + (size_t)l * FF * DM; d.N = DM; d.WT = (bf16_t*)(wb + WB_W2OUT); d.ldt = FF; d.item = r; return d; } r -= I_OUT;
        if (r < I_MI) {
            if (odd) { d.W = inp<25>() + (size_t)hl * DM * PO; d.N = PO; } else { d.W = inp<8>() + (size_t)hl * DM * PE; d.N = PE; }
            d.gain = inp<4>() + l * DM; d.WT = (bf16_t*)(wb + WB_WMIN); d.ldt = DM; d.item = r; return d; } r -= I_MI;
        if (r < I_MO) { d.W = (odd ? inp<26>() : inp<9>()) + (size_t)hl * DM * DM; d.N = DM; d.WT = (bf16_t*)(wb + WB_WMOUT); d.ldt = DM; d.item = r; return d; } r -= I_MO;
        if (odd) {
            if (r < 96) { d.W = inp<28>() + (size_t)hl * 256 * 768; d.N = 768; d.gain = inp<27>() + hl * 256; d.WT = (bf16_t*)(wb + WB_WX); d.ldt = 384; d.mode = 2; d.item = r; return d; } r -= 96;
            d.W = inp<30>() + (size_t)hl * 128 * 1024; d.N = 1024; d.gain = inp<29>() + hl * 128; d.WT = (bf16_t*)(wb + WB_WX) + (size_t)768 * 384; d.ldt = 384; d.kdst = 256; d.item = r; return d;
        }
        if (r < 16) { d.W = inp<16>() + (size_t)hl * 64 * 512; d.N = 512; d.WT = (bf16_t*)(wb + WB_WX); d.ldt = 64; d.item = r; return d; } r -= 16;
        if (r < 16) { d.W = inp<18>() + (size_t)hl * 64 * 512; d.N = 512; d.WT = (bf16_t*)(wb + WB_WX) + 512 * 64; d.ldt = 64; d.item = r; return d; } r -= 16;
        d.W = inp<19>() + (size_t)hl * 128 * 512; d.N = 512; d.WT = (bf16_t*)(wb + WB_WX) + 2 * 512 * 64; d.ldt = 128; d.item = r; return d;
    };
    {
        int it = it_lo + gw;
        if (it < it_hi) {
            CvtDesc d0 = desc(it), d1 = d0; f32x4 va[8], vc[8]; float ga[8], gc[8];
            cvt_load(d0, F.lane, va, ga);
            for (;;) {
                const int it1 = it + NGW; const bool h1 = it1 < it_hi;
                if (h1) { d1 = desc(it1); cvt_load(d1, F.lane, vc, gc); }
                cvt_finish(d0, F.lane, scr, va, ga);
                if (!h1) break;
                const int it2 = it1 + NGW; const bool h2 = it2 < it_hi;
                if (h2) { d0 = desc(it2); cvt_load(d0, F.lane, va, ga); }
                cvt_finish(d1, F.lane, scr, vc, gc);
                if (!h2) break;
                it = it2;
            }
        }
    }
    if (odd && part == 0) {
        const int gtid = vb * 512 + F.tid, gth = nvb * 512;
        zero_fill16(wb + WB_WMIN + (size_t)PO * DM * 2, DM * 2, 0, 128, POP - PO, gtid, gth);
        zero_fill16(wb + WB_WX, 384 * 2, 512, 16, 768, gtid, gth);
        zero_fill16(wb + WB_WX + (size_t)768 * 384 * 2, 384 * 2, 0, 32, 1024, gtid, gth);
    }
}

__device__ __forceinline__ void x_prologue(const Frame& F) {
    const float* x = inp<0>(); bf16_t* xb = (bf16_t*)(F.ws + WS_XB); float* ssq = (float*)(F.ws + WS_SSQ);
    const int gw = F.bid * 8 + F.wave, NGW = F.G * 8, lane = F.lane;
    for (int m = gw; m < T; m += NGW) {
        const f32x4* xr = (const f32x4*)(x + (size_t)m * DM) + lane;
        f32x4 v[4]; float s = 0.f;
#pragma unroll
        for (int j = 0; j < 4; ++j) { v[j] = xr[64 * j]; s += (v[j][0] * v[j][0] + v[j][1] * v[j][1]) + (v[j][2] * v[j][2] + v[j][3] * v[j][3]); }
        s = wave_sum(s);
        u32x2* o = (u32x2*)(xb + (size_t)m * DM) + lane;
#pragma unroll
        for (int j = 0; j < 4; ++j) st8_wt(o + 64 * j, pack4(v[j]));
        if (lane < 16) ssq[(size_t)lane * T + m] = (lane == 0) ? s : 0.f;
    }
    float* cosT = (float*)(F.ws + WS_COS); float* sinT = (float*)(F.ws + WS_SIN);
    for (int i = F.bid * 512 + F.tid; i < SEQ * 16; i += F.G * 512) {
        const int pos = i >> 4, k = i & 15;
        const float inv = exp2f(-(float)k * 0.8304820237218407f);
        const float ang = (float)pos * inv;
        const double rev = (double)ang * 0.15915494309189535;
        const float fr = (float)(rev - floor(rev));
        cosT[i] = __builtin_amdgcn_cosf(fr); sinT[i] = __builtin_amdgcn_sinf(fr);
    }
}
__device__ __forceinline__ void final_norm(const Frame& F) {
    const float* g = inp<35>(); float* x = F.out; const bf16_t* xb = (const bf16_t*)(F.ws + WS_XB);
    const int gw = F.bid * 8 + F.wave, NGW = F.G * 8, lane = F.lane;
    for (int m = gw; m < T; m += NGW) {
        f32x4* xr = (f32x4*)(x + (size_t)m * DM) + lane;
        const u32x2* br = (const u32x2*)(xb + (size_t)m * DM) + lane;
        f32x4 v[4]; float s = 0.f;
#pragma unroll
        for (int j = 0; j < 4; ++j) { v[j] = unpack4(br[64 * j]); s += (v[j][0] * v[j][0] + v[j][1] * v[j][1]) + (v[j][2] * v[j][2] + v[j][3] * v[j][3]); }
        s = wave_sum(s);
        const float rs = rsqrtf(s * (1.0f / 1024.0f) + RMS_EPS);
#pragma unroll
        for (int j = 0; j < 4; ++j) { const f32x4 gg = *((const f32x4*)g + lane + 64 * j); xr[64 * j] = v[j] * rs * gg; }
    }
}

__device__ __forceinline__ void gsu_item(const Frame& F, int item, int e) {
    const int nb = item >> 2, g = item & 3, tok0 = nb * 128, lane = F.lane, wave = F.wave, fr = lane & 15, fq = lane >> 4;
    const bf16_t* z = (const bf16_t*)(F.ws + WS_ACT);
    bf16_t* ymix = (bf16_t*)(F.ws + WS_YMIX);
    const float* ws = inp<10>() + (size_t)(e * 4 + g) * 128 * 128; const float* bs = inp<11>() + (e * 4 + g) * 128;
    const float* lng = inp<12>() + e * 512; const float* lnb = inp<13>() + e * 512;
    LAS bf16_t* vn = (LAS bf16_t*)F.lds;
    u32x4 zrs[16];
#pragma unroll
    for (int fi = 0; fi < 16; ++fi) zrs[fi] = *(const u32x4*)(z + (size_t)(tok0 + wave * 16 + fi) * PE + 512 + lane * 8);
    float lgv[8], lbv[8];
#pragma unroll
    for (int k = 0; k < 8; ++k) { lgv[k] = lng[lane * 8 + k]; lbv[k] = lnb[lane * 8 + k]; }
#pragma unroll
    for (int fi = 0; fi < 16; ++fi) {
        const int frame = wave * 16 + fi;
        const u32x4 zr = zrs[fi];
        float gv[8]; gv[0] = bflo(zr.x); gv[1] = bfhi(zr.x); gv[2] = bflo(zr.y); gv[3] = bfhi(zr.y); gv[4] = bflo(zr.z); gv[5] = bfhi(zr.z); gv[6] = bflo(zr.w); gv[7] = bfhi(zr.w);
        float s = 0.f;
#pragma unroll
        for (int k = 0; k < 8; ++k) { gv[k] = gelu_tanh(gv[k]); s += gv[k]; }
        const float mean = wave_sum(s) * (1.0f / 512.0f); float qv = 0.f;
#pragma unroll
        for (int k = 0; k < 8; ++k) { gv[k] -= mean; qv += gv[k] * gv[k]; }
        const float rstd = rsqrtf(wave_sum(qv) * (1.0f / 512.0f) + 1e-5f);
        if ((lane >> 4) == g) {
            const int cl = (lane & 15) * 8;
#pragma unroll
            for (int k = 0; k < 8; ++k) { const float o = gv[k] * rstd * lgv[k] + lbv[k]; vn[(cl + k) * 136 + frame] = (bf16_t)(pk2(o, 0.f) & 0xffffu); }
        }
    }
    __syncthreads();
    const int i = wave * 16 + fr; const int nks = (wave < 4) ? 2 : 4;
    f32x4 acc[8];
#pragma unroll
    for (int ct = 0; ct < 8; ++ct) acc[ct] = (f32x4){0.f, 0.f, 0.f, 0.f};
    for (int ks = 0; ks < nks; ++ks) {
        const float* wp = ws + (size_t)i * 128 + ks * 32 + fq * 8;
        const f32x4 w0 = *(const f32x4*)wp, w1 = *(const f32x4*)(wp + 4);
        u32x4 wy; wy.x = pk2(w0[0], w0[1]); wy.y = pk2(w0[2], w0[3]); wy.z = pk2(w1[0], w1[1]); wy.w = pk2(w1[2], w1[3]);
        const bf16x8 Y = __builtin_bit_cast(bf16x8, wy);
#pragma unroll
        for (int ct = 0; ct < 8; ++ct) {
            const bf16x8 X = *(const LAS bf16x8*)(vn + (ct * 16 + fr) * 136 + ks * 32 + fq * 8);
            acc[ct] = __builtin_amdgcn_mfma_f32_16x16x32_bf16(X, Y, acc[ct], 0, 0, 0);
        }
    }
    const size_t tok = tok0 + i; const float bsv = bs[i];
#pragma unroll
    for (int ct = 0; ct < 8; ++ct) {
        const int c = g * 128 + ct * 16 + fq * 4;
        const f32x4 uz = unpack4(*(const u32x2*)(z + tok * PE + c)); f32x4 o;
#pragma unroll
        for (int k = 0; k < 4; ++k) o[k] = gelu_tanh(uz[k]) * (acc[ct][k] + bsv);
        st8_wt(ymix + tok * DM + c, pack4(o));
    }
    __syncthreads();
}

__device__ __forceinline__ void prep_item(const Frame& F, int item, int e, const unsigned char* wb) {
    const int tok0 = item * 32, b = tok0 / SEQ, t0 = tok0 % SEQ, lane = F.lane, h = F.wave, fr = lane & 15, fq = lane >> 4, tid = F.tid;
    const bf16_t* z = (const bf16_t*)(F.ws + WS_ACT);
    bf16_t* ymix = (bf16_t*)(F.ws + WS_YMIX); bf16_t* sc = (bf16_t*)(F.ws + WS_SC); float* cb = (float*)(F.ws + WS_CB);
    const float* mu = inp<14>() + e * PB; const float* w0p = inp<15>() + e * 512; const float* a0p = inp<17>() + e * 512;
    const float* kkp = inp<20>() + e * 512; const float* kap = inp<21>() + e * 512; const float* rkp = inp<22>() + e * 512;
    LAS bf16_t* At = (LAS bf16_t*)F.lds;
    LAS float* PRM = (LAS float*)(F.lds + 32768);
    {
        PRM[0 * 512 + tid] = mu[tid]; PRM[1 * 512 + tid] = mu[512 + tid]; PRM[2 * 512 + tid] = mu[1024 + tid];
        PRM[3 * 512 + tid] = kkp[tid]; PRM[4 * 512 + tid] = kap[tid]; PRM[5 * 512 + tid] = rkp[tid];
        PRM[6 * 512 + tid] = w0p[tid]; PRM[7 * 512 + tid] = a0p[tid];
    }
    {
        const int token = tid >> 4, chunk = tid & 15, t = t0 + token; const size_t tok = tok0 + token;
        const bf16_t* zp = z + tok * PE + 2560 + chunk * 16;
        const u32x4 c0 = *(const u32x4*)zp, c1 = *(const u32x4*)(zp + 8);
        const bf16_t* zq = (t > 0) ? zp - PE : zp;
        u32x4 p0 = *(const u32x4*)zq, p1 = *(const u32x4*)(zq + 8);
        if (t == 0) { p0 = (u32x4){0u, 0u, 0u, 0u}; p1 = p0; }
        float cv[16], pv[16];
#pragma unroll
        for (int k = 0; k < 4; ++k) { cv[2 * k] = bflo(c0[k]); cv[2 * k + 1] = bfhi(c0[k]); cv[8 + 2 * k] = bflo(c1[k]); cv[9 + 2 * k] = bfhi(c1[k]);
                                      pv[2 * k] = bflo(p0[k]); pv[2 * k + 1] = bfhi(p0[k]); pv[8 + 2 * k] = bflo(p1[k]); pv[9 + 2 * k] = bfhi(p1[k]); }
        const f32x4* mup = (const f32x4*)(mu + 1536 + chunk * 16);
        const f32x4 m0 = mup[0], m1 = mup[1], m2 = mup[2], m3 = mup[3];
        const float mv_[16] = {m0[0], m0[1], m0[2], m0[3], m1[0], m1[1], m1[2], m1[3], m2[0], m2[1], m2[2], m2[3], m3[0], m3[1], m3[2], m3[3]};
#pragma unroll
        for (int k = 0; k < 16; ++k) cv[k] = cv[k] + mv_[k] * (pv[k] - cv[k]);
        if (chunk < 4) {
#pragma unroll
            for (int k = 0; k < 16; ++k) cv[k] = tanh_(cv[k]);
        } else if (chunk >= 8) {
#pragma unroll
            for (int k = 0; k < 16; ++k) cv[k] = sigmoidf_(cv[k]);
        }
        u32x4 o0, o1;
#pragma unroll
        for (int k = 0; k < 4; ++k) { o0[k] = pk2(cv[2 * k], cv[2 * k + 1]); o1[k] = pk2(cv[8 + 2 * k], cv[9 + 2 * k]); }
        *(LAS u32x4*)(At + token * 264 + chunk * 16) = o0; *(LAS u32x4*)(At + token * 264 + chunk * 16 + 8) = o1;
    }
    __syncthreads();
    const bf16_t* DUt = (const bf16_t*)(wb + WB_WX); const bf16_t* IUt = DUt + 512 * 64; const bf16_t* GUt = DUt + 2 * 512 * 64;
#pragma unroll
    for (int mt = 0; mt < 2; ++mt) {
        const LAS bf16_t* Ar = At + (mt * 16 + fr) * 264 + fq * 8;
        const int t = t0 + mt * 16 + fr; const size_t tok = tok0 + mt * 16 + fr; const bool hp = t > 0;
        f32x4 ev[4], av[4];
        {
            f32x4 acc[4];
#pragma unroll
            for (int nt = 0; nt < 4; ++nt) acc[nt] = (f32x4){0.f, 0.f, 0.f, 0.f};
#pragma unroll
            for (int ks = 0; ks < 2; ++ks) {
                const bf16x8 Yv = *(const LAS bf16x8*)(Ar + 0 + ks * 32);
#pragma unroll
                for (int nt = 0; nt < 4; ++nt) {
                    const bf16x8 X = *(const bf16x8*)(DUt + (size_t)(h * 64 + 32 * (nt >> 1) + 8 * (fr >> 2) + 4 * (nt & 1) + (fr & 3)) * 64 + ks * 32 + fq * 8);
                    acc[nt] = __builtin_amdgcn_mfma_f32_16x16x32_bf16(X, Yv, acc[nt], 0, 0, 0);
                }
            }
#pragma unroll
            for (int nt = 0; nt < 4; ++nt) {
                const f32x4 w0 = *(const LAS f32x4*)(PRM + 6 * 512 + h * 64 + 32 * (nt >> 1) + 8 * fq + 4 * (nt & 1));
#pragma unroll
                for (int k = 0; k < 4; ++k) ev[nt][k] = 0.6065306597126334f * __builtin_amdgcn_rcpf(1.0f + __expf(-(w0[k] + acc[nt][k])));
            }
        }
        {
            f32x4 acc[4];
#pragma unroll
            for (int nt = 0; nt < 4; ++nt) acc[nt] = (f32x4){0.f, 0.f, 0.f, 0.f};
#pragma unroll
            for (int ks = 0; ks < 2; ++ks) {
                const bf16x8 Yv = *(const LAS bf16x8*)(Ar + 64 + ks * 32);
#pragma unroll
                for (int nt = 0; nt < 4; ++nt) {
                    const bf16x8 X = *(const bf16x8*)(IUt + (size_t)(h * 64 + 32 * (nt >> 1) + 8 * (fr >> 2) + 4 * (nt & 1) + (fr & 3)) * 64 + ks * 32 + fq * 8);
                    acc[nt] = __builtin_amdgcn_mfma_f32_16x16x32_bf16(X, Yv, acc[nt], 0, 0, 0);
                }
            }
#pragma unroll
            for (int nt = 0; nt < 4; ++nt) {
                const f32x4 a0 = *(const LAS f32x4*)(PRM + 7 * 512 + h * 64 + 32 * (nt >> 1) + 8 * fq + 4 * (nt & 1));
#pragma unroll
                for (int k = 0; k < 4; ++k) av[nt][k] = sigmoidf_(a0[k] + acc[nt][k]);
            }
        }
        {
            f32x4 acc[4];
#pragma unroll
            for (int nt = 0; nt < 4; ++nt) acc[nt] = (f32x4){0.f, 0.f, 0.f, 0.f};
#pragma unroll
            for (int ks = 0; ks < 4; ++ks) {
                const bf16x8 Yv = *(const LAS bf16x8*)(Ar + 128 + ks * 32);
#pragma unroll
                for (int nt = 0; nt < 4; ++nt) {
                    const bf16x8 X = *(const bf16x8*)(GUt + (size_t)(h * 64 + 32 * (nt >> 1) + 8 * (fr >> 2) + 4 * (nt & 1) + (fr & 3)) * 128 + ks * 32 + fq * 8);
                    acc[nt] = __builtin_amdgcn_mfma_f32_16x16x32_bf16(X, Yv, acc[nt], 0, 0, 0);
                }
            }
#pragma unroll
            for (int a2 = 0; a2 < 2; ++a2) { const u32x2 p0 = pack4(acc[2 * a2]), p1 = pack4(acc[2 * a2 + 1]);
                st16_wt(ymix + tok * DM + 512 + h * 64 + 32 * a2 + 8 * fq, (u32x4){p0.x, p0.y, p1.x, p1.y}); }
        }
        f32x4 rv[4], kv[4], kk[4]; float ssq = 0.f;
        bf16_t* sp = sc + ((size_t)(b * 8 + h) * SEQ + t) * 384;
#define PK8(lo4, hi4) ({ const u32x2 p0_ = pack4(lo4), p1_ = pack4(hi4); (u32x4){p0_.x, p0_.y, p1_.x, p1_.y}; })
#pragma unroll
        for (int a2 = 0; a2 < 2; ++a2) {
            const int cl = 32 * a2 + 8 * fq, c = h * 64 + cl;
            const bf16_t* zp = z + tok * PE + 1024 + c;
            const u32x4 zr = *(const u32x4*)zp, zk = *(const u32x4*)(zp + 512), zv = *(const u32x4*)(zp + 1024);
            const bf16_t* zq = hp ? zp - PE : zp; const float hm = hp ? 1.0f : 0.0f;
            const u32x4 qr = *(const u32x4*)zq, qk = *(const u32x4*)(zq + 512), qv = *(const u32x4*)(zq + 1024);
            f32x4 vv[2];
#pragma unroll
            for (int hh = 0; hh < 2; ++hh) {
                const int nt = 2 * a2 + hh, c4 = c + 4 * hh;
                const f32x4 cr = unpack4(hh ? (u32x2){zr.z, zr.w} : (u32x2){zr.x, zr.y}), ck = unpack4(hh ? (u32x2){zk.z, zk.w} : (u32x2){zk.x, zk.y}), cvv = unpack4(hh ? (u32x2){zv.z, zv.w} : (u32x2){zv.x, zv.y});
                const f32x4 pr = unpack4(hh ? (u32x2){qr.z, qr.w} : (u32x2){qr.x, qr.y}) * hm, pk = unpack4(hh ? (u32x2){qk.z, qk.w} : (u32x2){qk.x, qk.y}) * hm, pvv = unpack4(hh ? (u32x2){qv.z, qv.w} : (u32x2){qv.x, qv.y}) * hm;
                const f32x4 mr = *(const LAS f32x4*)(PRM + c4), mk = *(const LAS f32x4*)(PRM + 512 + c4), mv = *(const LAS f32x4*)(PRM + 1024 + c4);
                rv[nt] = cr + mr * (pr - cr); kv[nt] = ck + mk * (pk - ck); vv[hh] = cvv + mv * (pvv - cvv);
                kk[nt] = kv[nt] * *(const LAS f32x4*)(PRM + 3 * 512 + c4);
                ssq += (kk[nt][0] * kk[nt][0] + kk[nt][1] * kk[nt][1]) + (kk[nt][2] * kk[nt][2] + kk[nt][3] * kk[nt][3]);
            }
            st16_wt(sp + 5 * 64 + cl, PK8(vv[0], vv[1]));
            st16_wt(sp + 4 * 64 + cl, PK8(rv[2 * a2], rv[2 * a2 + 1]));
            st16_wt(sp + 0 * 64 + cl, PK8(ev[2 * a2], ev[2 * a2 + 1]));
        }
        ssq += __shfl_xor(ssq, 16); ssq += __shfl_xor(ssq, 32);
        const float inv = 1.0f / fmaxf(sqrtf(ssq), 1e-12f);
        float cbp = 0.f;
#pragma unroll
        for (int a2 = 0; a2 < 2; ++a2) {
            const int cl = 32 * a2 + 8 * fq, c = h * 64 + cl;
            f32x4 kp[2], nk[2], nb[2];
#pragma unroll
            for (int hh = 0; hh < 2; ++hh) {
                const int nt = 2 * a2 + hh, c4 = c + 4 * hh;
                const f32x4 a = av[nt], kkn = kk[nt] * inv;
                const f32x4 ka = *(const LAS f32x4*)(PRM + 4 * 512 + c4), rk = *(const LAS f32x4*)(PRM + 5 * 512 + c4);
                kp[hh] = kv[nt] * (1.0f + (a - 1.0f) * ka);
                const f32x4 pr = rv[nt] * kp[hh] * rk; cbp += (pr[0] + pr[1]) + (pr[2] + pr[3]);
                nk[hh] = -kkn; nb[hh] = kkn * a;
            }
            st16_wt(sp + 1 * 64 + cl, PK8(kp[0], kp[1]));
            st16_wt(sp + 2 * 64 + cl, PK8(nk[0], nk[1]));
            st16_wt(sp + 3 * 64 + cl, PK8(nb[0], nb[1]));
        }
#undef PK8
        cbp += __shfl_xor(cbp, 16); cbp += __shfl_xor(cbp, 32);
        if (fq == 0) cb[tok * 8 + h] = cbp;
    }
    __syncthreads();
}

__device__ __forceinline__ void red16x2(float& a, float& b) {
    a += dpp_f<0x140>(a); b += dpp_f<0x140>(b);
    a += dpp_f<0x141>(a); b += dpp_f<0x141>(b);
    a += dpp_f<0xB1>(a);  b += dpp_f<0xB1>(b);
    a += dpp_f<0x4E>(a);  b += dpp_f<0x4E>(b);
}
__device__ __forceinline__ void red16x4(float& a, float& b, float& c, float& d) {
    a += dpp_f<0x140>(a); b += dpp_f<0x140>(b); c += dpp_f<0x140>(c); d += dpp_f<0x140>(d);
    a += dpp_f<0x141>(a); b += dpp_f<0x141>(b); c += dpp_f<0x141>(c); d += dpp_f<0x141>(d);
    a += dpp_f<0xB1>(a);  b += dpp_f<0xB1>(b);  c += dpp_f<0xB1>(c);  d += dpp_f<0xB1>(d);
    a += dpp_f<0x4E>(a);  b += dpp_f<0x4E>(b);  c += dpp_f<0x4E>(c);  d += dpp_f<0x4E>(d);
}
__device__ __forceinline__ void scan_item(const Frame& F, int item) {
    const int bh = item >> 2, rq = item & 3, b = bh >> 3, h = bh & 7, lane = F.lane, wave = F.wave;
    const bf16_t* sc = (const bf16_t*)(F.ws + WS_SC) + (size_t)bh * SEQ * 384;
    float* Y = (float*)(F.ws + WS_Y);
    LAS float* buf = (LAS float*)F.lds;
    constexpr int CH = 32, NP = CH / 2, PSTR = 712, CHF = NP * PSTR;
    const int ltid = F.tid - 256;
    const int lpair = ltid >> 4, lsub = ltid & 15;
    u32x2 raw0A[6], raw1A[6], raw0B[6], raw1B[6];
#define SCAN_GL(S, c) do { const bf16_t* src_ = sc + ((size_t)(c) * CH + 2 * lpair) * 384 + lsub * 4; \
        _Pragma("unroll") for (int p = 0; p < 6; ++p) { raw0##S[p] = *(const u32x2*)(src_ + p * 64); raw1##S[p] = *(const u32x2*)(src_ + 384 + p * 64); } } while (0)
#define SCAN_LW(S, bi) do { LAS float* pp_ = buf + (bi) * CHF + lpair * PSTR; LAS float* dst_ = pp_ + lsub * 4; \
        f32x4 e0_ = unpack4(raw0##S[0]), k0_ = unpack4(raw0##S[1]), a0_ = unpack4(raw0##S[2]), b0_ = unpack4(raw0##S[3]), r0_ = unpack4(raw0##S[4]), v0_ = unpack4(raw0##S[5]); \
        f32x4 e1_ = unpack4(raw1##S[0]), k1_ = unpack4(raw1##S[1]), a1_ = unpack4(raw1##S[2]), b1_ = unpack4(raw1##S[3]), r1_ = unpack4(raw1##S[4]), v1_ = unpack4(raw1##S[5]); \
        f32x4 w0_, w1_; _Pragma("unroll") for (int k = 0; k < 4; ++k) { w0_[k] = __expf(-e0_[k]); w1_[k] = __expf(-e1_[k]); } \
        const f32x4 ba_ = b0_ * a1_, ka_ = k0_ * a1_, br_ = b0_ * r0_, kr_ = k0_ * r0_; \
        float s0_ = (ba_[0] + ba_[1]) + (ba_[2] + ba_[3]), s1_ = (ka_[0] + ka_[1]) + (ka_[2] + ka_[3]), s2_ = (br_[0] + br_[1]) + (br_[2] + br_[3]), s3_ = (kr_[0] + kr_[1]) + (kr_[2] + kr_[3]); \
        red16x4(s0_, s1_, s2_, s3_); \
        *(LAS f32x4*)(dst_) = a0_; *(LAS f32x4*)(dst_ + 64) = w0_ * a1_; *(LAS f32x4*)(dst_ + 128) = w0_ * r0_; *(LAS f32x4*)(dst_ + 192) = r1_; \
        *(LAS f32x4*)(dst_ + 256) = w0_ * w1_; *(LAS f32x4*)(dst_ + 320) = b0_ * w1_; *(LAS f32x4*)(dst_ + 384) = k0_ * w1_; *(LAS f32x4*)(dst_ + 448) = b1_; \
        *(LAS f32x4*)(dst_ + 512) = k1_; *(LAS f32x4*)(dst_ + 576) = v0_; *(LAS f32x4*)(dst_ + 640) = v1_; \
        if (lsub == 0) *(LAS f32x4*)(pp_ + 704) = (f32x4){s0_, s1_, s2_, s3_}; } while (0)
    if (wave >= 4) { SCAN_GL(A, 0); SCAN_GL(B, 1); SCAN_LW(A, 0); SCAN_GL(A, 2); }
    __syncthreads();
    const int l16 = lane & 15, rl = wave * 4 + (lane >> 4), row = rq * 16 + rl, c4 = l16 * 4;
    f32x2 s01 = (f32x2){0.f, 0.f}, s23 = s01;
    f32x4 rprev = (f32x4){0.f, 0.f, 0.f, 0.f};
    float ykeep = 0.f;
    LAS float* ybuf = buf + 2 * CHF;
    LAS float* ywr = ybuf + l16 * 16 + rl;
    float* yflush = Y + ((size_t)b * SEQ + (ltid >> 2)) * 512 + h * 64 + rq * 16 + (ltid & 3) * 4;
#define SCAN_FLUSH(f) do { if (ltid < 128) { const f32x4 yv_ = *(const LAS f32x4*)(ybuf + ((f) & 3) * 512 + (ltid >> 2) * 16 + (ltid & 3) * 4); st16_wt(yflush + (size_t)(f) * 32 * 512, __builtin_bit_cast(u32x4, yv_)); } } while (0)
#define DOT4(x) ({ f32x2 p_ = s01 * (f32x2){(x)[0], (x)[1]}; p_ = __builtin_elementwise_fma(s23, (f32x2){(x)[2], (x)[3]}, p_); p_[0] + p_[1]; })
#define LDP(P, q) const f32x4 P##a = *(const LAS f32x4*)((q) + c4), P##wa = *(const LAS f32x4*)((q) + 64 + c4), P##wr = *(const LAS f32x4*)((q) + 128 + c4), P##r1 = *(const LAS f32x4*)((q) + 192 + c4), \
        P##ww = *(const LAS f32x4*)((q) + 256 + c4), P##bw = *(const LAS f32x4*)((q) + 320 + c4), P##kw = *(const LAS f32x4*)((q) + 384 + c4), P##b1 = *(const LAS f32x4*)((q) + 448 + c4), \
        P##k1 = *(const LAS f32x4*)((q) + 512 + c4), P##sc = *(const LAS f32x4*)((q) + 704); const float P##v0 = (q)[576 + row], P##v1 = (q)[640 + row]
    for (int c = 0; c < SEQ / CH; ++c) {
        if (wave >= 4) {
            if (c + 1 < SEQ / CH) {
                if ((c + 1) & 1) { SCAN_LW(B, 1); if (c + 3 < SEQ / CH) SCAN_GL(B, c + 3); }
                else { SCAN_LW(A, 0); if (c + 3 < SEQ / CH) SCAN_GL(A, c + 3); }
            }
            if (c >= 2) SCAN_FLUSH(c - 2);
        }
        else {
            const LAS float* bp = buf + (c & 1) * CHF;
            f32x4 Ca, Cwa, Cwr, Cr1, Cww, Cbw, Ckw, Cb1, Ck1, Csc; float Cv0, Cv1;
            { LDP(T, bp); Ca = Ta; Cwa = Twa; Cwr = Twr; Cr1 = Tr1; Cww = Tww; Cbw = Tbw; Ckw = Tkw; Cb1 = Tb1; Ck1 = Tk1; Csc = Tsc; Cv0 = Tv0; Cv1 = Tv1; }
#pragma unroll 1
            for (int hb = 0; hb < 2; ++hb) {
#pragma unroll
                for (int i = 0; i < 8; ++i) {
                    const int p = hb * 8 + i;
                    const LAS float* qn = bp + ((p + 1 < NP) ? (p + 1) : (NP - 1)) * PSTR;
                    LDP(N, qn);
                    float d0 = DOT4(rprev), d1 = DOT4(Ca), d2 = DOT4(Cwa), d3 = DOT4(Cwr);
                    red16x4(d0, d1, d2, d3);
                    ykeep = (l16 == ((2 * i + 15) & 15)) ? d0 : ykeep;
                    if (i == 0) { const int blk = 2 * c + hb - 1; if (blk >= 0) ywr[((blk >> 1) & 3) * 512 + (blk & 1) * 256] = ykeep; }
                    const float sa0 = d1;
                    const float yt = __builtin_fmaf(sa0, Csc[2], __builtin_fmaf(Cv0, Csc[3], d3));
                    ykeep = (l16 == (2 * i)) ? yt : ykeep;
                    const float sa1 = __builtin_fmaf(sa0, Csc[0], __builtin_fmaf(Cv0, Csc[1], d2));
                    const f32x2 a0v = (f32x2){sa0, sa0}, a1v = (f32x2){sa1, sa1}, v0v = (f32x2){Cv0, Cv0}, v1v = (f32x2){Cv1, Cv1};
                    f32x2 t01 = (f32x2){Ckw[0], Ckw[1]} * v0v, t23 = (f32x2){Ckw[2], Ckw[3]} * v0v;
                    t01 = __builtin_elementwise_fma((f32x2){Cbw[0], Cbw[1]}, a0v, t01); t23 = __builtin_elementwise_fma((f32x2){Cbw[2], Cbw[3]}, a0v, t23);
                    t01 = __builtin_elementwise_fma((f32x2){Ck1[0], Ck1[1]}, v1v, t01); t23 = __builtin_elementwise_fma((f32x2){Ck1[2], Ck1[3]}, v1v, t23);
                    t01 = __builtin_elementwise_fma((f32x2){Cb1[0], Cb1[1]}, a1v, t01); t23 = __builtin_elementwise_fma((f32x2){Cb1[2], Cb1[3]}, a1v, t23);
                    s01 = __builtin_elementwise_fma(s01, (f32x2){Cww[0], Cww[1]}, t01); s23 = __builtin_elementwise_fma(s23, (f32x2){Cww[2], Cww[3]}, t23);
                    rprev = Cr1;
                    Ca = Na; Cwa = Nwa; Cwr = Nwr; Cr1 = Nr1; Cww = Nww; Cbw = Nbw; Ckw = Nkw; Cb1 = Nb1; Ck1 = Nk1; Csc = Nsc; Cv0 = Nv0; Cv1 = Nv1;
                }
            }
        }
        __syncthreads();
    }
    if (wave < 4) {
        float d0 = DOT4(rprev), z1 = 0.f, z2 = 0.f, z3 = 0.f; red16x4(d0, z1, z2, z3);
        ykeep = (l16 == 15) ? d0 : ykeep;
        ywr[3 * 512 + 256] = ykeep;
    }
    __syncthreads();
    if (wave >= 4) { SCAN_FLUSH(SEQ / CH - 2); SCAN_FLUSH(SEQ / CH - 1); }
    __syncthreads();
#undef SCAN_FLUSH
#undef SCAN_GL
#undef SCAN_LW
#undef DOT4
#undef LDP
}
__device__ __forceinline__ void post_rows(const Frame& F, int e) {
    const float* Y = (const float*)(F.ws + WS_Y); const bf16_t* sc = (const bf16_t*)(F.ws + WS_SC); const float* cb = (const float*)(F.ws + WS_CB);
    bf16_t* ymix = (bf16_t*)(F.ws + WS_YMIX);
    const float* lg = inp<23>() + e * 512; const float* lb = inp<24>() + e * 512;
    const int lane = F.lane, hh = lane >> 3;
    for (int tl = (F.bid >> 3) * 8 + F.wave; tl < SEQ; tl += F.G) {
        const int tok = (F.bid & 7) * SEQ + tl;
        const int b = tok / SEQ, t = tok % SEQ;
        const f32x4 y0 = *(const f32x4*)(Y + (size_t)tok * 512 + lane * 8), y1 = *(const f32x4*)(Y + (size_t)tok * 512 + lane * 8 + 4);
        float yv[8] = {y0[0], y0[1], y0[2], y0[3], y1[0], y1[1], y1[2], y1[3]};
        float s = 0.f;
#pragma unroll
        for (int k = 0; k < 8; ++k) s += yv[k];
        s += __shfl_xor(s, 1); s += __shfl_xor(s, 2); s += __shfl_xor(s, 4);
        const float mean = s * (1.0f / 64.0f); float qv = 0.f;
#pragma unroll
        for (int k = 0; k < 8; ++k) { yv[k] -= mean; qv += yv[k] * yv[k]; }
        qv += __shfl_xor(qv, 1); qv += __shfl_xor(qv, 2); qv += __shfl_xor(qv, 4);
        const float rstd = rsqrtf(qv * (1.0f / 64.0f) + 64e-5f);
        const u32x4 vr = *(const u32x4*)(sc + ((size_t)(b * 8 + hh) * SEQ + t) * 384 + 5 * 64 + (lane & 7) * 8);
        bf16_t* gp = ymix + (size_t)tok * DM + 512 + lane * 8;
        const u32x4 gr = *(const u32x4*)gp;
        const float cbv = cb[(size_t)tok * 8 + hh];
        float vv[8] = {bflo(vr.x), bfhi(vr.x), bflo(vr.y), bfhi(vr.y), bflo(vr.z), bfhi(vr.z), bflo(vr.w), bfhi(vr.w)};
        float gg[8] = {bflo(gr.x), bfhi(gr.x), bflo(gr.y), bfhi(gr.y), bflo(gr.z), bfhi(gr.z), bflo(gr.w), bfhi(gr.w)};
        float o[8];
#pragma unroll
        for (int k = 0; k < 8; ++k) o[k] = (yv[k] * rstd * lg[lane * 8 + k] + lb[lane * 8 + k] + cbv * vv[k]) * gg[k];
        u32x4 ow; ow.x = pk2(o[0], o[1]); ow.y = pk2(o[2], o[3]); ow.z = pk2(o[4], o[5]); ow.w = pk2(o[6], o[7]);
        st16_wt(gp, ow);
    }
}

__device__ __forceinline__ void conv_item(const Frame& F, int item, int o) {
    const int b = item >> 6, tt = item & 63, t0 = tt * 32, c = F.tid, lane = F.lane, wave = F.wave;
    const bf16_t* z = (const bf16_t*)(F.ws + WS_ACT);
    bf16_t* ymix = (bf16_t*)(F.ws + WS_YMIX);
    const float* cw = inp<31>() + (size_t)o * 31 * 512; const float* cbias = inp<32>() + o * 512;
    const float* lg = inp<33>() + o * 512; const float* lb = inp<34>() + o * 512;
    LAS float* co = (LAS float*)F.lds;
    const size_t tokb = (size_t)b * SEQ;
    float hv[62];
#pragma unroll
    for (int i = 0; i < 62; ++i) {
        const int t = t0 - 30 + i; float hval = 0.f;
        if (t >= 0) { const bf16_t* zp = z + (tokb + t) * POP + 416 + c; const float za = bf1(zp[0]), zg = bf1(zp[512]); hval = za * sigmoidf_(zg); }
        hv[i] = hval;
    }
    float wv[31];
#pragma unroll
    for (int k = 0; k < 31; ++k) wv[k] = cw[k * 512 + c];
    const float bias = cbias[c];
#pragma unroll
    for (int i = 0; i < 32; ++i) {
        float a = bias;
#pragma unroll
        for (int k = 0; k < 31; ++k) a += wv[k] * hv[i + k];
        co[i * 512 + c] = a;
    }
    {
        const int token = F.tid >> 4, i = F.tid & 15, t = t0 + token;
        const bf16_t* zp = z + (tokb + t) * POP + 384;
        const float x1 = bf1(zp[i]), x2 = bf1(zp[16 + i]);
        const float cs = ((const float*)(F.ws + WS_COS))[t * 16 + i], sn = ((const float*)(F.ws + WS_SIN))[t * 16 + i];
        bf16_t* kr = (bf16_t*)(F.ws + WS_SC + SC_KR) + (tokb + t) * 32;
        const int kp_ = 8 * (i >> 2) + (i & 3);
        kr[kp_] = (bf16_t)(pk2(x1 * cs - x2 * sn, 0.f) & 0xffffu); kr[kp_ + 4] = (bf16_t)(pk2(x1 * sn + x2 * cs, 0.f) & 0xffffu);
    }
    __syncthreads();
#pragma unroll
    for (int j = 0; j < 4; ++j) {
        const int ti = wave * 4 + j;
        const f32x4 v0 = *(const LAS f32x4*)(co + ti * 512 + lane * 8), v1 = *(const LAS f32x4*)(co + ti * 512 + lane * 8 + 4);
        float v[8] = {v0[0], v0[1], v0[2], v0[3], v1[0], v1[1], v1[2], v1[3]};
        float s = 0.f;
#pragma unroll
        for (int k = 0; k < 8; ++k) s += v[k];
        const float mean = wave_sum(s) * (1.0f / 512.0f); float qv = 0.f;
#pragma unroll
        for (int k = 0; k < 8; ++k) { v[k] -= mean; qv += v[k] * v[k]; }
        const float rstd = rsqrtf(wave_sum(qv) * (1.0f / 512.0f) + 1e-5f);
        float ov[8];
#pragma unroll
        for (int k = 0; k < 8; ++k) { const float y = v[k] * rstd * lg[lane * 8 + k] + lb[lane * 8 + k]; ov[k] = y * sigmoidf_(y); }
        u32x4 ow; ow.x = pk2(ov[0], ov[1]); ow.y = pk2(ov[2], ov[3]); ow.z = pk2(ov[4], ov[5]); ow.w = pk2(ov[6], ov[7]);
        st16_wt(ymix + (tokb + t0 + ti) * DM + 512 + lane * 8, ow);
    }
    __syncthreads();
}

constexpr int AT_KS = 104, AT_VS = 80, AT_KB = 64 * AT_KS * 2, AT_VB = 64 * AT_VS * 2, AT_BUF = AT_KB + AT_VB;
typedef short v4i16_t __attribute__((ext_vector_type(4)));
__device__ __forceinline__ void attn_unit(const Frame& F, int b, int h, int qb) {
    const int lane = F.lane, wave = F.wave, tid = F.tid, fr = lane & 15, fq = lane >> 4;
    const bf16_t* Q = (const bf16_t*)(F.ws + WS_SC + SC_Q); const bf16_t* KV = (const bf16_t*)(F.ws + WS_SC + SC_KV); const bf16_t* KR = (const bf16_t*)(F.ws + WS_SC + SC_KR);
    bf16_t* ymix = (bf16_t*)(F.ws + WS_YMIX);
    const size_t tokb = (size_t)b * SEQ;
    const int q0 = qb * 256 + wave * 32;
    const int ntb = 4 * qb + 4, ntw = 4 * qb + 1 + (wave >> 1);
    bf16x8 qf[2][3];
#pragma unroll
    for (int mt = 0; mt < 2; ++mt)
#pragma unroll
        for (int ks = 0; ks < 3; ++ks) qf[mt][ks] = *(const bf16x8*)(Q + (tokb + q0 + mt * 16 + fr) * 768 + h * 96 + ks * 32 + fq * 8);
    const int key0 = tid / 12, ch0 = tid % 12, key1 = (tid + 512) / 12, ch1 = (tid + 512) % 12;
    const bool has1 = tid < 256;
    const int vkey = tid >> 3, vch = tid & 7;
    const bf16_t* ksrc0 = (ch0 < 8) ? KV + (tokb + key0) * 1024 + h * 128 + ch0 * 8 : KR + (tokb + key0) * 32 + (ch0 - 8) * 8;
    const bf16_t* ksrc1 = (ch1 < 8) ? KV + (tokb + key1) * 1024 + h * 128 + ch1 * 8 : KR + (tokb + key1) * 32 + (ch1 - 8) * 8;
    const int kstr0 = (ch0 < 8) ? 64 * 1024 : 64 * 32, kstr1 = (ch1 < 8) ? 64 * 1024 : 64 * 32;
    const bf16_t* vsrc = KV + (tokb + vkey) * 1024 + h * 128 + 64 + vch * 8;
    const unsigned kdst0 = key0 * (AT_KS * 2) + ch0 * 16, kdst1 = key1 * (AT_KS * 2) + ch1 * 16;
    u32x4 rk0[2], rk1[2], rv[2];
#pragma unroll
    for (int k = 0; k < 2; ++k) { rk0[k] = (u32x4){0u, 0u, 0u, 0u}; rk1[k] = rk0[k]; rv[k] = rk0[k]; }
#define AT_GLOAD(j, st) do { rk0[st] = *(const u32x4*)(ksrc0 + (size_t)(j) * kstr0); if (has1) rk1[st] = *(const u32x4*)(ksrc1 + (size_t)(j) * kstr1); rv[st] = *(const u32x4*)(vsrc + (size_t)(j) * 64 * 1024); } while (0)
#define AT_LSTORE(bi, st) do { LAS unsigned char* kb_ = F.lds + (bi) * AT_BUF; LAS bf16_t* vb_ = (LAS bf16_t*)(kb_ + AT_KB); \
        *(LAS u32x4*)(kb_ + kdst0) = rk0[st]; if (has1) *(LAS u32x4*)(kb_ + kdst1) = rk1[st]; \
        *(LAS u32x4*)(vb_ + vkey * AT_VS + vch * 8) = rv[st]; } while (0)
    f32x4 o[2][4];
#pragma unroll
    for (int mt = 0; mt < 2; ++mt)
#pragma unroll
        for (int dt = 0; dt < 4; ++dt) o[mt][dt] = (f32x4){0.f, 0.f, 0.f, 0.f};
    float mrun[2] = {-INFINITY, -INFINITY}, lsum[2] = {0.f, 0.f};
#pragma unroll
    for (int k = 0; k < 2; ++k) AT_GLOAD(k, k);
    for (int j0 = 0; j0 < ntb; j0 += 2) {
#pragma unroll
      for (int kk = 0; kk < 2; ++kk) {
        const int j = j0 + kk;
        AT_LSTORE(j & 1, kk);
        __syncthreads();
        if (j + 2 < ntb) AT_GLOAD(j + 2, kk);
        if (j < ntw) {
            const LAS unsigned char* kb = F.lds + (j & 1) * AT_BUF; const LAS bf16_t* vb = (const LAS bf16_t*)(kb + AT_KB);
            f32x4 st[2][4];
#pragma unroll
            for (int kt = 0; kt < 4; ++kt) {
                st[0][kt] = (f32x4){0.f, 0.f, 0.f, 0.f}; st[1][kt] = st[0][kt];
#pragma unroll
                for (int ks = 0; ks < 3; ++ks) {
                    const bf16x8 X = *(const LAS bf16x8*)(kb + (kt * 16 + fr) * (AT_KS * 2) + (ks * 32 + fq * 8) * 2);
                    st[0][kt] = __builtin_amdgcn_mfma_f32_16x16x32_bf16(X, qf[0][ks], st[0][kt], 0, 0, 0);
                    st[1][kt] = __builtin_amdgcn_mfma_f32_16x16x32_bf16(X, qf[1][ks], st[1][kt], 0, 0, 0);
                }
            }
            bf16x8 Yp[2][2];
#pragma unroll
            for (int mt = 0; mt < 2; ++mt) {
                float mx = fmaxf(fmaxf(st[mt][0][0], st[mt][0][1]), fmaxf(st[mt][0][2], st[mt][0][3]));
#pragma unroll
                for (int kt = 1; kt < 4; ++kt) mx = fmaxf(mx, fmaxf(fmaxf(st[mt][kt][0], st[mt][kt][1]), fmaxf(st[mt][kt][2], st[mt][kt][3])));
                mx = fmaxf(mx, __shfl_xor(mx, 16)); mx = fmaxf(mx, __shfl_xor(mx, 32));
                const float mnew = fmaxf(mrun[mt], mx), alpha = __builtin_amdgcn_exp2f(mrun[mt] - mnew);
                mrun[mt] = mnew;
                float ps = 0.f;
#pragma unroll
                for (int kt = 0; kt < 4; ++kt)
#pragma unroll
                    for (int k = 0; k < 4; ++k) { st[mt][kt][k] = __builtin_amdgcn_exp2f(st[mt][kt][k] - mnew); ps += st[mt][kt][k]; }
                lsum[mt] = lsum[mt] * alpha + ps;
#pragma unroll
                for (int dt = 0; dt < 4; ++dt) o[mt][dt] = o[mt][dt] * alpha;
#pragma unroll
                for (int g2 = 0; g2 < 2; ++g2) {
                    u32x4 pw; pw.x = pk2(st[mt][2 * g2][0], st[mt][2 * g2][1]); pw.y = pk2(st[mt][2 * g2][2], st[mt][2 * g2][3]); pw.z = pk2(st[mt][2 * g2 + 1][0], st[mt][2 * g2 + 1][1]); pw.w = pk2(st[mt][2 * g2 + 1][2], st[mt][2 * g2 + 1][3]);
                    Yp[mt][g2] = __builtin_bit_cast(bf16x8, pw);
                }
            }
#pragma unroll
            for (int g2 = 0; g2 < 2; ++g2)
#pragma unroll
                for (int dt = 0; dt < 4; ++dt) {
                    const LAS bf16_t* vp = vb + (g2 * 32 + fq * 4 + (fr >> 2)) * AT_VS + 32 * (dt >> 1) + 8 * (fr & 3) + 4 * (dt & 1);
                    const v4i16_t lo = __builtin_amdgcn_ds_read_tr16_b64_v4i16((LAS v4i16_t*)vp), hi = __builtin_amdgcn_ds_read_tr16_b64_v4i16((LAS v4i16_t*)(vp + 16 * AT_VS));
                    const bf16x8 Xv = (bf16x8){lo[0], lo[1], lo[2], lo[3], hi[0], hi[1], hi[2], hi[3]};
                    o[0][dt] = __builtin_amdgcn_mfma_f32_16x16x32_bf16(Xv, Yp[0][g2], o[0][dt], 0, 0, 0);
                    o[1][dt] = __builtin_amdgcn_mfma_f32_16x16x32_bf16(Xv, Yp[1][g2], o[1][dt], 0, 0, 0);
                }
        }
      }
    }
#undef AT_GLOAD
#undef AT_LSTORE
#pragma unroll
    for (int mt = 0; mt < 2; ++mt) {
        float ls = lsum[mt]; ls += __shfl_xor(ls, 16); ls += __shfl_xor(ls, 32);
        const float il = 1.0f / ls;
#pragma unroll
        for (int a2 = 0; a2 < 2; ++a2) { const u32x2 p0 = pack4(o[mt][2 * a2] * il), p1 = pack4(o[mt][2 * a2 + 1] * il);
            st16_wt(ymix + (tokb + q0 + mt * 16 + fr) * DM + h * 64 + 32 * a2 + 8 * fq, (u32x4){p0.x, p0.y, p1.x, p1.y}); }
    }
    __syncthreads();
}

constexpr int NPHASE = 1 + 9 * DEPTH + 1;
__global__ void __launch_bounds__(512, 2) mk_fwd(Args args) {
    extern __shared__ __attribute__((aligned(16))) unsigned char lds_raw[];
    Frame F;
    F.lds = (LAS unsigned char*)lds_raw;
    F.tid = threadIdx.x; F.lane = F.tid & 63; F.wave = __builtin_amdgcn_readfirstlane(F.tid >> 6);
    F.G = gridDim.x; F.bid = blockIdx.x; F.out = args.out; F.ws = args.ws;
    const int lo = args.ph_lo, hi = args.ph_hi;
    cg::grid_group grid = cg::this_grid();
    volatile LAS unsigned* bst = (volatile LAS unsigned*)(F.lds + 135168);
    if (threadIdx.x < 8) bst[threadIdx.x] = 0u;
    __syncthreads();
    XcdBarrier xbar = xcd_barrier_post((unsigned*)args.ws, bst);
    int vbid = blockIdx.x; bool regular = false;
#define IN(k) (lo <= (k) && (k) < hi)
#define ENTER() do { int t_ = threadIdx.x; int b_ = vbid; asm volatile("" : "+v"(t_), "+s"(b_)); F.tid = t_; F.lane = t_ & 63; F.wave = __builtin_amdgcn_readfirstlane(t_ >> 6); F.bid = b_; } while (0)
#define SEAM(k) do { if (IN(k) && IN((k) + 1)) { if (regular && (k) != 0 && (((k) - 1) % 9) != 8) xcd_local_barrier(xbar); else xcd_barrier(xbar); } } while (0)

    if (lo > hi) grid.sync();
    if (IN(0)) { ENTER(); { convert_layer(F, 0, 0, 1, F.bid, F.G); x_prologue(F); } }
    SEAM(0);
    if (IN(0) && IN(1)) {
        const unsigned reg_ = bst[2], rank_ = bst[3];
        regular = __builtin_amdgcn_readfirstlane((int)reg_) != 0;
        if (regular) vbid = __builtin_amdgcn_readfirstlane((int)(rank_ * 8u + xbar.x));
    }
    for (int l = 0; l < DEPTH; ++l) {
        const int p0 = 1 + 9 * l; const bool odd = l & 1; const int hl = l >> 1;
        size_t z0 = 0; asm volatile("" : "+s"(z0));
        unsigned char* ws = args.ws + z0;
        F.ws = ws;
        float* ssq = (float*)(ws + WS_SSQ);
        bf16_t* xb = (bf16_t*)(ws + WS_XB); bf16_t* ymix = (bf16_t*)(ws + WS_YMIX); bf16_t* act = (bf16_t*)(ws + WS_ACT);
        const unsigned char* wb = ws + WS_WBUF0 + (size_t)(l & 1) * WBUF_BYTES;
        if (IN(p0 + 0)) {
            ENTER();
            pg8::Gemm g{xb, (const bf16_t*)(wb + WB_W1IN), T, 2 * FF, DM, DM, DM}; pg8::StaticOrder S; S.init(T, 2 * FF, F.G, F.bid);
            EpiSwiGLU E{act, ssq}; pg8::gemm_phase(F.lds, g, S, E);
            ENTER();
            if (l + 1 < DEPTH) {
                const int nfull = ((T / 256) * (2 * FF / 256)) % F.G;
                if (nfull == 0) { __syncthreads(); convert_layer(F, l + 1, 0, 2, F.bid, F.G); }
                else if (F.bid >= nfull) { __syncthreads(); convert_layer(F, l + 1, 0, 2, F.bid - nfull, F.G - nfull); }
            }
        }
        SEAM(p0 + 0);
        if (IN(p0 + 1)) {
            ENTER();
            pg8::Gemm g{act, (const bf16_t*)(wb + WB_W1OUT), T, DM, FF, FF, FF}; pg8::StaticOrder S; S.init(T, DM, F.G, F.bid);
            EpiResid E{xb, ssq, 0.5f}; pg8::gemm_phase(F.lds, g, S, E);
        }
        SEAM(p0 + 1);
        if (IN(p0 + 2)) {
            ENTER();
            if (odd) { pg8::Gemm g{xb, (const bf16_t*)(wb + WB_WMIN), T, POP, DM, DM, DM}; pg8::StaticOrder S; S.init(T, POP, F.G, F.bid);
                EpiZ<true> E{act, POP, ssq, (float*)(ws + WS_PQ), (float*)(ws + WS_PKV)}; pg8::gemm_phase(F.lds, g, S, E); }
            else { pg8::Gemm g{xb, (const bf16_t*)(wb + WB_WMIN), T, PE, DM, DM, DM}; pg8::StaticOrder S; S.init(T, PE, F.G, F.bid);
                EpiZ<false> E{act, PE, ssq, nullptr, nullptr}; pg8::gemm_phase(F.lds, g, S, E); }
        }
        SEAM(p0 + 2);
        if (IN(p0 + 3)) {
            ENTER();
            if (odd) {
                pg8::Gemm g{act, (const bf16_t*)(wb + WB_WX), T, 1792, 384, POP, 384}; pg8::StaticOrder S; S.init(T, 1792, F.G, F.bid);
                EpiUp E{(bf16_t*)(ws + WS_SC + SC_Q), (bf16_t*)(ws + WS_SC + SC_KV), (const float*)(ws + WS_PQ), (const float*)(ws + WS_PKV), (const float*)(ws + WS_COS), (const float*)(ws + WS_SIN)};
                pg8::gemm_phase(F.lds, g, S, E);
                __syncthreads();
                ENTER();
                for (int j = F.bid >> 3; j < 64; j += F.G >> 3) conv_item(F, (F.bid & 7) * 64 + j, hl);
            } else {
                for (int j = F.bid >> 3; j < 64; j += F.G >> 3) prep_item(F, (F.bid & 7) * 64 + j, hl, wb);
                for (int j = F.bid >> 3; j < 64; j += F.G >> 3) gsu_item(F, (F.bid & 7) * 64 + j, hl);
            }
        }
        SEAM(p0 + 3);
        if (IN(p0 + 4)) {
            ENTER();
            if (odd) {
                for (int j = F.bid >> 3; j < 32; j += F.G >> 3) {
                    const int bh = (F.bid & 7) * 8 + (j & 7), pr = j >> 3;
                    attn_unit(F, bh >> 3, bh & 7, pr);
                    attn_unit(F, bh >> 3, bh & 7, 7 - pr);
                }
            } else {
                for (int j = F.bid >> 3; j < 32; j += F.G >> 3) scan_item(F, (F.bid & 7) * 32 + j);
            }
        }
        SEAM(p0 + 4);
        if (IN(p0 + 5)) { ENTER(); if (!odd) post_rows(F, hl); }
        if (!odd) SEAM(p0 + 5);
        if (IN(p0 + 6)) {
            ENTER();
            pg8::Gemm g{ymix, (const bf16_t*)(wb + WB_WMOUT), T, DM, DM, DM, DM}; pg8::StaticOrder S; S.init(T, DM, F.G, F.bid);
            EpiResid E{xb, ssq, 1.0f}; pg8::gemm_phase(F.lds, g, S, E);
        }
        SEAM(p0 + 6);
        if (IN(p0 + 7)) {
            ENTER();
            pg8::Gemm g{xb, (const bf16_t*)(wb + WB_W2IN), T, 2 * FF, DM, DM, DM}; pg8::StaticOrder S; S.init(T, 2 * FF, F.G, F.bid);
            EpiSwiGLU E{act, ssq}; pg8::gemm_phase(F.lds, g, S, E);
            ENTER();
            if (l + 1 < DEPTH) {
                const int nfull = ((T / 256) * (2 * FF / 256)) % F.G;
                if (nfull == 0) { __syncthreads(); convert_layer(F, l + 1, 1, 2, F.bid, F.G); }
                else if (F.bid >= nfull) { __syncthreads(); convert_layer(F, l + 1, 1, 2, F.bid - nfull, F.G - nfull); }
            }
        }
        SEAM(p0 + 7);
        if (IN(p0 + 8)) {
            ENTER();
            pg8::Gemm g{act, (const bf16_t*)(wb + WB_W2OUT), T, DM, FF, FF, FF}; pg8::StaticOrder S; S.init(T, DM, F.G, F.bid);
            EpiResid E{xb, ssq, 0.5f}; pg8::gemm_phase(F.lds, g, S, E);
        }
        SEAM(p0 + 8);
    }
    if (IN(NPHASE - 1)) { ENTER(); final_norm(F); }
#undef IN
#undef SEAM
#undef ENTER
}

extern "C" void kernel_launch(void* const* d_in, const int* in_sizes, int n_in, void* d_out, int out_size, void* d_ws, size_t ws_size, hipStream_t stream) {
    static int grid = 0;
    if (grid == 0) {
        if (n_in != 36 || out_size != T * DM || ws_size < WS_END) { fprintf(stderr, "kernel_launch: unexpected shapes (n_in %d out %d ws %zu)\n", n_in, out_size, ws_size); grid = -1; return; }
        int dev = 0, cus = 0, per_cu = 0;
        (void)hipGetDevice(&dev); (void)hipDeviceGetAttribute(&cus, hipDeviceAttributeMultiprocessorCount, dev);
        (void)hipFuncSetAttribute((const void*)mk_fwd, hipFuncAttributeMaxDynamicSharedMemorySize, LDS_BYTES);
        (void)hipOccupancyMaxActiveBlocksPerMultiprocessor(&per_cu, (const void*)mk_fwd, 512, LDS_BYTES);
        if (per_cu < 1) per_cu = 1;
        grid = cus * per_cu; if (grid > 256) grid = 256; if (grid < 1) grid = 256;
        (void)hipGetLastError();
    }
    if (grid < 0) return;
    (void)hipMemsetAsync(d_ws, 0, 32768, stream);
    Args a{};
    for (int i = 0; i < 36; ++i) a.in[i] = (const float*)d_in[i];
    a.out = (float*)d_out; a.ws = (unsigned char*)d_ws;
#if MK_MULTI
    for (int p = 0; p < NPHASE; ++p) {
        if (p >= 1 && p < NPHASE - 1) { const int l = (p - 1) / 9, k = (p - 1) % 9; if ((l & 1) && k == 5) continue; }
        a.ph_lo = p; a.ph_hi = p + 1;
        hipLaunchKernelGGL(mk_fwd, dim3(grid), dim3(512), LDS_BYTES, stream, a);
    }
#else
    a.ph_lo = 0; a.ph_hi = NPHASE;
    void* kargs[] = {&a};
    hipError_t e = hipLaunchCooperativeKernel((const void*)mk_fwd, dim3(grid), dim3(512), kargs, LDS_BYTES, stream);
    if (e != hipSuccess) fprintf(stderr, "cooperative launch failed: %s (grid %d)\n", hipGetErrorString(e), grid);
#endif
}
```

```cpp
#include <hip/hip_runtime.h>
#include <hip/hip_cooperative_groups.h>
#include <cstdio>
#include <cstdint>
namespace cg = cooperative_groups;

#ifndef MK_MULTI
#define MK_MULTI 0
#endif

#define LAS __attribute__((address_space(3)))
typedef unsigned short bf16_t;
typedef short bf16x8 __attribute__((ext_vector_type(8)));
typedef float f32x4 __attribute__((ext_vector_type(4)));
typedef float f32x2 __attribute__((ext_vector_type(2)));
typedef unsigned u32x4 __attribute__((ext_vector_type(4)));
typedef unsigned u32x2 __attribute__((ext_vector_type(2)));
typedef __bf16 bf16x2_t __attribute__((ext_vector_type(2)));

constexpr int T = 16384, DM = 1024, FF = 2816, SEQ = 2048, NBATCH = 8, DEPTH = 4;
constexpr int PE = 2816, PO = 1440, POP = 1536;
constexpr int PB = 1792;
constexpr float RMS_EPS = 1e-6f;
constexpr float QSCALE = 0.10206207261596575f * 1.4426950408889634f;

constexpr size_t MiB = 1u << 20;
constexpr size_t WS_SSQ = 1 * MiB;
constexpr size_t WS_PQ = 2 * MiB;
constexpr size_t WS_PKV = 2 * MiB + 256 * 1024;
constexpr size_t WS_COS = 2 * MiB + 512 * 1024;
constexpr size_t WS_SIN = 2 * MiB + 640 * 1024;
constexpr size_t WS_CB = 3 * MiB;
constexpr size_t WS_WBUF0 = 4 * MiB, WBUF_BYTES = 42 * MiB;
constexpr size_t WS_XB = 88 * MiB;
constexpr size_t WS_YMIX = 120 * MiB;
constexpr size_t WS_ACT = 152 * MiB;
constexpr size_t WS_SC = 240 * MiB;
constexpr size_t WS_Y = 336 * MiB;
constexpr size_t WS_END = 368 * MiB;
constexpr size_t WB_W1IN = 0, WB_W1OUT = 11534336, WB_W2IN = 17301504, WB_W2OUT = 28835840, WB_WMIN = 34603008, WB_WMOUT = 40370176, WB_WX = 42467328;
constexpr size_t SC_Q = 0, SC_KV = 24 * MiB, SC_KR = 56 * MiB;

constexpr int LDS_BYTES = 147456;

__device__ __forceinline__ unsigned pk2(float lo, float hi) { f32x2 v = {lo, hi}; bf16x2_t b = __builtin_convertvector(v, bf16x2_t); return __builtin_bit_cast(unsigned, b); }
__device__ __forceinline__ float bflo(unsigned u) { return __uint_as_float(u << 16); }
__device__ __forceinline__ float bfhi(unsigned u) { return __uint_as_float(u & 0xffff0000u); }
__device__ __forceinline__ float bf1(bf16_t h) { return __uint_as_float((unsigned)h << 16); }
__device__ __forceinline__ f32x4 unpack4(u32x2 u) { return (f32x4){bflo(u.x), bfhi(u.x), bflo(u.y), bfhi(u.y)}; }
__device__ __forceinline__ u32x2 pack4(f32x4 v) { u32x2 r; r.x = pk2(v[0], v[1]); r.y = pk2(v[2], v[3]); return r; }
template <int CTRL> __device__ __forceinline__ float dpp_f(float x) { return __int_as_float(__builtin_amdgcn_update_dpp(0, __float_as_int(x), CTRL, 0xF, 0xF, true)); }
__device__ __forceinline__ float red16(float x) {
    x += dpp_f<0x140>(x);
    x += dpp_f<0x141>(x);
    x += dpp_f<0xB1>(x);
    x += dpp_f<0x4E>(x);
    return x;
}
__device__ __forceinline__ void st16_wt(void* p, u32x4 v) { asm volatile("global_store_dwordx4 %0, %1, off\n\ts_nop 1" :: "v"(p), "v"(v) : "memory"); }
__device__ __forceinline__ void st8_wt(void* p, u32x2 v) { asm volatile("global_store_dwordx2 %0, %1, off" :: "v"(p), "v"(v) : "memory"); }
__device__ __forceinline__ float wave_sum(float v) {
    v = red16(v);
    v += __shfl_xor(v, 16); v += __shfl_xor(v, 32);
    return v;
}
__device__ __forceinline__ float sigmoidf_(float x) { return __builtin_amdgcn_rcpf(1.0f + __expf(-x)); }
__device__ __forceinline__ float gelu_tanh(float x) { const float u = 1.5957691216057308f * (x + 0.044715f * x * x * x); return x * __builtin_amdgcn_rcpf(1.0f + __expf(-u)); }
__device__ __forceinline__ float tanh_(float x) { return 1.0f - 2.0f * __builtin_amdgcn_rcpf(1.0f + __expf(2.0f * x)); }

namespace pg8 {
constexpr int BM = 256, BK = 64, HALF = 128, HTB = HALF * BK * 2, STAGE_BYTES = 8 * HTB, NXCD = 8, WGM = 8;
__host__ __device__ __forceinline__ int lds_byte(int r, int c) { const int st = (r >> 4) * 2 + (c >> 5), rr = r & 15, cc = c & 31, ob = rr * 64 + cc * 2; return st * 1024 + (ob ^ (((ob >> 9) & 1) << 5)); }
__host__ __device__ __forceinline__ int perm32(int rho) { const int n = rho >> 4, i = rho & 15; return 8 * (i >> 2) + 4 * n + (i & 3); }
__host__ __device__ __forceinline__ void stage_rc(int b, int& R, int& C) { const int st = b / 1024, sb = b % 1024, swz = sb ^ (((sb >> 9) & 1) << 5); R = (st >> 1) * 16 + swz / 64; C = (st & 1) * 32 + (swz % 64) / 2; }
struct Unit { int pm, pn; };
struct Gemm { const bf16_t* A; const bf16_t* Bt; int M, N, K, lda, ldb; };
struct StaticOrder {
    int nM, nN, nwg, G, c;
    __device__ void init(int M, int N, int G_, int c_) { nM = M / BM; nN = N / BM; nwg = nM * nN; G = G_; c = c_; }
    __device__ bool next(int i, Unit& u) const {
        const int L = i * G + c; if (L >= nwg) return false;
        int wgid = L; { const int q = nwg / NXCD, r = nwg % NXCD, xcd = wgid % NXCD, off = wgid / NXCD; wgid = (xcd < r ? xcd * (q + 1) : r * (q + 1) + (xcd - r) * q) + off; }
        const int nig = WGM * nN, gid = wgid / nig, fm = gid * WGM, gsz = (nM - fm) < WGM ? (nM - fm) : WGM;
        u.pm = fm + ((wgid % nig) % gsz); u.pn = (wgid % nig) / gsz; return true;
    }
};
template <class Epi>
__device__ __forceinline__ void gemm_phase(LAS unsigned char* lds, const Gemm g, const StaticOrder& S, const Epi& E) {
    int tid_ = threadIdx.x; asm volatile("" : "+v"(tid_));
    const int tid = tid_, wid = __builtin_amdgcn_readfirstlane(tid >> 6), lane = tid & 63, wr = wid >> 2, wc = wid & 3, fr = lane & 15, fq = lane >> 4;
    const int K = g.K, nt = K / BK;
    unsigned voffA[2], voffB[2];
#pragma unroll
    for (int i = 0; i < 2; ++i) { int R, C; stage_rc(tid * 16 + i * 8192, R, C); const int Rb = Epi::PERM ? ((R & ~31) + perm32(R & 31)) : R; voffA[i] = (unsigned)(R * g.lda + C) * 2u; voffB[i] = (unsigned)(Rb * g.ldb + C) * 2u; }
    const size_t kstep = (size_t)(BK * 2);
    const size_t hsA = (size_t)HALF * g.lda * 2, hsB = (size_t)HALF * g.ldb * 2;
    const size_t tsA = 2 * hsA, tsB = 2 * hsB;
    const unsigned ldsw = (unsigned)wid * 1024u;
    const int aoff = lds_byte(wr * 64 + fr, fq * 8), boff = lds_byte(wc * 32 + fr, fq * 8);
#define PG8_SA(b, h) (((b) * 2 + (h)) * HTB)
#define PG8_SB(b, h) ((4 + (b) * 2 + (h)) * HTB)
#define PG8_STAGE(bufoff, gbase, voff) do { _Pragma("unroll") for (int _i = 0; _i < 2; ++_i) \
        __builtin_amdgcn_global_load_lds((const unsigned*)((const char*)(gbase) + (voff)[_i]), (LAS unsigned*)(lds + (bufoff) + ldsw + _i * 8192), 16, 0, 0); } while (0)
#define PG8_LDA(dst, b, h) do { _Pragma("unroll") for (int m = 0; m < 4; ++m) _Pragma("unroll") for (int k = 0; k < 2; ++k) dst[m][k] = *(const LAS bf16x8*)(lds + PG8_SA(b, h) + aoff + m * 2048 + k * 1024); } while (0)
#define PG8_LDB(dst, b, h) do { _Pragma("unroll") for (int n = 0; n < 2; ++n) _Pragma("unroll") for (int k = 0; k < 2; ++k) dst[n][k] = *(const LAS bf16x8*)(lds + PG8_SB(b, h) + boff + n * 2048 + k * 1024); } while (0)
#define PG8_MMA(ai, bj, At, Bt) do { __builtin_amdgcn_s_setprio(1); _Pragma("unroll") for (int m = 0; m < 4; ++m) _Pragma("unroll") for (int n = 0; n < 2; ++n) _Pragma("unroll") for (int k = 0; k < 2; ++k) \
        acc[ai][bj][m][n] = __builtin_amdgcn_mfma_f32_16x16x32_bf16(Bt[n][k], At[m][k], acc[ai][bj][m][n], 0, 0, 0); __builtin_amdgcn_s_setprio(0); } while (0)
#define PG8_WAIT_V(n) asm volatile("s_waitcnt vmcnt(" #n ")" ::: "memory")
#define PG8_WAIT_L(n) asm volatile("s_waitcnt lgkmcnt(" #n ")" ::: "memory")
#define PG8_BAR __builtin_amdgcn_s_barrier()
#define PG8_SCHED __builtin_amdgcn_sched_barrier(0)
    Unit cur, nxt; int ui = 0;
    if (!S.next(0, cur)) return;
    f32x4 acc[2][2][4][2];
#pragma unroll
    for (int a = 0; a < 2; ++a)
#pragma unroll
        for (int b = 0; b < 2; ++b)
#pragma unroll
            for (int m = 0; m < 4; ++m)
#pragma unroll
                for (int n = 0; n < 2; ++n) acc[a][b][m][n] = (f32x4){0.f, 0.f, 0.f, 0.f};
    bf16x8 At[4][2], B0[2][2], B1[2][2];
    const char* cA = (const char*)g.A + (size_t)cur.pm * tsA; const char* cB = (const char*)g.Bt + (size_t)cur.pn * tsB;
    PG8_STAGE(PG8_SB(0, 0), cB, voffB); PG8_STAGE(PG8_SB(0, 1), cB + hsB, voffB); PG8_STAGE(PG8_SA(0, 0), cA, voffA); PG8_STAGE(PG8_SA(0, 1), cA + hsA, voffA);
    if (wr == 1) PG8_BAR;
    PG8_WAIT_V(2); PG8_BAR;
    PG8_STAGE(PG8_SB(1, 0), cB + kstep, voffB); PG8_STAGE(PG8_SA(1, 0), cA + kstep, voffA); PG8_STAGE(PG8_SB(1, 1), cB + hsB + kstep, voffB);
    PG8_WAIT_V(6); PG8_BAR;
    for (;;) {
        const bool has_next = S.next(ui + 1, nxt);
        const char* nA = has_next ? (const char*)g.A + (size_t)nxt.pm * tsA : cA; const char* nB = has_next ? (const char*)g.Bt + (size_t)nxt.pn * tsB : cB;
#pragma unroll 1
        for (int t = 0; t < nt; t += 2) {
            const bool last = (t == nt - 2);
            const char* a1 = cA + (size_t)(t + 1) * kstep;
            const char* a2 = last ? nA : cA + (size_t)(t + 2) * kstep; const char* b2 = last ? nB : cB + (size_t)(t + 2) * kstep;
            const char* a3 = a2 + kstep; const char* b3 = b2 + kstep;
            PG8_LDB(B0, 0, 0); PG8_LDB(B1, 0, 1); PG8_SCHED; PG8_LDA(At, 0, 0); PG8_STAGE(PG8_SA(1, 1), a1 + hsA, voffA);
            PG8_WAIT_V(8); PG8_WAIT_L(0); PG8_BAR; PG8_MMA(0, 0, At, B0); PG8_MMA(0, 1, At, B1); PG8_BAR; PG8_SCHED;
            PG8_LDA(At, 0, 1); PG8_STAGE(PG8_SB(0, 0), b2, voffB); PG8_STAGE(PG8_SB(0, 1), b2 + hsB, voffB); PG8_STAGE(PG8_SA(0, 0), a2, voffA);
            PG8_WAIT_V(8); PG8_WAIT_L(0); PG8_BAR; PG8_MMA(1, 0, At, B0); PG8_MMA(1, 1, At, B1); PG8_BAR; PG8_SCHED;
            PG8_LDB(B0, 1, 0); PG8_LDB(B1, 1, 1); PG8_SCHED; PG8_LDA(At, 1, 0); PG8_STAGE(PG8_SA(0, 1), a2 + hsA, voffA);
            PG8_WAIT_V(8); PG8_WAIT_L(0); PG8_BAR; PG8_MMA(0, 0, At, B0); PG8_MMA(0, 1, At, B1); PG8_BAR; PG8_SCHED;
            PG8_LDA(At, 1, 1); PG8_STAGE(PG8_SB(1, 0), b3, voffB); PG8_STAGE(PG8_SB(1, 1), b3 + hsB, voffB); PG8_STAGE(PG8_SA(1, 0), a3, voffA);
            PG8_WAIT_V(8); PG8_WAIT_L(0); PG8_BAR; PG8_MMA(1, 0, At, B0); PG8_MMA(1, 1, At, B1); PG8_BAR; PG8_SCHED;
        }
        if (wr == 0) PG8_BAR;
        E(acc, cur, wr, wc, fr, fq);
        if (!has_next) break;
#pragma unroll
        for (int a = 0; a < 2; ++a)
#pragma unroll
            for (int b = 0; b < 2; ++b)
#pragma unroll
                for (int m = 0; m < 4; ++m)
#pragma unroll
                    for (int n = 0; n < 2; ++n) acc[a][b][m][n] = (f32x4){0.f, 0.f, 0.f, 0.f};
        cur = nxt; cA = nA; cB = nB; ++ui;
        if (wr == 1) PG8_BAR;
    }
    PG8_WAIT_V(0);
    PG8_BAR;
#undef PG8_SA
#undef PG8_SB
#undef PG8_STAGE
#undef PG8_LDA
#undef PG8_LDB
#undef PG8_MMA
#undef PG8_WAIT_V
#undef PG8_WAIT_L
#undef PG8_BAR
#undef PG8_SCHED
}
}
using pg8::Unit;

__device__ __forceinline__ void rows_rstd16(const float* ssq, int row0, int fq, float (&rs)[8]) {
    float p[8][4];
#pragma unroll
    for (int i = 0; i < 8; ++i) { const unsigned o = (unsigned)(4 * fq) * T + row0 + (i >> 2) * 128 + (i & 3) * 16;
#pragma unroll
        for (int k = 0; k < 4; ++k) p[i][k] = ssq[o + k * T]; }
#pragma unroll
    for (int i = 0; i < 8; ++i) { float s = (p[i][0] + p[i][1]) + (p[i][2] + p[i][3]); s += __shfl_xor(s, 16); s += __shfl_xor(s, 32); rs[i] = rsqrtf(s * (1.0f / 1024.0f) + RMS_EPS); }
}
__device__ __forceinline__ void rows_rstd4(const float* pp, int row0, int fq, float invw, float mul, float (&rs)[8]) {
    float p[8];
#pragma unroll
    for (int i = 0; i < 8; ++i) p[i] = pp[(unsigned)fq * T + (unsigned)(row0 + (i >> 2) * 128 + (i & 3) * 16)];
#pragma unroll
    for (int i = 0; i < 8; ++i) { float s = p[i]; s += __shfl_xor(s, 16); s += __shfl_xor(s, 32); rs[i] = rsqrtf(s * invw + RMS_EPS) * mul; }
}

struct EpiSwiGLU {
    static constexpr bool PERM = false;
    bf16_t* act; const float* ssq;
    __device__ __forceinline__ void operator()(const f32x4 (&acc)[2][2][4][2], const Unit& u, int wr, int wc, int fr, int fq) const {
        const int row0 = u.pm * 256 + wr * 64 + fr;
        const unsigned off0 = (unsigned)row0 * FF + u.pn * 128 + wc * 32 + fq * 8;
        float rsv[8]; rows_rstd16(ssq, row0, fq, rsv);
#pragma unroll
        for (int ai = 0; ai < 2; ++ai)
#pragma unroll
            for (int m = 0; m < 4; ++m) {
                const float rs = rsv[ai * 4 + m];
                u32x4 w;
#pragma unroll
                for (int bj = 0; bj < 2; ++bj) {
                    const f32x4 gt = acc[ai][bj][m][0] * rs, up = acc[ai][bj][m][1] * rs; f32x4 o;
#pragma unroll
                    for (int k = 0; k < 4; ++k) o[k] = gt[k] * up[k] * __builtin_amdgcn_rcpf(1.0f + __expf(-gt[k]));
                    const u32x2 pw = pack4(o); if (bj == 0) { w.x = pw.x; w.y = pw.y; } else { w.z = pw.x; w.w = pw.y; }
                }
                st16_wt(act + (off0 + (unsigned)((ai * 128 + m * 16) * FF)), w);
            }
    }
};
struct EpiResid {
    static constexpr bool PERM = true;
    bf16_t* xb; float* ssq; float scale;
    __device__ __forceinline__ void operator()(const f32x4 (&acc)[2][2][4][2], const Unit& u, int wr, int wc, int fr, int fq) const {
        const int row0 = u.pm * 256 + wr * 64 + fr;
        const unsigned off0 = (unsigned)row0 * DM + u.pn * 256 + wc * 32 + fq * 8;
        const unsigned so = (unsigned)(u.pn * 4 + wc) * T + row0;
#pragma unroll
        for (int ai = 0; ai < 2; ++ai) {
            u32x4 bv[4][2];
#pragma unroll
            for (int m = 0; m < 4; ++m)
#pragma unroll
                for (int bj = 0; bj < 2; ++bj) bv[m][bj] = *(const u32x4*)(xb + (off0 + (unsigned)((ai * 128 + m * 16) * DM + bj * 128)));
#pragma unroll
            for (int m = 0; m < 4; ++m) {
                float ss = 0.f;
#pragma unroll
                for (int bj = 0; bj < 2; ++bj) {
                    const unsigned o2 = off0 + (unsigned)((ai * 128 + m * 16) * DM + bj * 128);
                    const f32x4 v0 = unpack4((u32x2){bv[m][bj].x, bv[m][bj].y}) + acc[ai][bj][m][0] * scale;
                    const f32x4 v1 = unpack4((u32x2){bv[m][bj].z, bv[m][bj].w}) + acc[ai][bj][m][1] * scale;
                    const u32x2 p0 = pack4(v0), p1 = pack4(v1);
                    st16_wt(xb + o2, (u32x4){p0.x, p0.y, p1.x, p1.y});
                    ss += ((v0[0] * v0[0] + v0[1] * v0[1]) + (v0[2] * v0[2] + v0[3] * v0[3])) + ((v1[0] * v1[0] + v1[1] * v1[1]) + (v1[2] * v1[2] + v1[3] * v1[3]));
                }
                ss += __shfl_xor(ss, 16); ss += __shfl_xor(ss, 32);
                if (fq == 0) ssq[so + (unsigned)(ai * 128 + m * 16)] = ss;
            }
            asm volatile("" ::: "memory");
        }
    }
};
template <bool ODD> struct EpiZ {
    static constexpr bool PERM = true;
    bf16_t* z; int ldz; const float* ssq; float* pq; float* pkv;
    __device__ __forceinline__ void operator()(const f32x4 (&acc)[2][2][4][2], const Unit& u, int wr, int wc, int fr, int fq) const {
        const int row0 = u.pm * 256 + wr * 64 + fr;
        const unsigned off0 = (unsigned)row0 * ldz + u.pn * 256 + wc * 32 + fq * 8;
        float rsv[8]; rows_rstd16(ssq, row0, fq, rsv);
#pragma unroll
        for (int ai = 0; ai < 2; ++ai)
#pragma unroll
            for (int m = 0; m < 4; ++m) {
                const int row = row0 + ai * 128 + m * 16;
                const float rs = rsv[ai * 4 + m];
                float s0 = 0.f, s1 = 0.f;
#pragma unroll
                for (int bj = 0; bj < 2; ++bj) {
                    const f32x4 v0 = acc[ai][bj][m][0] * rs, v1 = acc[ai][bj][m][1] * rs;
                    const u32x2 p0 = pack4(v0), p1 = pack4(v1);
                    st16_wt(z + (off0 + (unsigned)((ai * 128 + m * 16) * ldz + bj * 128)), (u32x4){p0.x, p0.y, p1.x, p1.y});
                    const float q = ((v0[0] * v0[0] + v0[1] * v0[1]) + (v0[2] * v0[2] + v0[3] * v0[3])) + ((v1[0] * v1[0] + v1[1] * v1[1]) + (v1[2] * v1[2] + v1[3] * v1[3]));
                    if (bj == 0) s0 += q; else s1 += q;
                }
                if (ODD) {
                    if (u.pn == 0) { float s = s0 + s1; s += __shfl_xor(s, 16); s += __shfl_xor(s, 32); if (fq == 0) pq[(unsigned)wc * T + row] = s; }
                    else if (u.pn == 1) { float s = s0; s += __shfl_xor(s, 16); s += __shfl_xor(s, 32); if (fq == 0) pkv[(unsigned)wc * T + row] = s; }
                }
            }
    }
};
struct EpiUp {
    static constexpr bool PERM = true;
    bf16_t* q; bf16_t* kv; const float* pq; const float* pkv; const float* cosT; const float* sinT;
    __device__ __forceinline__ void operator()(const f32x4 (&acc)[2][2][4][2], const Unit& u, int wr, int wc, int fr, int fq) const {
        const int row0 = u.pm * 256 + wr * 64 + fr;
        float rsv[8];
        if (u.pn < 3) {
            rows_rstd4(pq, row0, fq, 1.0f / 256.0f, QSCALE, rsv);
#pragma unroll
            for (int bj = 0; bj < 2; ++bj) {
                const int G = u.pn * 8 + bj * 4 + wc;
                const bool rope = (G % 3) == 2;
#pragma unroll
                for (int ai = 0; ai < 2; ++ai)
#pragma unroll
                    for (int m = 0; m < 4; ++m) {
                        const int row = row0 + ai * 128 + m * 16; const float rs = rsv[ai * 4 + m];
                        f32x4 v0 = acc[ai][bj][m][0] * rs, v1 = acc[ai][bj][m][1] * rs;
                        if (rope) {
                            const int pos = row & (SEQ - 1);
                            const f32x4 c4 = *(const f32x4*)(cosT + (unsigned)(pos * 16 + fq * 4)), s4 = *(const f32x4*)(sinT + (unsigned)(pos * 16 + fq * 4));
                            const f32x4 o0 = v0 * c4 - v1 * s4, o1 = v0 * s4 + v1 * c4; v0 = o0; v1 = o1;
                        }
                        const u32x2 p0 = pack4(v0), p1 = pack4(v1);
                        st16_wt(q + (unsigned)(row * 768 + G * 32 + fq * 8), (u32x4){p0.x, p0.y, p1.x, p1.y});
                    }
            }
        } else {
            rows_rstd4(pkv, row0, fq, 1.0f / 128.0f, 1.0f, rsv);
#pragma unroll
            for (int ai = 0; ai < 2; ++ai)
#pragma unroll
                for (int m = 0; m < 4; ++m) {
                    const int row = row0 + ai * 128 + m * 16; const float rs = rsv[ai * 4 + m];
#pragma unroll
                    for (int bj = 0; bj < 2; ++bj) {
                        const u32x2 p0 = pack4(acc[ai][bj][m][0] * rs), p1 = pack4(acc[ai][bj][m][1] * rs);
                        st16_wt(kv + (unsigned)(row * 1024 + (u.pn - 3) * 256 + bj * 128 + wc * 32 + fq * 8), (u32x4){p0.x, p0.y, p1.x, p1.y});
                    }
                }
        }
    }
};

#define XB_TMO      128
#define XB_XCNT(j)  (256  + 64 * (j))
#define XB_XSUB(j)  (1280 + 64 * (j))
#define XB_XGEN(j)  (2304 + 64 * (j))
#define XB_TOP      3328
#define XB_TOPGEN   3392
#define XCD_BAR_WORDS 3456
#define XB_LSUB(j)  (3456 + 64 * (j))
#define XB_LGEN(j)  (4480 + 64 * (j))
#define XB_SPIN_CAP (1u << 18)
__device__ __forceinline__ unsigned xb_ld(unsigned* p)              { return __hip_atomic_load(p, __ATOMIC_RELAXED, __HIP_MEMORY_SCOPE_AGENT); }
__device__ __forceinline__ unsigned xb_add(unsigned* p, unsigned v) { return __hip_atomic_fetch_add(p, v, __ATOMIC_RELAXED, __HIP_MEMORY_SCOPE_AGENT); }
__device__ __forceinline__ unsigned xb_xcc_id() { return (unsigned)__builtin_amdgcn_s_getreg((3 << 11) | 20) & 0xFu; }
#define XB_SPIN(cond, bar) do { unsigned _sp = 0; while (cond) { __builtin_amdgcn_s_sleep(1); \
    if ((++_sp & 255u) == 0u) { if (xb_ld(&(bar)[XB_TMO])) break; if (_sp > XB_SPIN_CAP) { atomicAdd(&(bar)[XB_TMO], 1u); break; } } } } while (0)
struct XcdBarrier { unsigned* bar; unsigned x; volatile LAS unsigned* st; };
__device__ __forceinline__ XcdBarrier xcd_barrier_post(unsigned* bar, volatile LAS unsigned* st) {
    XcdBarrier b; b.bar = bar; b.x = xb_xcc_id(); b.st = st;
    if (threadIdx.x == 0) st[3] = xb_add(&bar[XB_XCNT(b.x)], 1u);
    return b;
}
__device__ __forceinline__ void xcd_barrier_complete(unsigned* bar, unsigned x, unsigned& nloc, unsigned& nx, unsigned& regular) {
    const unsigned G = gridDim.x * gridDim.y * gridDim.z;
    unsigned sum, cnt, mine, sp = 0u;
    for (;;) {
        sum = 0u; cnt = 0u; mine = 0u;
#pragma unroll
        for (unsigned j = 0; j < 16; ++j) { const unsigned c = xb_ld(&bar[XB_XCNT(j)]); sum += c; cnt += (c > 0u) ? 1u : 0u; mine = (j == x) ? c : mine; }
        if (sum == G) break;
        __builtin_amdgcn_s_sleep(1);
        if ((++sp & 255u) == 0u) { if (xb_ld(&bar[XB_TMO])) break; if (sp > XB_SPIN_CAP) { atomicAdd(&bar[XB_TMO], 1u); break; } }
    }
    nloc = mine > 0u ? mine : 1u; nx = cnt > 0u ? cnt : 1u;
    unsigned reg = (G == 256u) ? 1u : 0u;
#pragma unroll
    for (unsigned j = 0; j < 16; ++j) { const unsigned c = xb_ld(&bar[XB_XCNT(j)]); if (c != (j < 8u ? 32u : 0u)) reg = 0u; }
    regular = reg;
}
__device__ __forceinline__ void xcd_barrier(const XcdBarrier& b) {
    asm volatile("s_waitcnt vmcnt(0)" ::: "memory");
    __syncthreads();
    if (threadIdx.x == 0) {
        unsigned* bar = b.bar;
        __builtin_amdgcn_s_waitcnt(0);
        unsigned nloc = b.st[0], nx = b.st[1];
        if (nloc == 0u) { unsigned reg_; xcd_barrier_complete(bar, b.x, nloc, nx, reg_); b.st[0] = nloc; b.st[1] = nx; b.st[2] = reg_; }
        const unsigned old = xb_add(&bar[XB_XSUB(b.x)], 1u);
        const unsigned gen = old / nloc;
        if (old + 1u == (gen + 1u) * nloc) {
            __builtin_amdgcn_fence(__ATOMIC_RELEASE, "agent");
            asm volatile("s_waitcnt vmcnt(0)" ::: "memory");
            const unsigned og = xb_add(&bar[XB_TOP], 1u);
            const unsigned tg = og / nx;
            if (og + 1u == (tg + 1u) * nx) xb_add(&bar[XB_TOPGEN], 1u);
            else XB_SPIN(xb_ld(&bar[XB_TOPGEN]) == tg, bar);
            __builtin_amdgcn_fence(__ATOMIC_ACQUIRE, "agent");
            xb_add(&bar[XB_XGEN(b.x)], 1u);
            asm volatile("s_waitcnt vmcnt(0)" ::: "memory");
        } else {
            XB_SPIN(xb_ld(&bar[XB_XGEN(b.x)]) == gen, bar);
            __builtin_amdgcn_fence(__ATOMIC_ACQUIRE, "agent");
            asm volatile("s_waitcnt vmcnt(0)" ::: "memory");
        }
    }
    __syncthreads();
}
__device__ __forceinline__ void xcd_local_barrier(const XcdBarrier& b) {
    asm volatile("s_waitcnt vmcnt(0)" ::: "memory");
    __syncthreads();
    if (threadIdx.x == 0) {
        unsigned* bar = b.bar;
        __builtin_amdgcn_s_waitcnt(0);
        const unsigned nloc = b.st[0];
        const unsigned old = xb_add(&bar[XB_LSUB(b.x)], 1u);
        const unsigned gen = old / nloc;
        if (old + 1u == (gen + 1u) * nloc) xb_add(&bar[XB_LGEN(b.x)], 1u);
        else XB_SPIN(xb_ld(&bar[XB_LGEN(b.x)]) == gen, bar);
        __builtin_amdgcn_fence(__ATOMIC_ACQUIRE, "agent");
        asm volatile("s_waitcnt vmcnt(0)" ::: "memory");
    }
    __syncthreads();
}
template <int K> __device__ __forceinline__ const float* inp() {
    unsigned long long v;
    const unsigned long long kp_ = (unsigned long long)__builtin_amdgcn_kernarg_segment_ptr();
    const unsigned long long kps_ = ((unsigned long long)(unsigned)__builtin_amdgcn_readfirstlane((int)(unsigned)(kp_ >> 32)) << 32) | (unsigned)__builtin_amdgcn_readfirstlane((int)(unsigned)kp_);
    asm volatile("s_load_dwordx2 %0, %1, %2\n\ts_waitcnt lgkmcnt(0)" : "=s"(v) : "s"(kps_), "n"(K * 8) : "memory");
    return (const float*)(const __attribute__((address_space(1))) float*)v;
}
struct Args { const float* in[36]; float* out; unsigned char* ws; int ph_lo, ph_hi; };
struct Frame {
    LAS unsigned char* lds;
    int tid, lane, wave, G, bid;
    float* out; unsigned char* ws;
};

struct CvtDesc { const float* W; const float* gain; bf16_t* WT; int N, ldt, kdst, mode, item; };
__device__ __forceinline__ void cvt_load(const CvtDesc& d, int lane, f32x4 (&v)[8], float (&g)[8]) {
    const int nblk = d.N / 32, kb = d.item / nblk, nb = d.item % nblk, k0 = 64 * kb, n0 = 32 * nb;
    const int kq = lane >> 3, nq = (lane & 7) * 4;
#pragma unroll
    for (int i = 0; i < 8; ++i) v[i] = *(const f32x4*)(d.W + (size_t)(k0 + i * 8 + kq) * d.N + n0 + nq);
#pragma unroll
    for (int i = 0; i < 8; ++i) g[i] = d.gain ? d.gain[k0 + i * 8 + kq] : 1.0f;
}
__device__ __forceinline__ void cvt_finish(const CvtDesc& d, int lane, LAS float* scr, const f32x4 (&v)[8], const float (&g)[8]) {
    const int nblk = d.N / 32, kb = d.item / nblk, nb = d.item % nblk, k0 = 64 * kb, n0 = 32 * nb;
    const int kq = lane >> 3, nq = (lane & 7) * 4;
#pragma unroll
    for (int i = 0; i < 8; ++i) { const int kk = i * 8 + kq; const float gk = g[i]; LAS float* dd = scr + kk * 33 + nq; dd[0] = v[i][0] * gk; dd[1] = v[i][1] * gk; dd[2] = v[i][2] * gk; dd[3] = v[i][3] * gk; }
    asm volatile("s_waitcnt lgkmcnt(0)" ::: "memory");
    const int c = lane & 7;
#pragma unroll
    for (int j = 0; j < 4; ++j) {
        const int n = (lane >> 3) + 8 * j; const LAS float* sp_ = scr + (8 * c) * 33 + n;
        u32x4 o; o.x = pk2(sp_[0 * 33], sp_[1 * 33]); o.y = pk2(sp_[2 * 33], sp_[3 * 33]); o.z = pk2(sp_[4 * 33], sp_[5 * 33]); o.w = pk2(sp_[6 * 33], sp_[7 * 33]);
        int nn = n0 + n;
        if (d.mode == 1) { const int which = nn >= FF ? 1 : 0, h = nn - which * FF, hl = h & 127; nn = 256 * (h >> 7) + 128 * ((hl >> 2) & 1) + 32 * (hl >> 5) + 16 * which + 4 * ((hl >> 3) & 3) + (hl & 3); }
        if (d.mode == 2) { const int hd = nn / 96, dd = nn % 96; if (dd >= 64) { const int r_ = dd - 64, n_ = r_ >> 4, i_ = r_ & 15; nn = hd * 96 + 64 + 8 * (i_ >> 2) + 4 * n_ + (i_ & 3); } }
        st16_wt(d.WT + (size_t)nn * d.ldt + d.kdst + k0 + 8 * c, o);
    }
    asm volatile("s_waitcnt lgkmcnt(0)" ::: "memory");
}
__device__ __forceinline__ void zero_fill16(unsigned char* base, int row_bytes_stride, int col_byte0, int chunks_per_row, int nrows, int gtid, int gthreads) {
    const int total = nrows * chunks_per_row;
    unsigned zz = 0u; asm volatile("" : "+v"(zz));
    const u32x4 z4 = (u32x4){zz, zz, zz, zz};
    for (int i = gtid; i < total; i += gthreads) { const int r = i / chunks_per_row, c = i % chunks_per_row; st16_wt(base + (size_t)r * row_bytes_stride + col_byte0 + c * 16, z4); }
}
__device__ __forceinline__ void convert_layer(const Frame& F, int l, int part, int nparts, int vb, int nvb) {
    unsigned char* wb = F.ws + WS_WBUF0 + (size_t)(l & 1) * WBUF_BYTES;
    LAS float* scr = (LAS float*)(F.lds + F.wave * 16384);
    const int gw = vb * 8 + F.wave, NGW = nvb * 8;
    const int hl = l >> 1; const bool odd = l & 1;
    constexpr int I_IN = 16 * 176, I_OUT = 44 * 32, I_MO = 16 * 32;
    const int I_MI = odd ? 16 * 45 : 16 * 88;
    const int I_X = odd ? (4 * 24 + 2 * 32) : (16 + 16 + 32);
    const int total = 2 * I_IN + 2 * I_OUT + I_MI + I_MO + I_X;
    const int it_lo = (int)((long)total * part / nparts), it_hi = (int)((long)total * (part + 1) / nparts);
    auto desc = [&](int it) -> CvtDesc {
        CvtDesc d; d.kdst = 0; d.mode = 0; d.gain = nullptr;
        int r = it;
        if (r < I_IN) { d.W = inp<2>() + (size_t)l * DM * 2 * FF; d.N = 2 * FF; d.gain = inp<1>() + l * DM; d.WT = (bf16_t*)(wb + WB_W1IN); d.ldt = DM; d.mode = 1; d.item = r; return d; } r -= I_IN;
        if (r < I_IN) { d.W = inp<6>() + (size_t)l * DM * 2 * FF; d.N = 2 * FF; d.gain = inp<5>() + l * DM; d.WT = (bf16_t*)(wb + WB_W2IN); d.ldt = DM; d.mode = 1; d.item = r; return d; } r -= I_IN;
        if (r < I_OUT) { d.W = inp<3>() + (size_t)l * FF * DM; d.N = DM; d.WT = (bf16_t*)(wb + WB_W1OUT); d.ldt = FF; d.item = r; return d; } r -= I_OUT;
        if (r < I_OUT) { d.W = inp<7>() + (size_t)l * FF * DM; d.N = DM; d.WT = (bf16_t*)(wb + WB_W2OUT); d.ldt = FF; d.item = r; return d; } r -= I_OUT;
        if (r < I_MI) {
            if (odd) { d.W = inp<25>() + (size_t)hl * DM * PO; d.N = PO; } else { d.W = inp<8>() + (size_t)hl * DM * PE; d.N = PE; }
            d.gain = inp<4>() + l * DM; d.WT = (bf16_t*)(wb + WB_WMIN); d.ldt = DM; d.item = r; return d; } r -= I_MI;
        if (r < I_MO) { d.W = (odd ? inp<26>() : inp<9>()) + (size_t)hl * DM * DM; d.N = DM; d.WT = (bf16_t*)(wb + WB_WMOUT); d.ldt = DM; d.item = r; return d; } r -= I_MO;
        if (odd) {
            if (r < 96) { d.W = inp<28>() + (size_t)hl * 256 * 768; d.N = 768; d.gain = inp<27>() + hl * 256; d.WT = (bf16_t*)(wb + WB_WX); d.ldt = 384; d.mode = 2; d.item = r; return d; } r -= 96;
            d.W = inp<30>() + (size_t)hl * 128 * 1024; d.N = 1024; d.gain = inp<29>() + hl * 128; d.WT = (bf16_t*)(wb + WB_WX) + (size_t)768 * 384; d.ldt = 384; d.kdst = 256; d.item = r; return d;
        }
        if (r < 16) { d.W = inp<16>() + (size_t)hl * 64 * 512; d.N = 512; d.WT = (bf16_t*)(wb + WB_WX); d.ldt = 64; d.item = r; return d; } r -= 16;
        if (r < 16) { d.W = inp<18>() + (size_t)hl * 64 * 512; d.N = 512; d.WT = (bf16_t*)(wb + WB_WX) + 512 * 64; d.ldt = 64; d.item = r; return d; } r -= 16;
        d.W = inp<19>() + (size_t)hl * 128 * 512; d.N = 512; d.WT = (bf16_t*)(wb + WB_WX) + 2 * 512 * 64; d.ldt = 128; d.item = r; return d;
    };
    {
        int it = it_lo + gw;
        if (it < it_hi) {
            CvtDesc d0 = desc(it), d1 = d0; f32x4 va[8], vc[8]; float ga[8], gc[8];
            cvt_load(d0, F.lane, va, ga);
            for (;;) {
                const int it1 = it + NGW; const bool h1 = it1 < it_hi;
                if (h1) { d1 = desc(it1); cvt_load(d1, F.lane, vc, gc); }
                cvt_finish(d0, F.lane, scr, va, ga);
                if (!h1) break;
                const int it2 = it1 + NGW; const bool h2 = it2 < it_hi;
                if (h2) { d0 = desc(it2); cvt_load(d0, F.lane, va, ga); }
                cvt_finish(d1, F.lane, scr, vc, gc);
                if (!h2) break;
                it = it2;
            }
        }
    }
    if (odd && part == 0) {
        const int gtid = vb * 512 + F.tid, gth = nvb * 512;
        zero_fill16(wb + WB_WMIN + (size_t)PO * DM * 2, DM * 2, 0, 128, POP - PO, gtid, gth);
        zero_fill16(wb + WB_WX, 384 * 2, 512, 16, 768, gtid, gth);
        zero_fill16(wb + WB_WX + (size_t)768 * 384 * 2, 384 * 2, 0, 32, 1024, gtid, gth);
    }
}

__device__ __forceinline__ void x_prologue(const Frame& F) {
    const float* x = inp<0>(); bf16_t* xb = (bf16_t*)(F.ws + WS_XB); float* ssq = (float*)(F.ws + WS_SSQ);
    const int gw = F.bid * 8 + F.wave, NGW = F.G * 8, lane = F.lane;
    for (int m = gw; m < T; m += NGW) {
        const f32x4* xr = (const f32x4*)(x + (size_t)m * DM) + lane;
        f32x4 v[4]; float s = 0.f;
#pragma unroll
        for (int j = 0; j < 4; ++j) { v[j] = xr[64 * j]; s += (v[j][0] * v[j][0] + v[j][1] * v[j][1]) + (v[j][2] * v[j][2] + v[j][3] * v[j][3]); }
        s = wave_sum(s);
        u32x2* o = (u32x2*)(xb + (size_t)m * DM) + lane;
#pragma unroll
        for (int j = 0; j < 4; ++j) st8_wt(o + 64 * j, pack4(v[j]));
        if (lane < 16) ssq[(size_t)lane * T + m] = (lane == 0) ? s : 0.f;
    }
    float* cosT = (float*)(F.ws + WS_COS); float* sinT = (float*)(F.ws + WS_SIN);
    for (int i = F.bid * 512 + F.tid; i < SEQ * 16; i += F.G * 512) {
        const int pos = i >> 4, k = i & 15;
        const float inv = exp2f(-(float)k * 0.8304820237218407f);
        const float ang = (float)pos * inv;
        const double rev = (double)ang * 0.15915494309189535;
        const float fr = (float)(rev - floor(rev));
        cosT[i] = __builtin_amdgcn_cosf(fr); sinT[i] = __builtin_amdgcn_sinf(fr);
    }
}
__device__ __forceinline__ void final_norm(const Frame& F) {
    const float* g = inp<35>(); float* x = F.out; const bf16_t* xb = (const bf16_t*)(F.ws + WS_XB);
    const int gw = F.bid * 8 + F.wave, NGW = F.G * 8, lane = F.lane;
    for (int m = gw; m < T; m += NGW) {
        f32x4* xr = (f32x4*)(x + (size_t)m * DM) + lane;
        const u32x2* br = (const u32x2*)(xb + (size_t)m * DM) + lane;
        f32x4 v[4]; float s = 0.f;
#pragma unroll
        for (int j = 0; j < 4; ++j) { v[j] = unpack4(br[64 * j]); s += (v[j][0] * v[j][0] + v[j][1] * v[j][1]) + (v[j][2] * v[j][2] + v[j][3] * v[j][3]); }
        s = wave_sum(s);
        const float rs = rsqrtf(s * (1.0f / 1024.0f) + RMS_EPS);
#pragma unroll
        for (int j = 0; j < 4; ++j) { const f32x4 gg = *((const f32x4*)g + lane + 64 * j); xr[64 * j] = v[j] * rs * gg; }
    }
}

__device__ __forceinline__ void gsu_item(const Frame& F, int item, int e) {
    const int nb = item >> 2, g = item & 3, tok0 = nb * 128, lane = F.lane, wave = F.wave, fr = lane & 15, fq = lane >> 4;
    const bf16_t* z = (const bf16_t*)(F.ws + WS_ACT);
    bf16_t* ymix = (bf16_t*)(F.ws + WS_YMIX);
    const float* ws = inp<10>() + (size_t)(e * 4 + g) * 128 * 128; const float* bs = inp<11>() + (e * 4 + g) * 128;
    const float* lng = inp<12>() + e * 512; const float* lnb = inp<13>() + e * 512;
    LAS bf16_t* vn = (LAS bf16_t*)F.lds;
    u32x4 zrs[16];
#pragma unroll
    for (int fi = 0; fi < 16; ++fi) zrs[fi] = *(const u32x4*)(z + (size_t)(tok0 + wave * 16 + fi) * PE + 512 + lane * 8);
    float lgv[8], lbv[8];
#pragma unroll
    for (int k = 0; k < 8; ++k) { lgv[k] = lng[lane * 8 + k]; lbv[k] = lnb[lane * 8 + k]; }
#pragma unroll
    for (int fi = 0; fi < 16; ++fi) {
        const int frame = wave * 16 + fi;
        const u32x4 zr = zrs[fi];
        float gv[8]; gv[0] = bflo(zr.x); gv[1] = bfhi(zr.x); gv[2] = bflo(zr.y); gv[3] = bfhi(zr.y); gv[4] = bflo(zr.z); gv[5] = bfhi(zr.z); gv[6] = bflo(zr.w); gv[7] = bfhi(zr.w);
        float s = 0.f;
#pragma unroll
        for (int k = 0; k < 8; ++k) { gv[k] = gelu_tanh(gv[k]); s += gv[k]; }
        const float mean = wave_sum(s) * (1.0f / 512.0f); float qv = 0.f;
#pragma unroll
        for (int k = 0; k < 8; ++k) { gv[k] -= mean; qv += gv[k] * gv[k]; }
        const float rstd = rsqrtf(wave_sum(qv) * (1.0f / 512.0f) + 1e-5f);
        if ((lane >> 4) == g) {
            const int cl = (lane & 15) * 8;
#pragma unroll
            for (int k = 0; k < 8; ++k) { const float o = gv[k] * rstd * lgv[k] + lbv[k]; vn[(cl + k) * 136 + frame] = (bf16_t)(pk2(o, 0.f) & 0xffffu); }
        }
    }
    __syncthreads();
    const int i = wave * 16 + fr; const int nks = (wave < 4) ? 2 : 4;
    f32x4 acc[8];
#pragma unroll
    for (int ct = 0; ct < 8; ++ct) acc[ct] = (f32x4){0.f, 0.f, 0.f, 0.f};
    for (int ks = 0; ks < nks; ++ks) {
        const float* wp = ws + (size_t)i * 128 + ks * 32 + fq * 8;
        const f32x4 w0 = *(const f32x4*)wp, w1 = *(const f32x4*)(wp + 4);
        u32x4 wy; wy.x = pk2(w0[0], w0[1]); wy.y = pk2(w0[2], w0[3]); wy.z = pk2(w1[0], w1[1]); wy.w = pk2(w1[2], w1[3]);
        const bf16x8 Y = __builtin_bit_cast(bf16x8, wy);
#pragma unroll
        for (int ct = 0; ct < 8; ++ct) {
            const bf16x8 X = *(const LAS bf16x8*)(vn + (ct * 16 + fr) * 136 + ks * 32 + fq * 8);
            acc[ct] = __builtin_amdgcn_mfma_f32_16x16x32_bf16(X, Y, acc[ct], 0, 0, 0);
        }
    }
    const size_t tok = tok0 + i; const float bsv = bs[i];
#pragma unroll
    for (int ct = 0; ct < 8; ++ct) {
        const int c = g * 128 + ct * 16 + fq * 4;
        const f32x4 uz = unpack4(*(const u32x2*)(z + tok * PE + c)); f32x4 o;
#pragma unroll
        for (int k = 0; k < 4; ++k) o[k] = gelu_tanh(uz[k]) * (acc[ct][k] + bsv);
        st8_wt(ymix + tok * DM + c, pack4(o));
    }
    __syncthreads();
}

__device__ __forceinline__ void prep_item(const Frame& F, int item, int e, const unsigned char* wb) {
    const int tok0 = item * 32, b = tok0 / SEQ, t0 = tok0 % SEQ, lane = F.lane, h = F.wave, fr = lane & 15, fq = lane >> 4, tid = F.tid;
    const bf16_t* z = (const bf16_t*)(F.ws + WS_ACT);
    bf16_t* ymix = (bf16_t*)(F.ws + WS_YMIX); bf16_t* sc = (bf16_t*)(F.ws + WS_SC); float* cb = (float*)(F.ws + WS_CB);
    const float* mu = inp<14>() + e * PB; const float* w0p = inp<15>() + e * 512; const float* a0p = inp<17>() + e * 512;
    const float* kkp = inp<20>() + e * 512; const float* kap = inp<21>() + e * 512; const float* rkp = inp<22>() + e * 512;
    LAS bf16_t* At = (LAS bf16_t*)F.lds;
    LAS float* PRM = (LAS float*)(F.lds + 32768);
    {
        PRM[0 * 512 + tid] = mu[tid]; PRM[1 * 512 + tid] = mu[512 + tid]; PRM[2 * 512 + tid] = mu[1024 + tid];
        PRM[3 * 512 + tid] = kkp[tid]; PRM[4 * 512 + tid] = kap[tid]; PRM[5 * 512 + tid] = rkp[tid];
        PRM[6 * 512 + tid] = w0p[tid]; PRM[7 * 512 + tid] = a0p[tid];
    }
    {
        const int token = tid >> 4, chunk = tid & 15, t = t0 + token; const size_t tok = tok0 + token;
        const bf16_t* zp = z + tok * PE + 2560 + chunk * 16;
        const u32x4 c0 = *(const u32x4*)zp, c1 = *(const u32x4*)(zp + 8);
        const bf16_t* zq = (t > 0) ? zp - PE : zp;
        u32x4 p0 = *(const u32x4*)zq, p1 = *(const u32x4*)(zq + 8);
        if (t == 0) { p0 = (u32x4){0u, 0u, 0u, 0u}; p1 = p0; }
        float cv[16], pv[16];
#pragma unroll
        for (int k = 0; k < 4; ++k) { cv[2 * k] = bflo(c0[k]); cv[2 * k + 1] = bfhi(c0[k]); cv[8 + 2 * k] = bflo(c1[k]); cv[9 + 2 * k] = bfhi(c1[k]);
                                      pv[2 * k] = bflo(p0[k]); pv[2 * k + 1] = bfhi(p0[k]); pv[8 + 2 * k] = bflo(p1[k]); pv[9 + 2 * k] = bfhi(p1[k]); }
        const f32x4* mup = (const f32x4*)(mu + 1536 + chunk * 16);
        const f32x4 m0 = mup[0], m1 = mup[1], m2 = mup[2], m3 = mup[3];
        const float mv_[16] = {m0[0], m0[1], m0[2], m0[3], m1[0], m1[1], m1[2], m1[3], m2[0], m2[1], m2[2], m2[3], m3[0], m3[1], m3[2], m3[3]};
#pragma unroll
        for (int k = 0; k < 16; ++k) cv[k] = cv[k] + mv_[k] * (pv[k] - cv[k]);
        if (chunk < 4) {
#pragma unroll
            for (int k = 0; k < 16; ++k) cv[k] = tanh_(cv[k]);
        } else if (chunk >= 8) {
#pragma unroll
            for (int k = 0; k < 16; ++k) cv[k] = sigmoidf_(cv[k]);
        }
        u32x4 o0, o1;
#pragma unroll
        for (int k = 0; k < 4; ++k) { o0[k] = pk2(cv[2 * k], cv[2 * k + 1]); o1[k] = pk2(cv[8 + 2 * k], cv[9 + 2 * k]); }
        *(LAS u32x4*)(At + token * 264 + chunk * 16) = o0; *(LAS u32x4*)(At + token * 264 + chunk * 16 + 8) = o1;
    }
    __syncthreads();
    const bf16_t* DUt = (const bf16_t*)(wb + WB_WX); const bf16_t* IUt = DUt + 512 * 64; const bf16_t* GUt = DUt + 2 * 512 * 64;
#pragma unroll
    for (int mt = 0; mt < 2; ++mt) {
        const LAS bf16_t* Ar = At + (mt * 16 + fr) * 264 + fq * 8;
        const int t = t0 + mt * 16 + fr; const size_t tok = tok0 + mt * 16 + fr; const bool hp = t > 0;
        f32x4 ev[4], av[4];
        {
            f32x4 acc[4];
#pragma unroll
            for (int nt = 0; nt < 4; ++nt) acc[nt] = (f32x4){0.f, 0.f, 0.f, 0.f};
#pragma unroll
            for (int ks = 0; ks < 2; ++ks) {
                const bf16x8 Yv = *(const LAS bf16x8*)(Ar + 0 + ks * 32);
#pragma unroll
                for (int nt = 0; nt < 4; ++nt) {
                    const bf16x8 X = *(const bf16x8*)(DUt + (size_t)(h * 64 + 32 * (nt >> 1) + 8 * (fr >> 2) + 4 * (nt & 1) + (fr & 3)) * 64 + ks * 32 + fq * 8);
                    acc[nt] = __builtin_amdgcn_mfma_f32_16x16x32_bf16(X, Yv, acc[nt], 0, 0, 0);
                }
            }
#pragma unroll
            for (int nt = 0; nt < 4; ++nt) {
                const f32x4 w0 = *(const LAS f32x4*)(PRM + 6 * 512 + h * 64 + 32 * (nt >> 1) + 8 * fq + 4 * (nt & 1));
#pragma unroll
                for (int k = 0; k < 4; ++k) ev[nt][k] = 0.6065306597126334f * __builtin_amdgcn_rcpf(1.0f + __expf(-(w0[k] + acc[nt][k])));
            }
        }
        {
            f32x4 acc[4];
#pragma unroll
            for (int nt = 0; nt < 4; ++nt) acc[nt] = (f32x4){0.f, 0.f, 0.f, 0.f};
#pragma unroll
            for (int ks = 0; ks < 2; ++ks) {
                const bf16x8 Yv = *(const LAS bf16x8*)(Ar + 64 + ks * 32);
#pragma unroll
                for (int nt = 0; nt < 4; ++nt) {
                    const bf16x8 X = *(const bf16x8*)(IUt + (size_t)(h * 64 + 32 * (nt >> 1) + 8 * (fr >> 2) + 4 * (nt & 1) + (fr & 3)) * 64 + ks * 32 + fq * 8);
                    acc[nt] = __builtin_amdgcn_mfma_f32_16x16x32_bf16(X, Yv, acc[nt], 0, 0, 0);
                }
            }
#pragma unroll
            for (int nt = 0; nt < 4; ++nt) {
                const f32x4 a0 = *(const LAS f32x4*)(PRM + 7 * 512 + h * 64 + 32 * (nt >> 1) + 8 * fq + 4 * (nt & 1));
#pragma unroll
                for (int k = 0; k < 4; ++k) av[nt][k] = sigmoidf_(a0[k] + acc[nt][k]);
            }
        }
        {
            f32x4 acc[4];
#pragma unroll
            for (int nt = 0; nt < 4; ++nt) acc[nt] = (f32x4){0.f, 0.f, 0.f, 0.f};
#pragma unroll
            for (int ks = 0; ks < 4; ++ks) {
                const bf16x8 Yv = *(const LAS bf16x8*)(Ar + 128 + ks * 32);
#pragma unroll
                for (int nt = 0; nt < 4; ++nt) {
                    const bf16x8 X = *(const bf16x8*)(GUt + (size_t)(h * 64 + 32 * (nt >> 1) + 8 * (fr >> 2) + 4 * (nt & 1) + (fr & 3)) * 128 + ks * 32 + fq * 8);
                    acc[nt] = __builtin_amdgcn_mfma_f32_16x16x32_bf16(X, Yv, acc[nt], 0, 0, 0);
                }
            }
#pragma unroll
            for (int a2 = 0; a2 < 2; ++a2) { const u32x2 p0 = pack4(acc[2 * a2]), p1 = pack4(acc[2 * a2 + 1]);
                st16_wt(ymix + tok * DM + 512 + h * 64 + 32 * a2 + 8 * fq, (u32x4){p0.x, p0.y, p1.x, p1.y}); }
        }
        f32x4 rv[4], kv[4], kk[4]; float ssq = 0.f;
        bf16_t* sp = sc + ((size_t)(b * 8 + h) * SEQ + t) * 384;
#define PK8(lo4, hi4) ({ const u32x2 p0_ = pack4(lo4), p1_ = pack4(hi4); (u32x4){p0_.x, p0_.y, p1_.x, p1_.y}; })
#pragma unroll
        for (int a2 = 0; a2 < 2; ++a2) {
            const int cl = 32 * a2 + 8 * fq, c = h * 64 + cl;
            const bf16_t* zp = z + tok * PE + 1024 + c;
            const u32x4 zr = *(const u32x4*)zp, zk = *(const u32x4*)(zp + 512), zv = *(const u32x4*)(zp + 1024);
            const bf16_t* zq = hp ? zp - PE : zp; const float hm = hp ? 1.0f : 0.0f;
            const u32x4 qr = *(const u32x4*)zq, qk = *(const u32x4*)(zq + 512), qv = *(const u32x4*)(zq + 1024);
            f32x4 vv[2];
#pragma unroll
            for (int hh = 0; hh < 2; ++hh) {
                const int nt = 2 * a2 + hh, c4 = c + 4 * hh;
                const f32x4 cr = unpack4(hh ? (u32x2){zr.z, zr.w} : (u32x2){zr.x, zr.y}), ck = unpack4(hh ? (u32x2){zk.z, zk.w} : (u32x2){zk.x, zk.y}), cvv = unpack4(hh ? (u32x2){zv.z, zv.w} : (u32x2){zv.x, zv.y});
                const f32x4 pr = unpack4(hh ? (u32x2){qr.z, qr.w} : (u32x2){qr.x, qr.y}) * hm, pk = unpack4(hh ? (u32x2){qk.z, qk.w} : (u32x2){qk.x, qk.y}) * hm, pvv = unpack4(hh ? (u32x2){qv.z, qv.w} : (u32x2){qv.x, qv.y}) * hm;
                const f32x4 mr = *(const LAS f32x4*)(PRM + c4), mk = *(const LAS f32x4*)(PRM + 512 + c4), mv = *(const LAS f32x4*)(PRM + 1024 + c4);
                rv[nt] = cr + mr * (pr - cr); kv[nt] = ck + mk * (pk - ck); vv[hh] = cvv + mv * (pvv - cvv);
                kk[nt] = kv[nt] * *(const LAS f32x4*)(PRM + 3 * 512 + c4);
                ssq += (kk[nt][0] * kk[nt][0] + kk[nt][1] * kk[nt][1]) + (kk[nt][2] * kk[nt][2] + kk[nt][3] * kk[nt][3]);
            }
            st16_wt(sp + 5 * 64 + cl, PK8(vv[0], vv[1]));
            st16_wt(sp + 4 * 64 + cl, PK8(rv[2 * a2], rv[2 * a2 + 1]));
            st16_wt(sp + 0 * 64 + cl, PK8(ev[2 * a2], ev[2 * a2 + 1]));
        }
        ssq += __shfl_xor(ssq, 16); ssq += __shfl_xor(ssq, 32);
        const float inv = 1.0f / fmaxf(sqrtf(ssq), 1e-12f);
        float cbp = 0.f;
#pragma unroll
        for (int a2 = 0; a2 < 2; ++a2) {
            const int cl = 32 * a2 + 8 * fq, c = h * 64 + cl;
            f32x4 kp[2], nk[2], nb[2];
#pragma unroll
            for (int hh = 0; hh < 2; ++hh) {
                const int nt = 2 * a2 + hh, c4 = c + 4 * hh;
                const f32x4 a = av[nt], kkn = kk[nt] * inv;
                const f32x4 ka = *(const LAS f32x4*)(PRM + 4 * 512 + c4), rk = *(const LAS f32x4*)(PRM + 5 * 512 + c4);
                kp[hh] = kv[nt] * (1.0f + (a - 1.0f) * ka);
                const f32x4 pr = rv[nt] * kp[hh] * rk; cbp += (pr[0] + pr[1]) + (pr[2] + pr[3]);
                nk[hh] = -kkn; nb[hh] = kkn * a;
            }
            st16_wt(sp + 1 * 64 + cl, PK8(kp[0], kp[1]));
            st16_wt(sp + 2 * 64 + cl, PK8(nk[0], nk[1]));
            st16_wt(sp + 3 * 64 + cl, PK8(nb[0], nb[1]));
        }
#undef PK8
        cbp += __shfl_xor(cbp, 16); cbp += __shfl_xor(cbp, 32);
        if (fq == 0) cb[tok * 8 + h] = cbp;
    }
    __syncthreads();
}

__device__ __forceinline__ void red16x2(float& a, float& b) {
    a += dpp_f<0x140>(a); b += dpp_f<0x140>(b);
    a += dpp_f<0x141>(a); b += dpp_f<0x141>(b);
    a += dpp_f<0xB1>(a);  b += dpp_f<0xB1>(b);
    a += dpp_f<0x4E>(a);  b += dpp_f<0x4E>(b);
}
__device__ __forceinline__ void red16x4(float& a, float& b, float& c, float& d) {
    a += dpp_f<0x140>(a); b += dpp_f<0x140>(b); c += dpp_f<0x140>(c); d += dpp_f<0x140>(d);
    a += dpp_f<0x141>(a); b += dpp_f<0x141>(b); c += dpp_f<0x141>(c); d += dpp_f<0x141>(d);
    a += dpp_f<0xB1>(a);  b += dpp_f<0xB1>(b);  c += dpp_f<0xB1>(c);  d += dpp_f<0xB1>(d);
    a += dpp_f<0x4E>(a);  b += dpp_f<0x4E>(b);  c += dpp_f<0x4E>(c);  d += dpp_f<0x4E>(d);
}
__device__ __forceinline__ void scan_item(const Frame& F, int item) {
    const int bh = item >> 2, rq = item & 3, b = bh >> 3, h = bh & 7, lane = F.lane, wave = F.wave;
    const bf16_t* sc = (const bf16_t*)(F.ws + WS_SC) + (size_t)bh * SEQ * 384;
    float* Y = (float*)(F.ws + WS_Y);
    LAS float* buf = (LAS float*)F.lds;
    constexpr int CH = 32, NP = CH / 2, PSTR = 712, CHF = NP * PSTR;
    const int ltid = F.tid - 256;
    const int lpair = ltid >> 4, lsub = ltid & 15;
    u32x2 raw0A[6], raw1A[6], raw0B[6], raw1B[6];
#define SCAN_GL(S, c) do { const bf16_t* src_ = sc + ((size_t)(c) * CH + 2 * lpair) * 384 + lsub * 4; \
        _Pragma("unroll") for (int p = 0; p < 6; ++p) { raw0##S[p] = *(const u32x2*)(src_ + p * 64); raw1##S[p] = *(const u32x2*)(src_ + 384 + p * 64); } } while (0)
#define SCAN_LW(S, bi) do { LAS float* pp_ = buf + (bi) * CHF + lpair * PSTR; LAS float* dst_ = pp_ + lsub * 4; \
        f32x4 e0_ = unpack4(raw0##S[0]), k0_ = unpack4(raw0##S[1]), a0_ = unpack4(raw0##S[2]), b0_ = unpack4(raw0##S[3]), r0_ = unpack4(raw0##S[4]), v0_ = unpack4(raw0##S[5]); \
        f32x4 e1_ = unpack4(raw1##S[0]), k1_ = unpack4(raw1##S[1]), a1_ = unpack4(raw1##S[2]), b1_ = unpack4(raw1##S[3]), r1_ = unpack4(raw1##S[4]), v1_ = unpack4(raw1##S[5]); \
        f32x4 w0_, w1_; _Pragma("unroll") for (int k = 0; k < 4; ++k) { w0_[k] = __expf(-e0_[k]); w1_[k] = __expf(-e1_[k]); } \
        const f32x4 ba_ = b0_ * a1_, ka_ = k0_ * a1_, br_ = b0_ * r0_, kr_ = k0_ * r0_; \
        float s0_ = (ba_[0] + ba_[1]) + (ba_[2] + ba_[3]), s1_ = (ka_[0] + ka_[1]) + (ka_[2] + ka_[3]), s2_ = (br_[0] + br_[1]) + (br_[2] + br_[3]), s3_ = (kr_[0] + kr_[1]) + (kr_[2] + kr_[3]); \
        red16x4(s0_, s1_, s2_, s3_); \
        *(LAS f32x4*)(dst_) = a0_; *(LAS f32x4*)(dst_ + 64) = w0_ * a1_; *(LAS f32x4*)(dst_ + 128) = w0_ * r0_; *(LAS f32x4*)(dst_ + 192) = r1_; \
        *(LAS f32x4*)(dst_ + 256) = w0_ * w1_; *(LAS f32x4*)(dst_ + 320) = b0_ * w1_; *(LAS f32x4*)(dst_ + 384) = k0_ * w1_; *(LAS f32x4*)(dst_ + 448) = b1_; \
        *(LAS f32x4*)(dst_ + 512) = k1_; *(LAS f32x4*)(dst_ + 576) = v0_; *(LAS f32x4*)(dst_ + 640) = v1_; \
        if (lsub == 0) *(LAS f32x4*)(pp_ + 704) = (f32x4){s0_, s1_, s2_, s3_}; } while (0)
    if (wave >= 4) { SCAN_GL(A, 0); SCAN_GL(B, 1); SCAN_LW(A, 0); SCAN_GL(A, 2); }
    __syncthreads();
    const int l16 = lane & 15, rl = wave * 4 + (lane >> 4), row = rq * 16 + rl, c4 = l16 * 4;
    f32x2 s01 = (f32x2){0.f, 0.f}, s23 = s01;
    f32x4 rprev = (f32x4){0.f, 0.f, 0.f, 0.f};
    float ykeep = 0.f;
    LAS float* ybuf = buf + 2 * CHF;
    LAS float* ywr = ybuf + l16 * 16 + rl;
    float* yflush = Y + ((size_t)b * SEQ + (ltid >> 2)) * 512 + h * 64 + rq * 16 + (ltid & 3) * 4;
#define SCAN_FLUSH(f) do { if (ltid < 128) { const f32x4 yv_ = *(const LAS f32x4*)(ybuf + ((f) & 3) * 512 + (ltid >> 2) * 16 + (ltid & 3) * 4); st16_wt(yflush + (size_t)(f) * 32 * 512, __builtin_bit_cast(u32x4, yv_)); } } while (0)
#define DOT4(x) ({ f32x2 p_ = s01 * (f32x2){(x)[0], (x)[1]}; p_ = __builtin_elementwise_fma(s23, (f32x2){(x)[2], (x)[3]}, p_); p_[0] + p_[1]; })
#define LDP(P, q) const f32x4 P##a = *(const LAS f32x4*)((q) + c4), P##wa = *(const LAS f32x4*)((q) + 64 + c4), P##wr = *(const LAS f32x4*)((q) + 128 + c4), P##r1 = *(const LAS f32x4*)((q) + 192 + c4), \
        P##ww = *(const LAS f32x4*)((q) + 256 + c4), P##bw = *(const LAS f32x4*)((q) + 320 + c4), P##kw = *(const LAS f32x4*)((q) + 384 + c4), P##b1 = *(const LAS f32x4*)((q) + 448 + c4), \
        P##k1 = *(const LAS f32x4*)((q) + 512 + c4), P##sc = *(const LAS f32x4*)((q) + 704); const float P##v0 = (q)[576 + row], P##v1 = (q)[640 + row]
    for (int c = 0; c < SEQ / CH; ++c) {
        if (wave >= 4) {
            if (c + 1 < SEQ / CH) {
                if ((c + 1) & 1) { SCAN_LW(B, 1); if (c + 3 < SEQ / CH) SCAN_GL(B, c + 3); }
                else { SCAN_LW(A, 0); if (c + 3 < SEQ / CH) SCAN_GL(A, c + 3); }
            }
            if (c >= 2) SCAN_FLUSH(c - 2);
        }
        else {
            const LAS float* bp = buf + (c & 1) * CHF;
            f32x4 Ca, Cwa, Cwr, Cr1, Cww, Cbw, Ckw, Cb1, Ck1, Csc; float Cv0, Cv1;
            { LDP(T, bp); Ca = Ta; Cwa = Twa; Cwr = Twr; Cr1 = Tr1; Cww = Tww; Cbw = Tbw; Ckw = Tkw; Cb1 = Tb1; Ck1 = Tk1; Csc = Tsc; Cv0 = Tv0; Cv1 = Tv1; }
#pragma unroll 1
            for (int hb = 0; hb < 2; ++hb) {
#pragma unroll
                for (int i = 0; i < 8; ++i) {
                    const int p = hb * 8 + i;
                    const LAS float* qn = bp + ((p + 1 < NP) ? (p + 1) : (NP - 1)) * PSTR;
                    LDP(N, qn);
                    float d0 = DOT4(rprev), d1 = DOT4(Ca), d2 = DOT4(Cwa), d3 = DOT4(Cwr);
                    red16x4(d0, d1, d2, d3);
                    ykeep = (l16 == ((2 * i + 15) & 15)) ? d0 : ykeep;
                    if (i == 0) { const int blk = 2 * c + hb - 1; if (blk >= 0) ywr[((blk >> 1) & 3) * 512 + (blk & 1) * 256] = ykeep; }
                    const float sa0 = d1;
                    const float yt = __builtin_fmaf(sa0, Csc[2], __builtin_fmaf(Cv0, Csc[3], d3));
                    ykeep = (l16 == (2 * i)) ? yt : ykeep;
                    const float sa1 = __builtin_fmaf(sa0, Csc[0], __builtin_fmaf(Cv0, Csc[1], d2));
                    const f32x2 a0v = (f32x2){sa0, sa0}, a1v = (f32x2){sa1, sa1}, v0v = (f32x2){Cv0, Cv0}, v1v = (f32x2){Cv1, Cv1};
                    f32x2 t01 = (f32x2){Ckw[0], Ckw[1]} * v0v, t23 = (f32x2){Ckw[2], Ckw[3]} * v0v;
                    t01 = __builtin_elementwise_fma((f32x2){Cbw[0], Cbw[1]}, a0v, t01); t23 = __builtin_elementwise_fma((f32x2){Cbw[2], Cbw[3]}, a0v, t23);
                    t01 = __builtin_elementwise_fma((f32x2){Ck1[0], Ck1[1]}, v1v, t01); t23 = __builtin_elementwise_fma((f32x2){Ck1[2], Ck1[3]}, v1v, t23);
                    t01 = __builtin_elementwise_fma((f32x2){Cb1[0], Cb1[1]}, a1v, t01); t23 = __builtin_elementwise_fma((f32x2){Cb1[2], Cb1[3]}, a1v, t23);
                    s01 = __builtin_elementwise_fma(s01, (f32x2){Cww[0], Cww[1]}, t01); s23 = __builtin_elementwise_fma(s23, (f32x2){Cww[2], Cww[3]}, t23);
                    rprev = Cr1;
                    Ca = Na; Cwa = Nwa; Cwr = Nwr; Cr1 = Nr1; Cww = Nww; Cbw = Nbw; Ckw = Nkw; Cb1 = Nb1; Ck1 = Nk1; Csc = Nsc; Cv0 = Nv0; Cv1 = Nv1;
                }
            }
        }
        __syncthreads();
    }
    if (wave < 4) {
        float d0 = DOT4(rprev), z1 = 0.f, z2 = 0.f, z3 = 0.f; red16x4(d0, z1, z2, z3);
        ykeep = (l16 == 15) ? d0 : ykeep;
        ywr[3 * 512 + 256] = ykeep;
    }
    __syncthreads();
    if (wave >= 4) { SCAN_FLUSH(SEQ / CH - 2); SCAN_FLUSH(SEQ / CH - 1); }
    __syncthreads();
#undef SCAN_FLUSH
#undef SCAN_GL
#undef SCAN_LW
#undef DOT4
#undef LDP
}
__device__ __forceinline__ void post_rows(const Frame& F, int e) {
    const float* Y = (const float*)(F.ws + WS_Y); const bf16_t* sc = (const bf16_t*)(F.ws + WS_SC); const float* cb = (const float*)(F.ws + WS_CB);
    bf16_t* ymix = (bf16_t*)(F.ws + WS_YMIX);
    const float* lg = inp<23>() + e * 512; const float* lb = inp<24>() + e * 512;
    const int lane = F.lane, hh = lane >> 3;
    for (int tl = (F.bid >> 3) * 8 + F.wave; tl < SEQ; tl += F.G) {
        const int tok = (F.bid & 7) * SEQ + tl;
        const int b = tok / SEQ, t = tok % SEQ;
        const f32x4 y0 = *(const f32x4*)(Y + (size_t)tok * 512 + lane * 8), y1 = *(const f32x4*)(Y + (size_t)tok * 512 + lane * 8 + 4);
        float yv[8] = {y0[0], y0[1], y0[2], y0[3], y1[0], y1[1], y1[2], y1[3]};
        float s = 0.f;
#pragma unroll
        for (int k = 0; k < 8; ++k) s += yv[k];
        s += __shfl_xor(s, 1); s += __shfl_xor(s, 2); s += __shfl_xor(s, 4);
        const float mean = s * (1.0f / 64.0f); float qv = 0.f;
#pragma unroll
        for (int k = 0; k < 8; ++k) { yv[k] -= mean; qv += yv[k] * yv[k]; }
        qv += __shfl_xor(qv, 1); qv += __shfl_xor(qv, 2); qv += __shfl_xor(qv, 4);
        const float rstd = rsqrtf(qv * (1.0f / 64.0f) + 64e-5f);
        const u32x4 vr = *(const u32x4*)(sc + ((size_t)(b * 8 + hh) * SEQ + t) * 384 + 5 * 64 + (lane & 7) * 8);
        bf16_t* gp = ymix + (size_t)tok * DM + 512 + lane * 8;
        const u32x4 gr = *(const u32x4*)gp;
        const float cbv = cb[(size_t)tok * 8 + hh];
        float vv[8] = {bflo(vr.x), bfhi(vr.x), bflo(vr.y), bfhi(vr.y), bflo(vr.z), bfhi(vr.z), bflo(vr.w), bfhi(vr.w)};
        float gg[8] = {bflo(gr.x), bfhi(gr.x), bflo(gr.y), bfhi(gr.y), bflo(gr.z), bfhi(gr.z), bflo(gr.w), bfhi(gr.w)};
        float o[8];
#pragma unroll
        for (int k = 0; k < 8; ++k) o[k] = (yv[k] * rstd * lg[lane * 8 + k] + lb[lane * 8 + k] + cbv * vv[k]) * gg[k];
        u32x4 ow; ow.x = pk2(o[0], o[1]); ow.y = pk2(o[2], o[3]); ow.z = pk2(o[4], o[5]); ow.w = pk2(o[6], o[7]);
        st16_wt(gp, ow);
    }
}

__device__ __forceinline__ void conv_item(const Frame& F, int item, int o) {
    const int b = item >> 6, tt = item & 63, t0 = tt * 32, c = F.tid, lane = F.lane, wave = F.wave;
    const bf16_t* z = (const bf16_t*)(F.ws + WS_ACT);
    bf16_t* ymix = (bf16_t*)(F.ws + WS_YMIX);
    const float* cw = inp<31>() + (size_t)o * 31 * 512; const float* cbias = inp<32>() + o * 512;
    const float* lg = inp<33>() + o * 512; const float* lb = inp<34>() + o * 512;
    LAS float* co = (LAS float*)F.lds;
    const size_t tokb = (size_t)b * SEQ;
    float hv[62];
#pragma unroll
    for (int i = 0; i < 62; ++i) {
        const int t = t0 - 30 + i; float hval = 0.f;
        if (t >= 0) { const bf16_t* zp = z + (tokb + t) * POP + 416 + c; const float za = bf1(zp[0]), zg = bf1(zp[512]); hval = za * sigmoidf_(zg); }
        hv[i] = hval;
    }
    float wv[31];
#pragma unroll
    for (int k = 0; k < 31; ++k) wv[k] = cw[k * 512 + c];
    const float bias = cbias[c];
#pragma unroll
    for (int i = 0; i < 32; ++i) {
        float a = bias;
#pragma unroll
        for (int k = 0; k < 31; ++k) a += wv[k] * hv[i + k];
        co[i * 512 + c] = a;
    }
    {
        const int token = F.tid >> 4, i = F.tid & 15, t = t0 + token;
        const bf16_t* zp = z + (tokb + t) * POP + 384;
        const float x1 = bf1(zp[i]), x2 = bf1(zp[16 + i]);
        const float cs = ((const float*)(F.ws + WS_COS))[t * 16 + i], sn = ((const float*)(F.ws + WS_SIN))[t * 16 + i];
        bf16_t* kr = (bf16_t*)(F.ws + WS_SC + SC_KR) + (tokb + t) * 32;
        const int kp_ = 8 * (i >> 2) + (i & 3);
        kr[kp_] = (bf16_t)(pk2(x1 * cs - x2 * sn, 0.f) & 0xffffu); kr[kp_ + 4] = (bf16_t)(pk2(x1 * sn + x2 * cs, 0.f) & 0xffffu);
    }
    __syncthreads();
#pragma unroll
    for (int j = 0; j < 4; ++j) {
        const int ti = wave * 4 + j;
        const f32x4 v0 = *(const LAS f32x4*)(co + ti * 512 + lane * 8), v1 = *(const LAS f32x4*)(co + ti * 512 + lane * 8 + 4);
        float v[8] = {v0[0], v0[1], v0[2], v0[3], v1[0], v1[1], v1[2], v1[3]};
        float s = 0.f;
#pragma unroll
        for (int k = 0; k < 8; ++k) s += v[k];
        const float mean = wave_sum(s) * (1.0f / 512.0f); float qv = 0.f;
#pragma unroll
        for (int k = 0; k < 8; ++k) { v[k] -= mean; qv += v[k] * v[k]; }
        const float rstd = rsqrtf(wave_sum(qv) * (1.0f / 512.0f) + 1e-5f);
        float ov[8];
#pragma unroll
        for (int k = 0; k < 8; ++k) { const float y = v[k] * rstd * lg[lane * 8 + k] + lb[lane * 8 + k]; ov[k] = y * sigmoidf_(y); }
        u32x4 ow; ow.x = pk2(ov[0], ov[1]); ow.y = pk2(ov[2], ov[3]); ow.z = pk2(ov[4], ov[5]); ow.w = pk2(ov[6], ov[7]);
        st16_wt(ymix + (tokb + t0 + ti) * DM + 512 + lane * 8, ow);
    }
    __syncthreads();
}

constexpr int AT_KS = 104, AT_VS = 80, AT_KB = 64 * AT_KS * 2, AT_VB = 64 * AT_VS * 2, AT_BUF = AT_KB + AT_VB;
typedef short v4i16_t __attribute__((ext_vector_type(4)));
__device__ __forceinline__ void attn_unit(const Frame& F, int b, int h, int qb) {
    const int lane = F.lane, wave = F.wave, tid = F.tid, fr = lane & 15, fq = lane >> 4;
    const bf16_t* Q = (const bf16_t*)(F.ws + WS_SC + SC_Q); const bf16_t* KV = (const bf16_t*)(F.ws + WS_SC + SC_KV); const bf16_t* KR = (const bf16_t*)(F.ws + WS_SC + SC_KR);
    bf16_t* ymix = (bf16_t*)(F.ws + WS_YMIX);
    const size_t tokb = (size_t)b * SEQ;
    const int q0 = qb * 256 + wave * 32;
    const int ntb = 4 * qb + 4, ntw = 4 * qb + 1 + (wave >> 1);
    bf16x8 qf[2][3];
#pragma unroll
    for (int mt = 0; mt < 2; ++mt)
#pragma unroll
        for (int ks = 0; ks < 3; ++ks) qf[mt][ks] = *(const bf16x8*)(Q + (tokb + q0 + mt * 16 + fr) * 768 + h * 96 + ks * 32 + fq * 8);
    const int key0 = tid / 12, ch0 = tid % 12, key1 = (tid + 512) / 12, ch1 = (tid + 512) % 12;
    const bool has1 = tid < 256;
    const int vkey = tid >> 3, vch = tid & 7;
    const bf16_t* ksrc0 = (ch0 < 8) ? KV + (tokb + key0) * 1024 + h * 128 + ch0 * 8 : KR + (tokb + key0) * 32 + (ch0 - 8) * 8;
    const bf16_t* ksrc1 = (ch1 < 8) ? KV + (tokb + key1) * 1024 + h * 128 + ch1 * 8 : KR + (tokb + key1) * 32 + (ch1 - 8) * 8;
    const int kstr0 = (ch0 < 8) ? 64 * 1024 : 64 * 32, kstr1 = (ch1 < 8) ? 64 * 1024 : 64 * 32;
    const bf16_t* vsrc = KV + (tokb + vkey) * 1024 + h * 128 + 64 + vch * 8;
    const unsigned kdst0 = key0 * (AT_KS * 2) + ch0 * 16, kdst1 = key1 * (AT_KS * 2) + ch1 * 16;
    u32x4 rk0[2], rk1[2], rv[2];
#pragma unroll
    for (int k = 0; k < 2; ++k) { rk0[k] = (u32x4){0u, 0u, 0u, 0u}; rk1[k] = rk0[k]; rv[k] = rk0[k]; }
#define AT_GLOAD(j, st) do { rk0[st] = *(const u32x4*)(ksrc0 + (size_t)(j) * kstr0); if (has1) rk1[st] = *(const u32x4*)(ksrc1 + (size_t)(j) * kstr1); rv[st] = *(const u32x4*)(vsrc + (size_t)(j) * 64 * 1024); } while (0)
#define AT_LSTORE(bi, st) do { LAS unsigned char* kb_ = F.lds + (bi) * AT_BUF; LAS bf16_t* vb_ = (LAS bf16_t*)(kb_ + AT_KB); \
        *(LAS u32x4*)(kb_ + kdst0) = rk0[st]; if (has1) *(LAS u32x4*)(kb_ + kdst1) = rk1[st]; \
        *(LAS u32x4*)(vb_ + vkey * AT_VS + vch * 8) = rv[st]; } while (0)
    f32x4 o[2][4];
#pragma unroll
    for (int mt = 0; mt < 2; ++mt)
#pragma unroll
        for (int dt = 0; dt < 4; ++dt) o[mt][dt] = (f32x4){0.f, 0.f, 0.f, 0.f};
    float mrun[2] = {-INFINITY, -INFINITY}, lsum[2] = {0.f, 0.f};
#pragma unroll
    for (int k = 0; k < 2; ++k) AT_GLOAD(k, k);
    for (int j0 = 0; j0 < ntb; j0 += 2) {
      AT_LSTORE(j0 & 3, 0); AT_LSTORE((j0 & 3) + 1, 1);
      __syncthreads();
      if (j0 + 2 < ntb) { AT_GLOAD(j0 + 2, 0); AT_GLOAD(j0 + 3, 1); }
#pragma unroll
      for (int kk = 0; kk < 2; ++kk) {
        const int j = j0 + kk;
        if (j < ntw) {
            const LAS unsigned char* kb = F.lds + (j & 3) * AT_BUF; const LAS bf16_t* vb = (const LAS bf16_t*)(kb + AT_KB);
            f32x4 st[2][4];
#pragma unroll
            for (int kt = 0; kt < 4; ++kt) {
                st[0][kt] = (f32x4){0.f, 0.f, 0.f, 0.f}; st[1][kt] = st[0][kt];
#pragma unroll
                for (int ks = 0; ks < 3; ++ks) {
                    const bf16x8 X = *(const LAS bf16x8*)(kb + (kt * 16 + fr) * (AT_KS * 2) + (ks * 32 + fq * 8) * 2);
                    st[0][kt] = __builtin_amdgcn_mfma_f32_16x16x32_bf16(X, qf[0][ks], st[0][kt], 0, 0, 0);
                    st[1][kt] = __builtin_amdgcn_mfma_f32_16x16x32_bf16(X, qf[1][ks], st[1][kt], 0, 0, 0);
                }
            }
            bf16x8 Yp[2][2];
#pragma unroll
            for (int mt = 0; mt < 2; ++mt) {
                float mx = fmaxf(fmaxf(st[mt][0][0], st[mt][0][1]), fmaxf(st[mt][0][2], st[mt][0][3]));
#pragma unroll
                for (int kt = 1; kt < 4; ++kt) mx = fmaxf(mx, fmaxf(fmaxf(st[mt][kt][0], st[mt][kt][1]), fmaxf(st[mt][kt][2], st[mt][kt][3])));
                mx = fmaxf(mx, __shfl_xor(mx, 16)); mx = fmaxf(mx, __shfl_xor(mx, 32));
                const float mnew = fmaxf(mrun[mt], mx), alpha = __builtin_amdgcn_exp2f(mrun[mt] - mnew);
                mrun[mt] = mnew;
                float ps = 0.f;
#pragma unroll
                for (int kt = 0; kt < 4; ++kt)
#pragma unroll
                    for (int k = 0; k < 4; ++k) { st[mt][kt][k] = __builtin_amdgcn_exp2f(st[mt][kt][k] - mnew); ps += st[mt][kt][k]; }
                lsum[mt] = lsum[mt] * alpha + ps;
#pragma unroll
                for (int dt = 0; dt < 4; ++dt) o[mt][dt] = o[mt][dt] * alpha;
#pragma unroll
                for (int g2 = 0; g2 < 2; ++g2) {
                    u32x4 pw; pw.x = pk2(st[mt][2 * g2][0], st[mt][2 * g2][1]); pw.y = pk2(st[mt][2 * g2][2], st[mt][2 * g2][3]); pw.z = pk2(st[mt][2 * g2 + 1][0], st[mt][2 * g2 + 1][1]); pw.w = pk2(st[mt][2 * g2 + 1][2], st[mt][2 * g2 + 1][3]);
                    Yp[mt][g2] = __builtin_bit_cast(bf16x8, pw);
                }
            }
#pragma unroll
            for (int g2 = 0; g2 < 2; ++g2)
#pragma unroll
                for (int dt = 0; dt < 4; ++dt) {
                    const LAS bf16_t* vp = vb + (g2 * 32 + fq * 4 + (fr >> 2)) * AT_VS + 32 * (dt >> 1) + 8 * (fr & 3) + 4 * (dt & 1);
                    const v4i16_t lo = __builtin_amdgcn_ds_read_tr16_b64_v4i16((LAS v4i16_t*)vp), hi = __builtin_amdgcn_ds_read_tr16_b64_v4i16((LAS v4i16_t*)(vp + 16 * AT_VS));
                    const bf16x8 Xv = (bf16x8){lo[0], lo[1], lo[2], lo[3], hi[0], hi[1], hi[2], hi[3]};
                    o[0][dt] = __builtin_amdgcn_mfma_f32_16x16x32_bf16(Xv, Yp[0][g2], o[0][dt], 0, 0, 0);
                    o[1][dt] = __builtin_amdgcn_mfma_f32_16x16x32_bf16(Xv, Yp[1][g2], o[1][dt], 0, 0, 0);
                }
        }
      }
    }
#undef AT_GLOAD
#undef AT_LSTORE
#pragma unroll
    for (int mt = 0; mt < 2; ++mt) {
        float ls = lsum[mt]; ls += __shfl_xor(ls, 16); ls += __shfl_xor(ls, 32);
        const float il = 1.0f / ls;
#pragma unroll
        for (int a2 = 0; a2 < 2; ++a2) { const u32x2 p0 = pack4(o[mt][2 * a2] * il), p1 = pack4(o[mt][2 * a2 + 1] * il);
            st16_wt(ymix + (tokb + q0 + mt * 16 + fr) * DM + h * 64 + 32 * a2 + 8 * fq, (u32x4){p0.x, p0.y, p1.x, p1.y}); }
    }
    __syncthreads();
}

constexpr int NPHASE = 1 + 9 * DEPTH + 1;
__global__ void __launch_bounds__(512, 2) mk_fwd(Args args) {
    extern __shared__ __attribute__((aligned(16))) unsigned char lds_raw[];
    Frame F;
    F.lds = (LAS unsigned char*)lds_raw;
    F.tid = threadIdx.x; F.lane = F.tid & 63; F.wave = __builtin_amdgcn_readfirstlane(F.tid >> 6);
    F.G = gridDim.x; F.bid = blockIdx.x; F.out = args.out; F.ws = args.ws;
    const int lo = args.ph_lo, hi = args.ph_hi;
    cg::grid_group grid = cg::this_grid();
    volatile LAS unsigned* bst = (volatile LAS unsigned*)(F.lds + 135168);
    if (threadIdx.x < 8) bst[threadIdx.x] = 0u;
    __syncthreads();
    XcdBarrier xbar = xcd_barrier_post((unsigned*)args.ws, bst);
    int vbid = blockIdx.x; bool regular = false;
#define IN(k) (lo <= (k) && (k) < hi)
#define ENTER() do { int t_ = threadIdx.x; int b_ = vbid; asm volatile("" : "+v"(t_), "+s"(b_)); F.tid = t_; F.lane = t_ & 63; F.wave = __builtin_amdgcn_readfirstlane(t_ >> 6); F.bid = b_; } while (0)
#define SEAM(k) do { if (IN(k) && IN((k) + 1)) { if (regular && (k) != 0 && (((k) - 1) % 9) != 8) xcd_local_barrier(xbar); else xcd_barrier(xbar); } } while (0)

    if (lo > hi) grid.sync();
    if (IN(0)) { ENTER(); { convert_layer(F, 0, 0, 1, F.bid, F.G); x_prologue(F); } }
    SEAM(0);
    if (IN(0) && IN(1)) {
        const unsigned reg_ = bst[2], rank_ = bst[3];
        regular = __builtin_amdgcn_readfirstlane((int)reg_) != 0;
        if (regular) vbid = __builtin_amdgcn_readfirstlane((int)(rank_ * 8u + xbar.x));
    }
    for (int l = 0; l < DEPTH; ++l) {
        const int p0 = 1 + 9 * l; const bool odd = l & 1; const int hl = l >> 1;
        size_t z0 = 0; asm volatile("" : "+s"(z0));
        unsigned char* ws = args.ws + z0;
        F.ws = ws;
        float* ssq = (float*)(ws + WS_SSQ);
        bf16_t* xb = (bf16_t*)(ws + WS_XB); bf16_t* ymix = (bf16_t*)(ws + WS_YMIX); bf16_t* act = (bf16_t*)(ws + WS_ACT);
        const unsigned char* wb = ws + WS_WBUF0 + (size_t)(l & 1) * WBUF_BYTES;
        if (IN(p0 + 0)) {
            ENTER();
            pg8::Gemm g{xb, (const bf16_t*)(wb + WB_W1IN), T, 2 * FF, DM, DM, DM}; pg8::StaticOrder S; S.init(T, 2 * FF, F.G, F.bid);
            EpiSwiGLU E{act, ssq}; pg8::gemm_phase(F.lds, g, S, E);
            ENTER();
            if (l + 1 < DEPTH) {
                const int nfull = ((T / 256) * (2 * FF / 256)) % F.G;
                if (nfull == 0) { __syncthreads(); convert_layer(F, l + 1, 0, 2, F.bid, F.G); }
                else if (F.bid >= nfull) { __syncthreads(); convert_layer(F, l + 1, 0, 2, F.bid - nfull, F.G - nfull); }
            }
        }
        SEAM(p0 + 0);
        if (IN(p0 + 1)) {
            ENTER();
            pg8::Gemm g{act, (const bf16_t*)(wb + WB_W1OUT), T, DM, FF, FF, FF}; pg8::StaticOrder S; S.init(T, DM, F.G, F.bid);
            EpiResid E{xb, ssq, 0.5f}; pg8::gemm_phase(F.lds, g, S, E);
        }
        SEAM(p0 + 1);
        if (IN(p0 + 2)) {
            ENTER();
            if (odd) { pg8::Gemm g{xb, (const bf16_t*)(wb + WB_WMIN), T, POP, DM, DM, DM}; pg8::StaticOrder S; S.init(T, POP, F.G, F.bid);
                EpiZ<true> E{act, POP, ssq, (float*)(ws + WS_PQ), (float*)(ws + WS_PKV)}; pg8::gemm_phase(F.lds, g, S, E); }
            else { pg8::Gemm g{xb, (const bf16_t*)(wb + WB_WMIN), T, PE, DM, DM, DM}; pg8::StaticOrder S; S.init(T, PE, F.G, F.bid);
                EpiZ<false> E{act, PE, ssq, nullptr, nullptr}; pg8::gemm_phase(F.lds, g, S, E); }
        }
        SEAM(p0 + 2);
        if (IN(p0 + 3)) {
            ENTER();
            if (odd) {
                pg8::Gemm g{act, (const bf16_t*)(wb + WB_WX), T, 1792, 384, POP, 384}; pg8::StaticOrder S; S.init(T, 1792, F.G, F.bid);
                EpiUp E{(bf16_t*)(ws + WS_SC + SC_Q), (bf16_t*)(ws + WS_SC + SC_KV), (const float*)(ws + WS_PQ), (const float*)(ws + WS_PKV), (const float*)(ws + WS_COS), (const float*)(ws + WS_SIN)};
                pg8::gemm_phase(F.lds, g, S, E);
                __syncthreads();
                ENTER();
                for (int j = F.bid >> 3; j < 64; j += F.G >> 3) conv_item(F, (F.bid & 7) * 64 + j, hl);
            } else {
                for (int j = F.bid >> 3; j < 64; j += F.G >> 3) prep_item(F, (F.bid & 7) * 64 + j, hl, wb);
                for (int j = F.bid >> 3; j < 64; j += F.G >> 3) gsu_item(F, (F.bid & 7) * 64 + j, hl);
            }
        }
        SEAM(p0 + 3);
        if (IN(p0 + 4)) {
            ENTER();
            if (odd) {
                for (int j = F.bid >> 3; j < 32; j += F.G >> 3) {
                    const int bh = (F.bid & 7) * 8 + (j & 7), pr = j >> 3;
                    attn_unit(F, bh >> 3, bh & 7, pr);
                    attn_unit(F, bh >> 3, bh & 7, 7 - pr);
                }
            } else {
                for (int j = F.bid >> 3; j < 32; j += F.G >> 3) scan_item(F, (F.bid & 7) * 32 + j);
            }
        }
        SEAM(p0 + 4);
        if (IN(p0 + 5)) { ENTER(); if (!odd) post_rows(F, hl); }
        if (!odd) SEAM(p0 + 5);
        if (IN(p0 + 6)) {
            ENTER();
            pg8::Gemm g{ymix, (const bf16_t*)(wb + WB_WMOUT), T, DM, DM, DM, DM}; pg8::StaticOrder S; S.init(T, DM, F.G, F.bid);
            EpiResid E{xb, ssq, 1.0f}; pg8::gemm_phase(F.lds, g, S, E);
        }
        SEAM(p0 + 6);
        if (IN(p0 + 7)) {
            ENTER();
            pg8::Gemm g{xb, (const bf16_t*)(wb + WB_W2IN), T, 2 * FF, DM, DM, DM}; pg8::StaticOrder S; S.init(T, 2 * FF, F.G, F.bid);
            EpiSwiGLU E{act, ssq}; pg8::gemm_phase(F.lds, g, S, E);
            ENTER();
            if (l + 1 < DEPTH) {
                const int nfull = ((T / 256) * (2 * FF / 256)) % F.G;
                if (nfull == 0) { __syncthreads(); convert_layer(F, l + 1, 1, 2, F.bid, F.G); }
                else if (F.bid >= nfull) { __syncthreads(); convert_layer(F, l + 1, 1, 2, F.bid - nfull, F.G - nfull); }
            }
        }
        SEAM(p0 + 7);
        if (IN(p0 + 8)) {
            ENTER();
            pg8::Gemm g{act, (const bf16_t*)(wb + WB_W2OUT), T, DM, FF, FF, FF}; pg8::StaticOrder S; S.init(T, DM, F.G, F.bid);
            EpiResid E{xb, ssq, 0.5f}; pg8::gemm_phase(F.lds, g, S, E);
        }
        SEAM(p0 + 8);
    }
    if (IN(NPHASE - 1)) { ENTER(); final_norm(F); }
#undef IN
#undef SEAM
#undef ENTER
}

extern "C" void kernel_launch(void* const* d_in, const int* in_sizes, int n_in, void* d_out, int out_size, void* d_ws, size_t ws_size, hipStream_t stream) {
    static int grid = 0;
    if (grid == 0) {
        if (n_in != 36 || out_size != T * DM || ws_size < WS_END) { fprintf(stderr, "kernel_launch: unexpected shapes (n_in %d out %d ws %zu)\n", n_in, out_size, ws_size); grid = -1; return; }
        int dev = 0, cus = 0, per_cu = 0;
        (void)hipGetDevice(&dev); (void)hipDeviceGetAttribute(&cus, hipDeviceAttributeMultiprocessorCount, dev);
        (void)hipFuncSetAttribute((const void*)mk_fwd, hipFuncAttributeMaxDynamicSharedMemorySize, LDS_BYTES);
        (void)hipOccupancyMaxActiveBlocksPerMultiprocessor(&per_cu, (const void*)mk_fwd, 512, LDS_BYTES);
        if (per_cu < 1) per_cu = 1;
        grid = cus * per_cu; if (grid > 256) grid = 256; if (grid < 1) grid = 256;
        (void)hipGetLastError();
    }
    if (grid < 0) return;
    (void)hipMemsetAsync(d_ws, 0, 32768, stream);
    Args a{};
    for (int i = 0; i < 36; ++i) a.in[i] = (const float*)d_in[i];
    a.out = (float*)d_out; a.ws = (unsigned char*)d_ws;
#if MK_MULTI
    for (int p = 0; p < NPHASE; ++p) {
        if (p >= 1 && p < NPHASE - 1) { const int l = (p - 1) / 9, k = (p - 1) % 9; if ((l & 1) && k == 5) continue; }
        a.ph_lo = p; a.ph_hi = p + 1;
        hipLaunchKernelGGL(mk_fwd, dim3(grid), dim3(512), LDS_BYTES, stream, a);
    }
#else
    a.ph_lo = 0; a.ph_hi = NPHASE;
    void* kargs[] = {&a};
    hipError_t e = hipLaunchCooperativeKernel((const void*)mk_fwd, dim3(grid), dim3(512), kargs, LDS_BYTES, stream);
    if (e != hipSuccess) fprintf(stderr, "cooperative launch failed: %s (grid %d)\n", hipGetErrorString(e), grid);
#endif
}
```

```cpp
#include <hip/hip_runtime.h>
#include <hip/hip_cooperative_groups.h>
#include <cstdio>
#include <cstdint>
namespace cg = cooperative_groups;

#ifndef MK_MULTI
#define MK_MULTI 0
#endif

#define LAS __attribute__((address_space(3)))
typedef unsigned short bf16_t;
typedef short bf16x8 __attribute__((ext_vector_type(8)));
typedef float f32x4 __attribute__((ext_vector_type(4)));
typedef float f32x2 __attribute__((ext_vector_type(2)));
typedef unsigned u32x4 __attribute__((ext_vector_type(4)));
typedef unsigned u32x2 __attribute__((ext_vector_type(2)));
typedef __bf16 bf16x2_t __attribute__((ext_vector_type(2)));

constexpr int T = 16384, DM = 1024, FF = 2816, SEQ = 2048, NBATCH = 8, DEPTH = 4;
constexpr int PE = 2816, PO = 1440, POP = 1536;
constexpr int PB = 1792;
constexpr float RMS_EPS = 1e-6f;
constexpr float QSCALE = 0.10206207261596575f * 1.4426950408889634f;

constexpr size_t MiB = 1u << 20;
constexpr size_t WS_SSQ = 1 * MiB;
constexpr size_t WS_PQ = 2 * MiB;
constexpr size_t WS_PKV = 2 * MiB + 256 * 1024;
constexpr size_t WS_COS = 2 * MiB + 512 * 1024;
constexpr size_t WS_SIN = 2 * MiB + 640 * 1024;
constexpr size_t WS_CB = 3 * MiB;
constexpr size_t WS_WBUF0 = 4 * MiB, WBUF_BYTES = 42 * MiB;
constexpr size_t WS_XB = 88 * MiB;
constexpr size_t WS_YMIX = 120 * MiB;
constexpr size_t WS_ACT = 152 * MiB;
constexpr size_t WS_SC = 240 * MiB;
constexpr size_t WS_Y = 336 * MiB;
constexpr size_t WS_END = 368 * MiB;
constexpr size_t WB_W1IN = 0, WB_W1OUT = 11534336, WB_W2IN = 17301504, WB_W2OUT = 28835840, WB_WMIN = 34603008, WB_WMOUT = 40370176, WB_WX = 42467328;
constexpr size_t SC_Q = 0, SC_KV = 24 * MiB, SC_KR = 56 * MiB;

constexpr int LDS_BYTES = 147456;

__device__ __forceinline__ unsigned pk2(float lo, float hi) { f32x2 v = {lo, hi}; bf16x2_t b = __builtin_convertvector(v, bf16x2_t); return __builtin_bit_cast(unsigned, b); }
__device__ __forceinline__ float bflo(unsigned u) { return __uint_as_float(u << 16); }
__device__ __forceinline__ float bfhi(unsigned u) { return __uint_as_float(u & 0xffff0000u); }
__device__ __forceinline__ float bf1(bf16_t h) { return __uint_as_float((unsigned)h << 16); }
__device__ __forceinline__ f32x4 unpack4(u32x2 u) { return (f32x4){bflo(u.x), bfhi(u.x), bflo(u.y), bfhi(u.y)}; }
__device__ __forceinline__ u32x2 pack4(f32x4 v) { u32x2 r; r.x = pk2(v[0], v[1]); r.y = pk2(v[2], v[3]); return r; }
template <int CTRL> __device__ __forceinline__ float dpp_f(float x) { return __int_as_float(__builtin_amdgcn_update_dpp(0, __float_as_int(x), CTRL, 0xF, 0xF, true)); }
__device__ __forceinline__ float red16(float x) {
    x += dpp_f<0x140>(x);
    x += dpp_f<0x141>(x);
    x += dpp_f<0xB1>(x);
    x += dpp_f<0x4E>(x);
    return x;
}
__device__ __forceinline__ void st16_wt(void* p, u32x4 v) { asm volatile("global_store_dwordx4 %0, %1, off\n\ts_nop 1" :: "v"(p), "v"(v) : "memory"); }
__device__ __forceinline__ void st8_wt(void* p, u32x2 v) { asm volatile("global_store_dwordx2 %0, %1, off" :: "v"(p), "v"(v) : "memory"); }
__device__ __forceinline__ float xor32_add(float x) { auto rr = __builtin_amdgcn_permlane32_swap(__float_as_uint(x), __float_as_uint(x), false, false); return __uint_as_float(rr[0]) + __uint_as_float(rr[1]); }
__device__ __forceinline__ float xor32_max(float x) { auto rr = __builtin_amdgcn_permlane32_swap(__float_as_uint(x), __float_as_uint(x), false, false); return fmaxf(__uint_as_float(rr[0]), __uint_as_float(rr[1])); }
__device__ __forceinline__ float wave_sum(float v) {
    v = red16(v);
    v += __shfl_xor(v, 16); v = xor32_add(v);
    return v;
}
__device__ __forceinline__ float sigmoidf_(float x) { return __builtin_amdgcn_rcpf(1.0f + __expf(-x)); }
__device__ __forceinline__ float gelu_tanh(float x) { const float u = 1.5957691216057308f * (x + 0.044715f * x * x * x); return x * __builtin_amdgcn_rcpf(1.0f + __expf(-u)); }
__device__ __forceinline__ float tanh_(float x) { return 1.0f - 2.0f * __builtin_amdgcn_rcpf(1.0f + __expf(2.0f * x)); }

namespace pg8 {
constexpr int BM = 256, BK = 64, HALF = 128, HTB = HALF * BK * 2, STAGE_BYTES = 8 * HTB, NXCD = 8, WGM = 8;
__host__ __device__ __forceinline__ int lds_byte(int r, int c) { const int st = (r >> 4) * 2 + (c >> 5), rr = r & 15, cc = c & 31, ob = rr * 64 + cc * 2; return st * 1024 + (ob ^ (((ob >> 9) & 1) << 5)); }
__host__ __device__ __forceinline__ int perm32(int rho) { const int n = rho >> 4, i = rho & 15; return 8 * (i >> 2) + 4 * n + (i & 3); }
__host__ __device__ __forceinline__ void stage_rc(int b, int& R, int& C) { const int st = b / 1024, sb = b % 1024, swz = sb ^ (((sb >> 9) & 1) << 5); R = (st >> 1) * 16 + swz / 64; C = (st & 1) * 32 + (swz % 64) / 2; }
struct Unit { int pm, pn; };
struct Gemm { const bf16_t* A; const bf16_t* Bt; int M, N, K, lda, ldb; };
struct StaticOrder {
    int nM, nN, nwg, G, c;
    __device__ void init(int M, int N, int G_, int c_) { nM = M / BM; nN = N / BM; nwg = nM * nN; G = G_; c = c_; }
    __device__ bool next(int i, Unit& u) const {
        const int L = i * G + c; if (L >= nwg) return false;
        int wgid = L; { const int q = nwg / NXCD, r = nwg % NXCD, xcd = wgid % NXCD, off = wgid / NXCD; wgid = (xcd < r ? xcd * (q + 1) : r * (q + 1) + (xcd - r) * q) + off; }
        const int nig = WGM * nN, gid = wgid / nig, fm = gid * WGM, gsz = (nM - fm) < WGM ? (nM - fm) : WGM;
        u.pm = fm + ((wgid % nig) % gsz); u.pn = (wgid % nig) / gsz; return true;
    }
};
template <class Epi>
__device__ __forceinline__ void gemm_phase(LAS unsigned char* lds, const Gemm g, const StaticOrder& S, const Epi& E) {
    int tid_ = threadIdx.x; asm volatile("" : "+v"(tid_));
    const int tid = tid_, wid = __builtin_amdgcn_readfirstlane(tid >> 6), lane = tid & 63, wr = wid >> 2, wc = wid & 3, fr = lane & 15, fq = lane >> 4;
    const int K = g.K, nt = K / BK;
    unsigned voffA[2], voffB[2];
#pragma unroll
    for (int i = 0; i < 2; ++i) { int R, C; stage_rc(tid * 16 + i * 8192, R, C); const int Rb = Epi::PERM ? ((R & ~31) + perm32(R & 31)) : R; voffA[i] = (unsigned)(R * g.lda + C) * 2u; voffB[i] = (unsigned)(Rb * g.ldb + C) * 2u; }
    const size_t kstep = (size_t)(BK * 2);
    const size_t hsA = (size_t)HALF * g.lda * 2, hsB = (size_t)HALF * g.ldb * 2;
    const size_t tsA = 2 * hsA, tsB = 2 * hsB;
    const unsigned ldsw = (unsigned)wid * 1024u;
    const int aoff = lds_byte(wr * 64 + fr, fq * 8), boff = lds_byte(wc * 32 + fr, fq * 8);
#define PG8_SA(b, h) (((b) * 2 + (h)) * HTB)
#define PG8_SB(b, h) ((4 + (b) * 2 + (h)) * HTB)
#define PG8_STAGE(bufoff, gbase, voff) do { _Pragma("unroll") for (int _i = 0; _i < 2; ++_i) \
        __builtin_amdgcn_global_load_lds((const unsigned*)((const char*)(gbase) + (voff)[_i]), (LAS unsigned*)(lds + (bufoff) + ldsw + _i * 8192), 16, 0, 0); } while (0)
#define PG8_LDA(dst, b, h) do { _Pragma("unroll") for (int m = 0; m < 4; ++m) _Pragma("unroll") for (int k = 0; k < 2; ++k) dst[m][k] = *(const LAS bf16x8*)(lds + PG8_SA(b, h) + aoff + m * 2048 + k * 1024); } while (0)
#define PG8_LDB(dst, b, h) do { _Pragma("unroll") for (int n = 0; n < 2; ++n) _Pragma("unroll") for (int k = 0; k < 2; ++k) dst[n][k] = *(const LAS bf16x8*)(lds + PG8_SB(b, h) + boff + n * 2048 + k * 1024); } while (0)
#define PG8_MMA(ai, bj, At, Bt) do { __builtin_amdgcn_s_setprio(1); _Pragma("unroll") for (int m = 0; m < 4; ++m) _Pragma("unroll") for (int n = 0; n < 2; ++n) _Pragma("unroll") for (int k = 0; k < 2; ++k) \
        acc[ai][bj][m][n] = __builtin_amdgcn_mfma_f32_16x16x32_bf16(Bt[n][k], At[m][k], acc[ai][bj][m][n], 0, 0, 0); __builtin_amdgcn_s_setprio(0); } while (0)
#define PG8_WAIT_V(n) asm volatile("s_waitcnt vmcnt(" #n ")" ::: "memory")
#define PG8_WAIT_L(n) asm volatile("s_waitcnt lgkmcnt(" #n ")" ::: "memory")
#define PG8_BAR __builtin_amdgcn_s_barrier()
#define PG8_SCHED __builtin_amdgcn_sched_barrier(0)
    Unit cur, nxt; int ui = 0;
    if (!S.next(0, cur)) return;
    f32x4 acc[2][2][4][2];
#pragma unroll
    for (int a = 0; a < 2; ++a)
#pragma unroll
        for (int b = 0; b < 2; ++b)
#pragma unroll
            for (int m = 0; m < 4; ++m)
#pragma unroll
                for (int n = 0; n < 2; ++n) acc[a][b][m][n] = (f32x4){0.f, 0.f, 0.f, 0.f};
    bf16x8 At[4][2], B0[2][2], B1[2][2];
    const char* cA = (const char*)g.A + (size_t)cur.pm * tsA; const char* cB = (const char*)g.Bt + (size_t)cur.pn * tsB;
    PG8_STAGE(PG8_SB(0, 0), cB, voffB); PG8_STAGE(PG8_SB(0, 1), cB + hsB, voffB); PG8_STAGE(PG8_SA(0, 0), cA, voffA); PG8_STAGE(PG8_SA(0, 1), cA + hsA, voffA);
    if (wr == 1) PG8_BAR;
    PG8_WAIT_V(2); PG8_BAR;
    PG8_STAGE(PG8_SB(1, 0), cB + kstep, voffB); PG8_STAGE(PG8_SA(1, 0), cA + kstep, voffA); PG8_STAGE(PG8_SB(1, 1), cB + hsB + kstep, voffB);
    PG8_WAIT_V(6); PG8_BAR;
    for (;;) {
        const bool has_next = S.next(ui + 1, nxt);
        const char* nA = has_next ? (const char*)g.A + (size_t)nxt.pm * tsA : cA; const char* nB = has_next ? (const char*)g.Bt + (size_t)nxt.pn * tsB : cB;
#pragma unroll 1
        for (int t = 0; t < nt; t += 2) {
            const bool last = (t == nt - 2);
            const char* a1 = cA + (size_t)(t + 1) * kstep;
            const char* a2 = last ? nA : cA + (size_t)(t + 2) * kstep; const char* b2 = last ? nB : cB + (size_t)(t + 2) * kstep;
            const char* a3 = a2 + kstep; const char* b3 = b2 + kstep;
            PG8_LDB(B0, 0, 0); PG8_LDB(B1, 0, 1); PG8_SCHED; PG8_LDA(At, 0, 0); PG8_STAGE(PG8_SA(1, 1), a1 + hsA, voffA);
            PG8_WAIT_V(8); PG8_WAIT_L(0); PG8_BAR; PG8_MMA(0, 0, At, B0); PG8_MMA(0, 1, At, B1); PG8_BAR; PG8_SCHED;
            PG8_LDA(At, 0, 1); PG8_STAGE(PG8_SB(0, 0), b2, voffB); PG8_STAGE(PG8_SB(0, 1), b2 + hsB, voffB); PG8_STAGE(PG8_SA(0, 0), a2, voffA);
            PG8_WAIT_V(8); PG8_WAIT_L(0); PG8_BAR; PG8_MMA(1, 0, At, B0); PG8_MMA(1, 1, At, B1); PG8_BAR; PG8_SCHED;
            PG8_LDB(B0, 1, 0); PG8_LDB(B1, 1, 1); PG8_SCHED; PG8_LDA(At, 1, 0); PG8_STAGE(PG8_SA(0, 1), a2 + hsA, voffA);
            PG8_WAIT_V(8); PG8_WAIT_L(0); PG8_BAR; PG8_MMA(0, 0, At, B0); PG8_MMA(0, 1, At, B1); PG8_BAR; PG8_SCHED;
            PG8_LDA(At, 1, 1); PG8_STAGE(PG8_SB(1, 0), b3, voffB); PG8_STAGE(PG8_SB(1, 1), b3 + hsB, voffB); PG8_STAGE(PG8_SA(1, 0), a3, voffA);
            PG8_WAIT_V(8); PG8_WAIT_L(0); PG8_BAR; PG8_MMA(1, 0, At, B0); PG8_MMA(1, 1, At, B1); PG8_BAR; PG8_SCHED;
        }
        if (wr == 0) PG8_BAR;
        E(acc, cur, wr, wc, fr, fq);
        if (!has_next) break;
#pragma unroll
        for (int a = 0; a < 2; ++a)
#pragma unroll
            for (int b = 0; b < 2; ++b)
#pragma unroll
                for (int m = 0; m < 4; ++m)
#pragma unroll
                    for (int n = 0; n < 2; ++n) acc[a][b][m][n] = (f32x4){0.f, 0.f, 0.f, 0.f};
        cur = nxt; cA = nA; cB = nB; ++ui;
        if (wr == 1) PG8_BAR;
    }
    PG8_WAIT_V(0);
    PG8_BAR;
#undef PG8_SA
#undef PG8_SB
#undef PG8_STAGE
#undef PG8_LDA
#undef PG8_LDB
#undef PG8_MMA
#undef PG8_WAIT_V
#undef PG8_WAIT_L
#undef PG8_BAR
#undef PG8_SCHED
}
}
using pg8::Unit;

__device__ __forceinline__ void rows_rstd16(const float* ssq, int row0, int fq, float (&rs)[8]) {
    float p[8][4];
#pragma unroll
    for (int i = 0; i < 8; ++i) { const unsigned o = (unsigned)(4 * fq) * T + row0 + (i >> 2) * 128 + (i & 3) * 16;
#pragma unroll
        for (int k = 0; k < 4; ++k) p[i][k] = ssq[o + k * T]; }
#pragma unroll
    for (int i = 0; i < 8; ++i) { float s = (p[i][0] + p[i][1]) + (p[i][2] + p[i][3]); s += __shfl_xor(s, 16); s = xor32_add(s); rs[i] = rsqrtf(s * (1.0f / 1024.0f) + RMS_EPS); }
}
__device__ __forceinline__ void rows_rstd4(const float* pp, int row0, int fq, float invw, float mul, float (&rs)[8]) {
    float p[8];
#pragma unroll
    for (int i = 0; i < 8; ++i) p[i] = pp[(unsigned)fq * T + (unsigned)(row0 + (i >> 2) * 128 + (i & 3) * 16)];
#pragma unroll
    for (int i = 0; i < 8; ++i) { float s = p[i]; s += __shfl_xor(s, 16); s = xor32_add(s); rs[i] = rsqrtf(s * invw + RMS_EPS) * mul; }
}

struct EpiSwiGLU {
    static constexpr bool PERM = false;
    bf16_t* act; const float* ssq;
    __device__ __forceinline__ void operator()(const f32x4 (&acc)[2][2][4][2], const Unit& u, int wr, int wc, int fr, int fq) const {
        const int row0 = u.pm * 256 + wr * 64 + fr;
        const unsigned off0 = (unsigned)row0 * FF + u.pn * 128 + wc * 32 + fq * 8;
        float rsv[8]; rows_rstd16(ssq, row0, fq, rsv);
#pragma unroll
        for (int ai = 0; ai < 2; ++ai)
#pragma unroll
            for (int m = 0; m < 4; ++m) {
                const float rs = rsv[ai * 4 + m];
                u32x4 w;
#pragma unroll
                for (int bj = 0; bj < 2; ++bj) {
                    const f32x4 gt = acc[ai][bj][m][0] * rs, up = acc[ai][bj][m][1] * rs; f32x4 o;
#pragma unroll
                    for (int k = 0; k < 4; ++k) o[k] = gt[k] * up[k] * __builtin_amdgcn_rcpf(1.0f + __expf(-gt[k]));
                    const u32x2 pw = pack4(o); if (bj == 0) { w.x = pw.x; w.y = pw.y; } else { w.z = pw.x; w.w = pw.y; }
                }
                st16_wt(act + (off0 + (unsigned)((ai * 128 + m * 16) * FF)), w);
            }
    }
};
struct EpiResid {
    static constexpr bool PERM = true;
    bf16_t* xb; float* ssq; float scale;
    __device__ __forceinline__ void operator()(const f32x4 (&acc)[2][2][4][2], const Unit& u, int wr, int wc, int fr, int fq) const {
        const int row0 = u.pm * 256 + wr * 64 + fr;
        const unsigned off0 = (unsigned)row0 * DM + u.pn * 256 + wc * 32 + fq * 8;
        const unsigned so = (unsigned)(u.pn * 4 + wc) * T + row0;
#pragma unroll
        for (int ai = 0; ai < 2; ++ai) {
            u32x4 bv[4][2];
#pragma unroll
            for (int m = 0; m < 4; ++m)
#pragma unroll
                for (int bj = 0; bj < 2; ++bj) bv[m][bj] = *(const u32x4*)(xb + (off0 + (unsigned)((ai * 128 + m * 16) * DM + bj * 128)));
#pragma unroll
            for (int m = 0; m < 4; ++m) {
                float ss = 0.f;
#pragma unroll
                for (int bj = 0; bj < 2; ++bj) {
                    const unsigned o2 = off0 + (unsigned)((ai * 128 + m * 16) * DM + bj * 128);
                    const f32x4 v0 = unpack4((u32x2){bv[m][bj].x, bv[m][bj].y}) + acc[ai][bj][m][0] * scale;
                    const f32x4 v1 = unpack4((u32x2){bv[m][bj].z, bv[m][bj].w}) + acc[ai][bj][m][1] * scale;
                    const u32x2 p0 = pack4(v0), p1 = pack4(v1);
                    st16_wt(xb + o2, (u32x4){p0.x, p0.y, p1.x, p1.y});
                    ss += ((v0[0] * v0[0] + v0[1] * v0[1]) + (v0[2] * v0[2] + v0[3] * v0[3])) + ((v1[0] * v1[0] + v1[1] * v1[1]) + (v1[2] * v1[2] + v1[3] * v1[3]));
                }
                ss += __shfl_xor(ss, 16); ss = xor32_add(ss);
                if (fq == 0) ssq[so + (unsigned)(ai * 128 + m * 16)] = ss;
            }
            asm volatile("" ::: "memory");
        }
    }
};
template <bool ODD> struct EpiZ {
    static constexpr bool PERM = true;
    bf16_t* z; int ldz; const float* ssq; float* pq; float* pkv;
    __device__ __forceinline__ void operator()(const f32x4 (&acc)[2][2][4][2], const Unit& u, int wr, int wc, int fr, int fq) const {
        const int row0 = u.pm * 256 + wr * 64 + fr;
        const unsigned off0 = (unsigned)row0 * ldz + u.pn * 256 + wc * 32 + fq * 8;
        float rsv[8]; rows_rstd16(ssq, row0, fq, rsv);
#pragma unroll
        for (int ai = 0; ai < 2; ++ai)
#pragma unroll
            for (int m = 0; m < 4; ++m) {
                const int row = row0 + ai * 128 + m * 16;
                const float rs = rsv[ai * 4 + m];
                float s0 = 0.f, s1 = 0.f;
#pragma unroll
                for (int bj = 0; bj < 2; ++bj) {
                    const f32x4 v0 = acc[ai][bj][m][0] * rs, v1 = acc[ai][bj][m][1] * rs;
                    const u32x2 p0 = pack4(v0), p1 = pack4(v1);
                    st16_wt(z + (off0 + (unsigned)((ai * 128 + m * 16) * ldz + bj * 128)), (u32x4){p0.x, p0.y, p1.x, p1.y});
                    const float q = ((v0[0] * v0[0] + v0[1] * v0[1]) + (v0[2] * v0[2] + v0[3] * v0[3])) + ((v1[0] * v1[0] + v1[1] * v1[1]) + (v1[2] * v1[2] + v1[3] * v1[3]));
                    if (bj == 0) s0 += q; else s1 += q;
                }
                if (ODD) {
                    if (u.pn == 0) { float s = s0 + s1; s += __shfl_xor(s, 16); s = xor32_add(s); if (fq == 0) pq[(unsigned)wc * T + row] = s; }
                    else if (u.pn == 1) { float s = s0; s += __shfl_xor(s, 16); s = xor32_add(s); if (fq == 0) pkv[(unsigned)wc * T + row] = s; }
                }
            }
    }
};
struct EpiUp {
    static constexpr bool PERM = true;
    bf16_t* q; bf16_t* kv; const float* pq; const float* pkv; const float* cosT; const float* sinT;
    __device__ __forceinline__ void operator()(const f32x4 (&acc)[2][2][4][2], const Unit& u, int wr, int wc, int fr, int fq) const {
        const int row0 = u.pm * 256 + wr * 64 + fr;
        float rsv[8];
        if (u.pn < 3) {
            rows_rstd4(pq, row0, fq, 1.0f / 256.0f, QSCALE, rsv);
#pragma unroll
            for (int bj = 0; bj < 2; ++bj) {
                const int G = u.pn * 8 + bj * 4 + wc;
                const bool rope = (G % 3) == 2;
#pragma unroll
                for (int ai = 0; ai < 2; ++ai)
#pragma unroll
                    for (int m = 0; m < 4; ++m) {
                        const int row = row0 + ai * 128 + m * 16; const float rs = rsv[ai * 4 + m];
                        f32x4 v0 = acc[ai][bj][m][0] * rs, v1 = acc[ai][bj][m][1] * rs;
                        if (rope) {
                            const int pos = row & (SEQ - 1);
                            const f32x4 c4 = *(const f32x4*)(cosT + (unsigned)(pos * 16 + fq * 4)), s4 = *(const f32x4*)(sinT + (unsigned)(pos * 16 + fq * 4));
                            const f32x4 o0 = v0 * c4 - v1 * s4, o1 = v0 * s4 + v1 * c4; v0 = o0; v1 = o1;
                        }
                        const u32x2 p0 = pack4(v0), p1 = pack4(v1);
                        st16_wt(q + (unsigned)(row * 768 + G * 32 + fq * 8), (u32x4){p0.x, p0.y, p1.x, p1.y});
                    }
            }
        } else {
            rows_rstd4(pkv, row0, fq, 1.0f / 128.0f, 1.0f, rsv);
#pragma unroll
            for (int ai = 0; ai < 2; ++ai)
#pragma unroll
                for (int m = 0; m < 4; ++m) {
                    const int row = row0 + ai * 128 + m * 16; const float rs = rsv[ai * 4 + m];
#pragma unroll
                    for (int bj = 0; bj < 2; ++bj) {
                        const u32x2 p0 = pack4(acc[ai][bj][m][0] * rs), p1 = pack4(acc[ai][bj][m][1] * rs);
                        st16_wt(kv + (unsigned)(row * 1024 + (u.pn - 3) * 256 + bj * 128 + wc * 32 + fq * 8), (u32x4){p0.x, p0.y, p1.x, p1.y});
                    }
                }
        }
    }
};

#define XB_TMO      128
#define XB_XCNT(j)  (256  + 64 * (j))
#define XB_XSUB(j)  (1280 + 64 * (j))
#define XB_XGEN(j)  (2304 + 64 * (j))
#define XB_TOP      3328
#define XB_TOPGEN   3392
#define XCD_BAR_WORDS 3456
#define XB_LSUB(j)  (3456 + 64 * (j))
#define XB_LGEN(j)  (4480 + 64 * (j))
#define XB_SPIN_CAP (1u << 18)
__device__ __forceinline__ unsigned xb_ld(unsigned* p)              { return __hip_atomic_load(p, __ATOMIC_RELAXED, __HIP_MEMORY_SCOPE_AGENT); }
__device__ __forceinline__ unsigned xb_add(unsigned* p, unsigned v) { return __hip_atomic_fetch_add(p, v, __ATOMIC_RELAXED, __HIP_MEMORY_SCOPE_AGENT); }
__device__ __forceinline__ unsigned xb_xcc_id() { return (unsigned)__builtin_amdgcn_s_getreg((3 << 11) | 20) & 0xFu; }
#define XB_SPIN(cond, bar) do { unsigned _sp = 0; while (cond) { __builtin_amdgcn_s_sleep(1); \
    if ((++_sp & 255u) == 0u) { if (xb_ld(&(bar)[XB_TMO])) break; if (_sp > XB_SPIN_CAP) { atomicAdd(&(bar)[XB_TMO], 1u); break; } } } } while (0)
struct XcdBarrier { unsigned* bar; unsigned x; volatile LAS unsigned* st; };
__device__ __forceinline__ XcdBarrier xcd_barrier_post(unsigned* bar, volatile LAS unsigned* st) {
    XcdBarrier b; b.bar = bar; b.x = xb_xcc_id(); b.st = st;
    if (threadIdx.x == 0) st[3] = xb_add(&bar[XB_XCNT(b.x)], 1u);
    return b;
}
__device__ __forceinline__ void xcd_barrier_complete(unsigned* bar, unsigned x, unsigned& nloc, unsigned& nx, unsigned& regular) {
    const unsigned G = gridDim.x * gridDim.y * gridDim.z;
    unsigned sum, cnt, mine, sp = 0u;
    for (;;) {
        sum = 0u; cnt = 0u; mine = 0u;
#pragma unroll
        for (unsigned j = 0; j < 16; ++j) { const unsigned c = xb_ld(&bar[XB_XCNT(j)]); sum += c; cnt += (c > 0u) ? 1u : 0u; mine = (j == x) ? c : mine; }
        if (sum == G) break;
        __builtin_amdgcn_s_sleep(1);
        if ((++sp & 255u) == 0u) { if (xb_ld(&bar[XB_TMO])) break; if (sp > XB_SPIN_CAP) { atomicAdd(&bar[XB_TMO], 1u); break; } }
    }
    nloc = mine > 0u ? mine : 1u; nx = cnt > 0u ? cnt : 1u;
    unsigned reg = (G == 256u) ? 1u : 0u;
#pragma unroll
    for (unsigned j = 0; j < 16; ++j) { const unsigned c = xb_ld(&bar[XB_XCNT(j)]); if (c != (j < 8u ? 32u : 0u)) reg = 0u; }
    regular = reg;
}
__device__ __forceinline__ void xcd_barrier(const XcdBarrier& b) {
    asm volatile("s_waitcnt vmcnt(0)" ::: "memory");
    __syncthreads();
    if (threadIdx.x == 0) {
        unsigned* bar = b.bar;
        __builtin_amdgcn_s_waitcnt(0);
        unsigned nloc = b.st[0], nx = b.st[1];
        if (nloc == 0u) { unsigned reg_; xcd_barrier_complete(bar, b.x, nloc, nx, reg_); b.st[0] = nloc; b.st[1] = nx; b.st[2] = reg_; }
        const unsigned old = xb_add(&bar[XB_XSUB(b.x)], 1u);
        const unsigned gen = old / nloc;
        if (old + 1u == (gen + 1u) * nloc) {
            __builtin_amdgcn_fence(__ATOMIC_RELEASE, "agent");
            asm volatile("s_waitcnt vmcnt(0)" ::: "memory");
            const unsigned og = xb_add(&bar[XB_TOP], 1u);
            const unsigned tg = og / nx;
            if (og + 1u == (tg + 1u) * nx) xb_add(&bar[XB_TOPGEN], 1u);
            else XB_SPIN(xb_ld(&bar[XB_TOPGEN]) == tg, bar);
            __builtin_amdgcn_fence(__ATOMIC_ACQUIRE, "agent");
            xb_add(&bar[XB_XGEN(b.x)], 1u);
            asm volatile("s_waitcnt vmcnt(0)" ::: "memory");
        } else {
            XB_SPIN(xb_ld(&bar[XB_XGEN(b.x)]) == gen, bar);
            __builtin_amdgcn_fence(__ATOMIC_ACQUIRE, "agent");
            asm volatile("s_waitcnt vmcnt(0)" ::: "memory");
        }
    }
    __syncthreads();
}
__device__ __forceinline__ void xcd_local_barrier(const XcdBarrier& b) {
    asm volatile("s_waitcnt vmcnt(0)" ::: "memory");
    __syncthreads();
    if (threadIdx.x == 0) {
        unsigned* bar = b.bar;
        __builtin_amdgcn_s_waitcnt(0);
        const unsigned nloc = b.st[0];
        const unsigned old = xb_add(&bar[XB_LSUB(b.x)], 1u);
        const unsigned gen = old / nloc;
        if (old + 1u == (gen + 1u) * nloc) xb_add(&bar[XB_LGEN(b.x)], 1u);
        else XB_SPIN(xb_ld(&bar[XB_LGEN(b.x)]) == gen, bar);
        __builtin_amdgcn_fence(__ATOMIC_ACQUIRE, "agent");
        asm volatile("s_waitcnt vmcnt(0)" ::: "memory");
    }
    __syncthreads();
}
template <int K> __device__ __forceinline__ const float* inp() {
    unsigned long long v;
    const unsigned long long kp_ = (unsigned long long)__builtin_amdgcn_kernarg_segment_ptr();
    const unsigned long long kps_ = ((unsigned long long)(unsigned)__builtin_amdgcn_readfirstlane((int)(unsigned)(kp_ >> 32)) << 32) | (unsigned)__builtin_amdgcn_readfirstlane((int)(unsigned)kp_);
    asm volatile("s_load_dwordx2 %0, %1, %2\n\ts_waitcnt lgkmcnt(0)" : "=s"(v) : "s"(kps_), "n"(K * 8) : "memory");
    return (const float*)(const __attribute__((address_space(1))) float*)v;
}
struct Args { const float* in[36]; float* out; unsigned char* ws; int ph_lo, ph_hi; };
struct Frame {
    LAS unsigned char* lds;
    int tid, lane, wave, G, bid;
    float* out; unsigned char* ws;
};

struct CvtDesc { const float* W; const float* gain; bf16_t* WT; int N, ldt, kdst, mode, item; };
__device__ __forceinline__ void cvt_load(const CvtDesc& d, int lane, f32x4 (&v)[8], float (&g)[8]) {
    const int nblk = d.N / 32, kb = d.item / nblk, nb = d.item % nblk, k0 = 64 * kb, n0 = 32 * nb;
    const int kq = lane >> 3, nq = (lane & 7) * 4;
#pragma unroll
    for (int i = 0; i < 8; ++i) v[i] = *(const f32x4*)(d.W + (size_t)(k0 + i * 8 + kq) * d.N + n0 + nq);
#pragma unroll
    for (int i = 0; i < 8; ++i) g[i] = d.gain ? d.gain[k0 + i * 8 + kq] : 1.0f;
}
__device__ __forceinline__ void cvt_finish(const CvtDesc& d, int lane, LAS float* scr, const f32x4 (&v)[8], const float (&g)[8]) {
    const int nblk = d.N / 32, kb = d.item / nblk, nb = d.item % nblk, k0 = 64 * kb, n0 = 32 * nb;
    const int kq = lane >> 3, nq = (lane & 7) * 4;
#pragma unroll
    for (int i = 0; i < 8; ++i) { const int kk = i * 8 + kq; const float gk = g[i]; LAS float* dd = scr + kk * 33 + nq; dd[0] = v[i][0] * gk; dd[1] = v[i][1] * gk; dd[2] = v[i][2] * gk; dd[3] = v[i][3] * gk; }
    asm volatile("s_waitcnt lgkmcnt(0)" ::: "memory");
    const int c = lane & 7;
#pragma unroll
    for (int j = 0; j < 4; ++j) {
        const int n = (lane >> 3) + 8 * j; const LAS float* sp_ = scr + (8 * c) * 33 + n;
        u32x4 o; o.x = pk2(sp_[0 * 33], sp_[1 * 33]); o.y = pk2(sp_[2 * 33], sp_[3 * 33]); o.z = pk2(sp_[4 * 33], sp_[5 * 33]); o.w = pk2(sp_[6 * 33], sp_[7 * 33]);
        int nn = n0 + n;
        if (d.mode == 1) { const int which = nn >= FF ? 1 : 0, h = nn - which * FF, hl = h & 127; nn = 256 * (h >> 7) + 128 * ((hl >> 2) & 1) + 32 * (hl >> 5) + 16 * which + 4 * ((hl >> 3) & 3) + (hl & 3); }
        if (d.mode == 2) { const int hd = nn / 96, dd = nn % 96; if (dd >= 64) { const int r_ = dd - 64, n_ = r_ >> 4, i_ = r_ & 15; nn = hd * 96 + 64 + 8 * (i_ >> 2) + 4 * n_ + (i_ & 3); } }
        st16_wt(d.WT + (size_t)nn * d.ldt + d.kdst + k0 + 8 * c, o);
    }
    asm volatile("s_waitcnt lgkmcnt(0)" ::: "memory");
}
__device__ __forceinline__ void zero_fill16(unsigned char* base, int row_bytes_stride, int col_byte0, int chunks_per_row, int nrows, int gtid, int gthreads) {
    const int total = nrows * chunks_per_row;
    unsigned zz = 0u; asm volatile("" : "+v"(zz));
    const u32x4 z4 = (u32x4){zz, zz, zz, zz};
    for (int i = gtid; i < total; i += gthreads) { const int r = i / chunks_per_row, c = i % chunks_per_row; st16_wt(base + (size_t)r * row_bytes_stride + col_byte0 + c * 16, z4); }
}
__device__ __forceinline__ void convert_layer(const Frame& F, int l, int part, int nparts, int vb, int nvb) {
    unsigned char* wb = F.ws + WS_WBUF0 + (size_t)(l & 1) * WBUF_BYTES;
    LAS float* scr = (LAS float*)(F.lds + F.wave * 16384);
    const int gw = vb * 8 + F.wave, NGW = nvb * 8;
    const int hl = l >> 1; const bool odd = l & 1;
    constexpr int I_IN = 16 * 176, I_OUT = 44 * 32, I_MO = 16 * 32;
    const int I_MI = odd ? 16 * 45 : 16 * 88;
    const int I_X = odd ? (4 * 24 + 2 * 32) : (16 + 16 + 32);
    const int total = 2 * I_IN + 2 * I_OUT + I_MI + I_MO + I_X;
    const int it_lo = (int)((long)total * part / nparts), it_hi = (int)((long)total * (part + 1) / nparts);
    auto desc = [&](int it) -> CvtDesc {
        CvtDesc d; d.kdst = 0; d.mode = 0; d.gain = nullptr;
        int r = it;
        if (r < I_IN) { d.W = inp<2>() + (size_t)l * DM * 2 * FF; d.N = 2 * FF; d.gain = inp<1>() + l * DM; d.WT = (bf16_t*)(wb + WB_W1IN); d.ldt = DM; d.mode = 1; d.item = r; return d; } r -= I_IN;
        if (r < I_IN) { d.W = inp<6>() + (size_t)l * DM * 2 * FF; d.N = 2 * FF; d.gain = inp<5>() + l * DM; d.WT = (bf16_t*)(wb + WB_W2IN); d.ldt = DM; d.mode = 1; d.item = r; return d; } r -= I_IN;
        if (r < I_OUT) { d.W = inp<3>() + (size_t)l * FF * DM; d.N = DM; d.WT = (bf16_t*)(wb + WB_W1OUT); d.ldt = FF; d.item = r; return d; } r -= I_OUT;
        if (r < I_OUT) { d.W = inp<7>() + (size_t)l * FF * DM; d.N = DM; d.WT = (bf16_t*)(wb + WB_W2OUT); d.ldt = FF; d.item = r; return d; } r -= I_OUT;
        if (r < I_MI) {
            if (odd) { d.W = inp<25>() + (size_t)hl * DM * PO; d.N = PO; } else { d.W = inp<8>() + (size_t)hl * DM * PE; d.N = PE; }
            d.gain = inp<4>() + l * DM; d.WT = (bf16_t*)(wb + WB_WMIN); d.ldt = DM; d.item = r; return d; } r -= I_MI;
        if (r < I_MO) { d.W = (odd ? inp<26>() : inp<9>()) + (size_t)hl * DM * DM; d.N = DM; d.WT = (bf16_t*)(wb + WB_WMOUT); d.ldt = DM; d.item = r; return d; } r -= I_MO;
        if (odd) {
            if (r < 96) { d.W = inp<28>() + (size_t)hl * 256 * 768; d.N = 768; d.gain = inp<27>() + hl * 256; d.WT = (bf16_t*)(wb + WB_WX); d.ldt = 384; d.mode = 2; d.item = r; return d; } r -= 96;
            d.W = inp<30>() + (size_t)hl * 128 * 1024; d.N = 1024; d.gain = inp<29>() + hl * 128; d.WT = (bf16_t*)(wb + WB_WX) + (size_t)768 * 384; d.ldt = 384; d.kdst = 256; d.item = r; return d;
        }
        if (r < 16) { d.W = inp<16>() + (size_t)hl * 64 * 512; d.N = 512; d.WT = (bf16_t*)(wb + WB_WX); d.ldt = 64; d.item = r; return d; } r -= 16;
        if (r < 16) { d.W = inp<18>() + (size_t)hl * 64 * 512; d.N = 512; d.WT = (bf16_t*)(wb + WB_WX) + 512 * 64; d.ldt = 64; d.item = r; return d; } r -= 16;
        d.W = inp<19>() + (size_t)hl * 128 * 512; d.N = 512; d.WT = (bf16_t*)(wb + WB_WX) + 2 * 512 * 64; d.ldt = 128; d.item = r; return d;
    };
    {
        int it = it_lo + gw;
        if (it < it_hi) {
            CvtDesc d0 = desc(it), d1 = d0; f32x4 va[8], vc[8]; float ga[8], gc[8];
            cvt_load(d0, F.lane, va, ga);
            for (;;) {
                const int it1 = it + NGW; const bool h1 = it1 < it_hi;
                if (h1) { d1 = desc(it1); cvt_load(d1, F.lane, vc, gc); }
                cvt_finish(d0, F.lane, scr, va, ga);
                if (!h1) break;
                const int it2 = it1 + NGW; const bool h2 = it2 < it_hi;
                if (h2) { d0 = desc(it2); cvt_load(d0, F.lane, va, ga); }
                cvt_finish(d1, F.lane, scr, vc, gc);
                if (!h2) break;
                it = it2;
            }
        }
    }
    if (odd && part == 0) {
        const int gtid = vb * 512 + F.tid, gth = nvb * 512;
        zero_fill16(wb + WB_WMIN + (size_t)PO * DM * 2, DM * 2, 0, 128, POP - PO, gtid, gth);
        zero_fill16(wb + WB_WX, 384 * 2, 512, 16, 768, gtid, gth);
        zero_fill16(wb + WB_WX + (size_t)768 * 384 * 2, 384 * 2, 0, 32, 1024, gtid, gth);
    }
}

__device__ __forceinline__ void x_prologue(const Frame& F) {
    const float* x = inp<0>(); bf16_t* xb = (bf16_t*)(F.ws + WS_XB); float* ssq = (float*)(F.ws + WS_SSQ);
    const int gw = F.bid * 8 + F.wave, NGW = F.G * 8, lane = F.lane;
    for (int m = gw; m < T; m += NGW) {
        const f32x4* xr = (const f32x4*)(x + (size_t)m * DM) + lane;
        f32x4 v[4]; float s = 0.f;
#pragma unroll
        for (int j = 0; j < 4; ++j) { v[j] = xr[64 * j]; s += (v[j][0] * v[j][0] + v[j][1] * v[j][1]) + (v[j][2] * v[j][2] + v[j][3] * v[j][3]); }
        s = wave_sum(s);
        u32x2* o = (u32x2*)(xb + (size_t)m * DM) + lane;
#pragma unroll
        for (int j = 0; j < 4; ++j) st8_wt(o + 64 * j, pack4(v[j]));
        if (lane < 16) ssq[(size_t)lane * T + m] = (lane == 0) ? s : 0.f;
    }
    float* cosT = (float*)(F.ws + WS_COS); float* sinT = (float*)(F.ws + WS_SIN);
    for (int i = F.bid * 512 + F.tid; i < SEQ * 16; i += F.G * 512) {
        const int pos = i >> 4, k = i & 15;
        const float inv = exp2f(-(float)k * 0.8304820237218407f);
        const float ang = (float)pos * inv;
        const double rev = (double)ang * 0.15915494309189535;
        const float fr = (float)(rev - floor(rev));
        cosT[i] = __builtin_amdgcn_cosf(fr); sinT[i] = __builtin_amdgcn_sinf(fr);
    }
}
__device__ __forceinline__ void final_norm(const Frame& F) {
    const float* g = inp<35>(); float* x = F.out; const bf16_t* xb = (const bf16_t*)(F.ws + WS_XB);
    const int gw = F.bid * 8 + F.wave, NGW = F.G * 8, lane = F.lane;
    for (int m = gw; m < T; m += NGW) {
        f32x4* xr = (f32x4*)(x + (size_t)m * DM) + lane;
        const u32x2* br = (const u32x2*)(xb + (size_t)m * DM) + lane;
        f32x4 v[4]; float s = 0.f;
#pragma unroll
        for (int j = 0; j < 4; ++j) { v[j] = unpack4(br[64 * j]); s += (v[j][0] * v[j][0] + v[j][1] * v[j][1]) + (v[j][2] * v[j][2] + v[j][3] * v[j][3]); }
        s = wave_sum(s);
        const float rs = rsqrtf(s * (1.0f / 1024.0f) + RMS_EPS);
#pragma unroll
        for (int j = 0; j < 4; ++j) { const f32x4 gg = *((const f32x4*)g + lane + 64 * j); xr[64 * j] = v[j] * rs * gg; }
    }
}

__device__ __forceinline__ void gsu_item(const Frame& F, int item, int e) {
    const int nb = item >> 2, g = item & 3, tok0 = nb * 128, lane = F.lane, wave = F.wave, fr = lane & 15, fq = lane >> 4;
    const bf16_t* z = (const bf16_t*)(F.ws + WS_ACT);
    bf16_t* ymix = (bf16_t*)(F.ws + WS_YMIX);
    const float* ws = inp<10>() + (size_t)(e * 4 + g) * 128 * 128; const float* bs = inp<11>() + (e * 4 + g) * 128;
    const float* lng = inp<12>() + e * 512; const float* lnb = inp<13>() + e * 512;
    LAS bf16_t* vn = (LAS bf16_t*)F.lds;
    u32x4 zrs[16];
#pragma unroll
    for (int fi = 0; fi < 16; ++fi) zrs[fi] = *(const u32x4*)(z + (size_t)(tok0 + wave * 16 + fi) * PE + 512 + lane * 8);
    float lgv[8], lbv[8];
#pragma unroll
    for (int k = 0; k < 8; ++k) { lgv[k] = lng[lane * 8 + k]; lbv[k] = lnb[lane * 8 + k]; }
#pragma unroll
    for (int fi = 0; fi < 16; ++fi) {
        const int frame = wave * 16 + fi;
        const u32x4 zr = zrs[fi];
        float gv[8]; gv[0] = bflo(zr.x); gv[1] = bfhi(zr.x); gv[2] = bflo(zr.y); gv[3] = bfhi(zr.y); gv[4] = bflo(zr.z); gv[5] = bfhi(zr.z); gv[6] = bflo(zr.w); gv[7] = bfhi(zr.w);
        float s = 0.f;
#pragma unroll
        for (int k = 0; k < 8; ++k) { gv[k] = gelu_tanh(gv[k]); s += gv[k]; }
        const float mean = wave_sum(s) * (1.0f / 512.0f); float qv = 0.f;
#pragma unroll
        for (int k = 0; k < 8; ++k) { gv[k] -= mean; qv += gv[k] * gv[k]; }
        const float rstd = rsqrtf(wave_sum(qv) * (1.0f / 512.0f) + 1e-5f);
        if ((lane >> 4) == g) {
            const int cl = (lane & 15) * 8;
#pragma unroll
            for (int k = 0; k < 8; ++k) { const float o = gv[k] * rstd * lgv[k] + lbv[k]; vn[(cl + k) * 136 + frame] = (bf16_t)(pk2(o, 0.f) & 0xffffu); }
        }
    }
    __syncthreads();
    const int i = wave * 16 + fr; const int nks = (wave < 4) ? 2 : 4;
    f32x4 acc[8];
#pragma unroll
    for (int ct = 0; ct < 8; ++ct) acc[ct] = (f32x4){0.f, 0.f, 0.f, 0.f};
    for (int ks = 0; ks < nks; ++ks) {
        const float* wp = ws + (size_t)i * 128 + ks * 32 + fq * 8;
        const f32x4 w0 = *(const f32x4*)wp, w1 = *(const f32x4*)(wp + 4);
        u32x4 wy; wy.x = pk2(w0[0], w0[1]); wy.y = pk2(w0[2], w0[3]); wy.z = pk2(w1[0], w1[1]); wy.w = pk2(w1[2], w1[3]);
        const bf16x8 Y = __builtin_bit_cast(bf16x8, wy);
#pragma unroll
        for (int ct = 0; ct < 8; ++ct) {
            const bf16x8 X = *(const LAS bf16x8*)(vn + (ct * 16 + fr) * 136 + ks * 32 + fq * 8);
            acc[ct] = __builtin_amdgcn_mfma_f32_16x16x32_bf16(X, Y, acc[ct], 0, 0, 0);
        }
    }
    const size_t tok = tok0 + i; const float bsv = bs[i];
#pragma unroll
    for (int ct = 0; ct < 8; ++ct) {
        const int c = g * 128 + ct * 16 + fq * 4;
        const f32x4 uz = unpack4(*(const u32x2*)(z + tok * PE + c)); f32x4 o;
#pragma unroll
        for (int k = 0; k < 4; ++k) o[k] = gelu_tanh(uz[k]) * (acc[ct][k] + bsv);
        st8_wt(ymix + tok * DM + c, pack4(o));
    }
    __syncthreads();
}

__device__ __forceinline__ void prep_item(const Frame& F, int item, int e, const unsigned char* wb) {
    const int tok0 = item * 32, b = tok0 / SEQ, t0 = tok0 % SEQ, lane = F.lane, h = F.wave, fr = lane & 15, fq = lane >> 4, tid = F.tid;
    const bf16_t* z = (const bf16_t*)(F.ws + WS_ACT);
    bf16_t* ymix = (bf16_t*)(F.ws + WS_YMIX); bf16_t* sc = (bf16_t*)(F.ws + WS_SC); float* cb = (float*)(F.ws + WS_CB);
    const float* mu = inp<14>() + e * PB; const float* w0p = inp<15>() + e * 512; const float* a0p = inp<17>() + e * 512;
    const float* kkp = inp<20>() + e * 512; const float* kap = inp<21>() + e * 512; const float* rkp = inp<22>() + e * 512;
    LAS bf16_t* At = (LAS bf16_t*)F.lds;
    LAS float* PRM = (LAS float*)(F.lds + 32768);
    {
        PRM[0 * 512 + tid] = mu[tid]; PRM[1 * 512 + tid] = mu[512 + tid]; PRM[2 * 512 + tid] = mu[1024 + tid];
        PRM[3 * 512 + tid] = kkp[tid]; PRM[4 * 512 + tid] = kap[tid]; PRM[5 * 512 + tid] = rkp[tid];
        PRM[6 * 512 + tid] = w0p[tid]; PRM[7 * 512 + tid] = a0p[tid];
    }
    {
        const int token = tid >> 4, chunk = tid & 15, t = t0 + token; const size_t tok = tok0 + token;
        const bf16_t* zp = z + tok * PE + 2560 + chunk * 16;
        const u32x4 c0 = *(const u32x4*)zp, c1 = *(const u32x4*)(zp + 8);
        const bf16_t* zq = (t > 0) ? zp - PE : zp;
        u32x4 p0 = *(const u32x4*)zq, p1 = *(const u32x4*)(zq + 8);
        if (t == 0) { p0 = (u32x4){0u, 0u, 0u, 0u}; p1 = p0; }
        float cv[16], pv[16];
#pragma unroll
        for (int k = 0; k < 4; ++k) { cv[2 * k] = bflo(c0[k]); cv[2 * k + 1] = bfhi(c0[k]); cv[8 + 2 * k] = bflo(c1[k]); cv[9 + 2 * k] = bfhi(c1[k]);
                                      pv[2 * k] = bflo(p0[k]); pv[2 * k + 1] = bfhi(p0[k]); pv[8 + 2 * k] = bflo(p1[k]); pv[9 + 2 * k] = bfhi(p1[k]); }
        const f32x4* mup = (const f32x4*)(mu + 1536 + chunk * 16);
        const f32x4 m0 = mup[0], m1 = mup[1], m2 = mup[2], m3 = mup[3];
        const float mv_[16] = {m0[0], m0[1], m0[2], m0[3], m1[0], m1[1], m1[2], m1[3], m2[0], m2[1], m2[2], m2[3], m3[0], m3[1], m3[2], m3[3]};
#pragma unroll
        for (int k = 0; k < 16; ++k) cv[k] = cv[k] + mv_[k] * (pv[k] - cv[k]);
        if (chunk < 4) {
#pragma unroll
            for (int k = 0; k < 16; ++k) cv[k] = tanh_(cv[k]);
        } else if (chunk >= 8) {
#pragma unroll
            for (int k = 0; k < 16; ++k) cv[k] = sigmoidf_(cv[k]);
        }
        u32x4 o0, o1;
#pragma unroll
        for (int k = 0; k < 4; ++k) { o0[k] = pk2(cv[2 * k], cv[2 * k + 1]); o1[k] = pk2(cv[8 + 2 * k], cv[9 + 2 * k]); }
        *(LAS u32x4*)(At + token * 264 + chunk * 16) = o0; *(LAS u32x4*)(At + token * 264 + chunk * 16 + 8) = o1;
    }
    __syncthreads();
    const bf16_t* DUt = (const bf16_t*)(wb + WB_WX); const bf16_t* IUt = DUt + 512 * 64; const bf16_t* GUt = DUt + 2 * 512 * 64;
#pragma unroll
    for (int mt = 0; mt < 2; ++mt) {
        const LAS bf16_t* Ar = At + (mt * 16 + fr) * 264 + fq * 8;
        const int t = t0 + mt * 16 + fr; const size_t tok = tok0 + mt * 16 + fr; const bool hp = t > 0;
        f32x4 ev[4], av[4];
        {
            f32x4 acc[4];
#pragma unroll
            for (int nt = 0; nt < 4; ++nt) acc[nt] = (f32x4){0.f, 0.f, 0.f, 0.f};
#pragma unroll
            for (int ks = 0; ks < 2; ++ks) {
                const bf16x8 Yv = *(const LAS bf16x8*)(Ar + 0 + ks * 32);
#pragma unroll
                for (int nt = 0; nt < 4; ++nt) {
                    const bf16x8 X = *(const bf16x8*)(DUt + (size_t)(h * 64 + 32 * (nt >> 1) + 8 * (fr >> 2) + 4 * (nt & 1) + (fr & 3)) * 64 + ks * 32 + fq * 8);
                    acc[nt] = __builtin_amdgcn_mfma_f32_16x16x32_bf16(X, Yv, acc[nt], 0, 0, 0);
                }
            }
#pragma unroll
            for (int nt = 0; nt < 4; ++nt) {
                const f32x4 w0 = *(const LAS f32x4*)(PRM + 6 * 512 + h * 64 + 32 * (nt >> 1) + 8 * fq + 4 * (nt & 1));
#pragma unroll
                for (int k = 0; k < 4; ++k) ev[nt][k] = 0.6065306597126334f * __builtin_amdgcn_rcpf(1.0f + __expf(-(w0[k] + acc[nt][k])));
            }
        }
        {
            f32x4 acc[4];
#pragma unroll
            for (int nt = 0; nt < 4; ++nt) acc[nt] = (f32x4){0.f, 0.f, 0.f, 0.f};
#pragma unroll
            for (int ks = 0; ks < 2; ++ks) {
                const bf16x8 Yv = *(const LAS bf16x8*)(Ar + 64 + ks * 32);
#pragma unroll
                for (int nt = 0; nt < 4; ++nt) {
                    const bf16x8 X = *(const bf16x8*)(IUt + (size_t)(h * 64 + 32 * (nt >> 1) + 8 * (fr >> 2) + 4 * (nt & 1) + (fr & 3)) * 64 + ks * 32 + fq * 8);
                    acc[nt] = __builtin_amdgcn_mfma_f32_16x16x32_bf16(X, Yv, acc[nt], 0, 0, 0);
                }
            }
#pragma unroll
            for (int nt = 0; nt < 4; ++nt) {
                const f32x4 a0 = *(const LAS f32x4*)(PRM + 7 * 512 + h * 64 + 32 * (nt >> 1) + 8 * fq + 4 * (nt & 1));
#pragma unroll
                for (int k = 0; k < 4; ++k) av[nt][k] = sigmoidf_(a0[k] + acc[nt][k]);
            }
        }
        {
            f32x4 acc[4];
#pragma unroll
            for (int nt = 0; nt < 4; ++nt) acc[nt] = (f32x4){0.f, 0.f, 0.f, 0.f};
#pragma unroll
            for (int ks = 0; ks < 4; ++ks) {
                const bf16x8 Yv = *(const LAS bf16x8*)(Ar + 128 + ks * 32);
#pragma unroll
                for (int nt = 0; nt < 4; ++nt) {
                    const bf16x8 X = *(const bf16x8*)(GUt + (size_t)(h * 64 + 32 * (nt >> 1) + 8 * (fr >> 2) + 4 * (nt & 1) + (fr & 3)) * 128 + ks * 32 + fq * 8);
                    acc[nt] = __builtin_amdgcn_mfma_f32_16x16x32_bf16(X, Yv, acc[nt], 0, 0, 0);
                }
            }
#pragma unroll
            for (int a2 = 0; a2 < 2; ++a2) { const u32x2 p0 = pack4(acc[2 * a2]), p1 = pack4(acc[2 * a2 + 1]);
                st16_wt(ymix + tok * DM + 512 + h * 64 + 32 * a2 + 8 * fq, (u32x4){p0.x, p0.y, p1.x, p1.y}); }
        }
        f32x4 rv[4], kv[4], kk[4]; float ssq = 0.f;
        bf16_t* sp = sc + ((size_t)(b * 8 + h) * SEQ + t) * 384;
#define PK8(lo4, hi4) ({ const u32x2 p0_ = pack4(lo4), p1_ = pack4(hi4); (u32x4){p0_.x, p0_.y, p1_.x, p1_.y}; })
#pragma unroll
        for (int a2 = 0; a2 < 2; ++a2) {
            const int cl = 32 * a2 + 8 * fq, c = h * 64 + cl;
            const bf16_t* zp = z + tok * PE + 1024 + c;
            const u32x4 zr = *(const u32x4*)zp, zk = *(const u32x4*)(zp + 512), zv = *(const u32x4*)(zp + 1024);
            const bf16_t* zq = hp ? zp - PE : zp; const float hm = hp ? 1.0f : 0.0f;
            const u32x4 qr = *(const u32x4*)zq, qk = *(const u32x4*)(zq + 512), qv = *(const u32x4*)(zq + 1024);
            f32x4 vv[2];
#pragma unroll
            for (int hh = 0; hh < 2; ++hh) {
                const int nt = 2 * a2 + hh, c4 = c + 4 * hh;
                const f32x4 cr = unpack4(hh ? (u32x2){zr.z, zr.w} : (u32x2){zr.x, zr.y}), ck = unpack4(hh ? (u32x2){zk.z, zk.w} : (u32x2){zk.x, zk.y}), cvv = unpack4(hh ? (u32x2){zv.z, zv.w} : (u32x2){zv.x, zv.y});
                const f32x4 pr = unpack4(hh ? (u32x2){qr.z, qr.w} : (u32x2){qr.x, qr.y}) * hm, pk = unpack4(hh ? (u32x2){qk.z, qk.w} : (u32x2){qk.x, qk.y}) * hm, pvv = unpack4(hh ? (u32x2){qv.z, qv.w} : (u32x2){qv.x, qv.y}) * hm;
                const f32x4 mr = *(const LAS f32x4*)(PRM + c4), mk = *(const LAS f32x4*)(PRM + 512 + c4), mv = *(const LAS f32x4*)(PRM + 1024 + c4);
                rv[nt] = cr + mr * (pr - cr); kv[nt] = ck + mk * (pk - ck); vv[hh] = cvv + mv * (pvv - cvv);
                kk[nt] = kv[nt] * *(const LAS f32x4*)(PRM + 3 * 512 + c4);
                ssq += (kk[nt][0] * kk[nt][0] + kk[nt][1] * kk[nt][1]) + (kk[nt][2] * kk[nt][2] + kk[nt][3] * kk[nt][3]);
            }
            st16_wt(sp + 5 * 64 + cl, PK8(vv[0], vv[1]));
            st16_wt(sp + 4 * 64 + cl, PK8(rv[2 * a2], rv[2 * a2 + 1]));
            st16_wt(sp + 0 * 64 + cl, PK8(ev[2 * a2], ev[2 * a2 + 1]));
        }
        ssq += __shfl_xor(ssq, 16); ssq = xor32_add(ssq);
        const float inv = 1.0f / fmaxf(sqrtf(ssq), 1e-12f);
        float cbp = 0.f;
#pragma unroll
        for (int a2 = 0; a2 < 2; ++a2) {
            const int cl = 32 * a2 + 8 * fq, c = h * 64 + cl;
            f32x4 kp[2], nk[2], nb[2];
#pragma unroll
            for (int hh = 0; hh < 2; ++hh) {
                const int nt = 2 * a2 + hh, c4 = c + 4 * hh;
                const f32x4 a = av[nt], kkn = kk[nt] * inv;
                const f32x4 ka = *(const LAS f32x4*)(PRM + 4 * 512 + c4), rk = *(const LAS f32x4*)(PRM + 5 * 512 + c4);
                kp[hh] = kv[nt] * (1.0f + (a - 1.0f) * ka);
                const f32x4 pr = rv[nt] * kp[hh] * rk; cbp += (pr[0] + pr[1]) + (pr[2] + pr[3]);
                nk[hh] = -kkn; nb[hh] = kkn * a;
            }
            st16_wt(sp + 1 * 64 + cl, PK8(kp[0], kp[1]));
            st16_wt(sp + 2 * 64 + cl, PK8(nk[0], nk[1]));
            st16_wt(sp + 3 * 64 + cl, PK8(nb[0], nb[1]));
        }
#undef PK8
        cbp += __shfl_xor(cbp, 16); cbp = xor32_add(cbp);
        if (fq == 0) cb[tok * 8 + h] = cbp;
    }
    __syncthreads();
}

__device__ __forceinline__ void red16x2(float& a, float& b) {
    a += dpp_f<0x140>(a); b += dpp_f<0x140>(b);
    a += dpp_f<0x141>(a); b += dpp_f<0x141>(b);
    a += dpp_f<0xB1>(a);  b += dpp_f<0xB1>(b);
    a += dpp_f<0x4E>(a);  b += dpp_f<0x4E>(b);
}
__device__ __forceinline__ void red16x4(float& a, float& b, float& c, float& d) {
    a += dpp_f<0x140>(a); b += dpp_f<0x140>(b); c += dpp_f<0x140>(c); d += dpp_f<0x140>(d);
    a += dpp_f<0x141>(a); b += dpp_f<0x141>(b); c += dpp_f<0x141>(c); d += dpp_f<0x141>(d);
    a += dpp_f<0xB1>(a);  b += dpp_f<0xB1>(b);  c += dpp_f<0xB1>(c);  d += dpp_f<0xB1>(d);
    a += dpp_f<0x4E>(a);  b += dpp_f<0x4E>(b);  c += dpp_f<0x4E>(c);  d += dpp_f<0x4E>(d);
}
__device__ __forceinline__ void scan_item(const Frame& F, int item) {
    const int bh = item >> 2, rq = item & 3, b = bh >> 3, h = bh & 7, lane = F.lane, wave = F.wave;
    const bf16_t* sc = (const bf16_t*)(F.ws + WS_SC) + (size_t)bh * SEQ * 384;
    float* Y = (float*)(F.ws + WS_Y);
    LAS float* buf = (LAS float*)F.lds;
    constexpr int CH = 32, NP = CH / 2, PSTR = 712, CHF = NP * PSTR;
    const int ltid = F.tid - 256;
    const int lpair = ltid >> 4, lsub = ltid & 15;
    u32x2 raw0A[6], raw1A[6], raw0B[6], raw1B[6];
#define SCAN_GL(S, c) do { const bf16_t* src_ = sc + ((size_t)(c) * CH + 2 * lpair) * 384 + lsub * 4; \
        _Pragma("unroll") for (int p = 0; p < 6; ++p) { raw0##S[p] = *(const u32x2*)(src_ + p * 64); raw1##S[p] = *(const u32x2*)(src_ + 384 + p * 64); } } while (0)
#define SCAN_LW(S, bi) do { LAS float* pp_ = buf + (bi) * CHF + lpair * PSTR; LAS float* dst_ = pp_ + lsub * 4; \
        f32x4 e0_ = unpack4(raw0##S[0]), k0_ = unpack4(raw0##S[1]), a0_ = unpack4(raw0##S[2]), b0_ = unpack4(raw0##S[3]), r0_ = unpack4(raw0##S[4]), v0_ = unpack4(raw0##S[5]); \
        f32x4 e1_ = unpack4(raw1##S[0]), k1_ = unpack4(raw1##S[1]), a1_ = unpack4(raw1##S[2]), b1_ = unpack4(raw1##S[3]), r1_ = unpack4(raw1##S[4]), v1_ = unpack4(raw1##S[5]); \
        f32x4 w0_, w1_; _Pragma("unroll") for (int k = 0; k < 4; ++k) { w0_[k] = __expf(-e0_[k]); w1_[k] = __expf(-e1_[k]); } \
        const f32x4 ba_ = b0_ * a1_, ka_ = k0_ * a1_, br_ = b0_ * r0_, kr_ = k0_ * r0_; \
        float s0_ = (ba_[0] + ba_[1]) + (ba_[2] + ba_[3]), s1_ = (ka_[0] + ka_[1]) + (ka_[2] + ka_[3]), s2_ = (br_[0] + br_[1]) + (br_[2] + br_[3]), s3_ = (kr_[0] + kr_[1]) + (kr_[2] + kr_[3]); \
        red16x4(s0_, s1_, s2_, s3_); \
        *(LAS f32x4*)(dst_) = a0_; *(LAS f32x4*)(dst_ + 64) = w0_ * a1_; *(LAS f32x4*)(dst_ + 128) = w0_ * r0_; *(LAS f32x4*)(dst_ + 192) = r1_; \
        *(LAS f32x4*)(dst_ + 256) = w0_ * w1_; *(LAS f32x4*)(dst_ + 320) = b0_ * w1_; *(LAS f32x4*)(dst_ + 384) = k0_ * w1_; *(LAS f32x4*)(dst_ + 448) = b1_; \
        *(LAS f32x4*)(dst_ + 512) = k1_; *(LAS f32x4*)(dst_ + 576) = v0_; *(LAS f32x4*)(dst_ + 640) = v1_; \
        if (lsub == 0) *(LAS f32x4*)(pp_ + 704) = (f32x4){s0_, s1_, s2_, s3_}; } while (0)
    if (wave >= 4) { SCAN_GL(A, 0); SCAN_GL(B, 1); SCAN_LW(A, 0); SCAN_GL(A, 2); }
    __syncthreads();
    const int l16 = lane & 15, rl = wave * 4 + (lane >> 4), row = rq * 16 + rl, c4 = l16 * 4;
    f32x2 s01 = (f32x2){0.f, 0.f}, s23 = s01;
    f32x4 rprev = (f32x4){0.f, 0.f, 0.f, 0.f};
    float ykeep = 0.f;
    LAS float* ybuf = buf + 2 * CHF;
    LAS float* ywr = ybuf + l16 * 16 + rl;
    float* yflush = Y + ((size_t)b * SEQ + (ltid >> 2)) * 512 + h * 64 + rq * 16 + (ltid & 3) * 4;
#define SCAN_FLUSH(f) do { if (ltid < 128) { const f32x4 yv_ = *(const LAS f32x4*)(ybuf + ((f) & 3) * 512 + (ltid >> 2) * 16 + (ltid & 3) * 4); st16_wt(yflush + (size_t)(f) * 32 * 512, __builtin_bit_cast(u32x4, yv_)); } } while (0)
#define DOT4(x) ({ f32x2 p_ = s01 * (f32x2){(x)[0], (x)[1]}; p_ = __builtin_elementwise_fma(s23, (f32x2){(x)[2], (x)[3]}, p_); p_[0] + p_[1]; })
#define LDP(P, q) const f32x4 P##a = *(const LAS f32x4*)((q) + c4), P##wa = *(const LAS f32x4*)((q) + 64 + c4), P##wr = *(const LAS f32x4*)((q) + 128 + c4), P##r1 = *(const LAS f32x4*)((q) + 192 + c4), \
        P##ww = *(const LAS f32x4*)((q) + 256 + c4), P##bw = *(const LAS f32x4*)((q) + 320 + c4), P##kw = *(const LAS f32x4*)((q) + 384 + c4), P##b1 = *(const LAS f32x4*)((q) + 448 + c4), \
        P##k1 = *(const LAS f32x4*)((q) + 512 + c4), P##sc = *(const LAS f32x4*)((q) + 704); const float P##v0 = (q)[576 + row], P##v1 = (q)[640 + row]
    for (int c = 0; c < SEQ / CH; ++c) {
        if (wave >= 4) {
            if (c + 1 < SEQ / CH) {
                if ((c + 1) & 1) { SCAN_LW(B, 1); if (c + 3 < SEQ / CH) SCAN_GL(B, c + 3); }
                else { SCAN_LW(A, 0); if (c + 3 < SEQ / CH) SCAN_GL(A, c + 3); }
            }
            if (c >= 2) SCAN_FLUSH(c - 2);
        }
        else {
            const LAS float* bp = buf + (c & 1) * CHF;
            f32x4 Ca, Cwa, Cwr, Cr1, Cww, Cbw, Ckw, Cb1, Ck1, Csc; float Cv0, Cv1;
            { LDP(T, bp); Ca = Ta; Cwa = Twa; Cwr = Twr; Cr1 = Tr1; Cww = Tww; Cbw = Tbw; Ckw = Tkw; Cb1 = Tb1; Ck1 = Tk1; Csc = Tsc; Cv0 = Tv0; Cv1 = Tv1; }
#pragma unroll 1
            for (int hb = 0; hb < 2; ++hb) {
#pragma unroll
                for (int i = 0; i < 8; ++i) {
                    const int p = hb * 8 + i;
                    const LAS float* qn = bp + ((p + 1 < NP) ? (p + 1) : (NP - 1)) * PSTR;
                    LDP(N, qn);
                    float d0 = DOT4(rprev), d1 = DOT4(Ca), d2 = DOT4(Cwa), d3 = DOT4(Cwr);
                    red16x4(d0, d1, d2, d3);
                    ykeep = (l16 == ((2 * i + 15) & 15)) ? d0 : ykeep;
                    if (i == 0) { const int blk = 2 * c + hb - 1; if (blk >= 0) ywr[((blk >> 1) & 3) * 512 + (blk & 1) * 256] = ykeep; }
                    const float sa0 = d1;
                    const float yt = __builtin_fmaf(sa0, Csc[2], __builtin_fmaf(Cv0, Csc[3], d3));
                    ykeep = (l16 == (2 * i)) ? yt : ykeep;
                    const float sa1 = __builtin_fmaf(sa0, Csc[0], __builtin_fmaf(Cv0, Csc[1], d2));
                    const f32x2 a0v = (f32x2){sa0, sa0}, a1v = (f32x2){sa1, sa1}, v0v = (f32x2){Cv0, Cv0}, v1v = (f32x2){Cv1, Cv1};
                    f32x2 t01 = (f32x2){Ckw[0], Ckw[1]} * v0v, t23 = (f32x2){Ckw[2], Ckw[3]} * v0v;
                    t01 = __builtin_elementwise_fma((f32x2){Cbw[0], Cbw[1]}, a0v, t01); t23 = __builtin_elementwise_fma((f32x2){Cbw[2], Cbw[3]}, a0v, t23);
                    t01 = __builtin_elementwise_fma((f32x2){Ck1[0], Ck1[1]}, v1v, t01); t23 = __builtin_elementwise_fma((f32x2){Ck1[2], Ck1[3]}, v1v, t23);
                    t01 = __builtin_elementwise_fma((f32x2){Cb1[0], Cb1[1]}, a1v, t01); t23 = __builtin_elementwise_fma((f32x2){Cb1[2], Cb1[3]}, a1v, t23);
                    s01 = __builtin_elementwise_fma(s01, (f32x2){Cww[0], Cww[1]}, t01); s23 = __builtin_elementwise_fma(s23, (f32x2){Cww[2], Cww[3]}, t23);
                    rprev = Cr1;
                    Ca = Na; Cwa = Nwa; Cwr = Nwr; Cr1 = Nr1; Cww = Nww; Cbw = Nbw; Ckw = Nkw; Cb1 = Nb1; Ck1 = Nk1; Csc = Nsc; Cv0 = Nv0; Cv1 = Nv1;
                }
            }
        }
        __syncthreads();
    }
    if (wave < 4) {
        float d0 = DOT4(rprev), z1 = 0.f, z2 = 0.f, z3 = 0.f; red16x4(d0, z1, z2, z3);
        ykeep = (l16 == 15) ? d0 : ykeep;
        ywr[3 * 512 + 256] = ykeep;
    }
    __syncthreads();
    if (wave >= 4) { SCAN_FLUSH(SEQ / CH - 2); SCAN_FLUSH(SEQ / CH - 1); }
    __syncthreads();
#undef SCAN_FLUSH
#undef SCAN_GL
#undef SCAN_LW
#undef DOT4
#undef LDP
}
__device__ __forceinline__ void post_rows(const Frame& F, int e) {
    const float* Y = (const float*)(F.ws + WS_Y); const bf16_t* sc = (const bf16_t*)(F.ws + WS_SC); const float* cb = (const float*)(F.ws + WS_CB);
    bf16_t* ymix = (bf16_t*)(F.ws + WS_YMIX);
    const float* lg = inp<23>() + e * 512; const float* lb = inp<24>() + e * 512;
    const int lane = F.lane, hh = lane >> 3;
    for (int tl = (F.bid >> 3) * 8 + F.wave; tl < SEQ; tl += F.G) {
        const int tok = (F.bid & 7) * SEQ + tl;
        const int b = tok / SEQ, t = tok % SEQ;
        const f32x4 y0 = *(const f32x4*)(Y + (size_t)tok * 512 + lane * 8), y1 = *(const f32x4*)(Y + (size_t)tok * 512 + lane * 8 + 4);
        float yv[8] = {y0[0], y0[1], y0[2], y0[3], y1[0], y1[1], y1[2], y1[3]};
        float s = 0.f;
#pragma unroll
        for (int k = 0; k < 8; ++k) s += yv[k];
        s += __shfl_xor(s, 1); s += __shfl_xor(s, 2); s += __shfl_xor(s, 4);
        const float mean = s * (1.0f / 64.0f); float qv = 0.f;
#pragma unroll
        for (int k = 0; k < 8; ++k) { yv[k] -= mean; qv += yv[k] * yv[k]; }
        qv += __shfl_xor(qv, 1); qv += __shfl_xor(qv, 2); qv += __shfl_xor(qv, 4);
        const float rstd = rsqrtf(qv * (1.0f / 64.0f) + 64e-5f);
        const u32x4 vr = *(const u32x4*)(sc + ((size_t)(b * 8 + hh) * SEQ + t) * 384 + 5 * 64 + (lane & 7) * 8);
        bf16_t* gp = ymix + (size_t)tok * DM + 512 + lane * 8;
        const u32x4 gr = *(const u32x4*)gp;
        const float cbv = cb[(size_t)tok * 8 + hh];
        float vv[8] = {bflo(vr.x), bfhi(vr.x), bflo(vr.y), bfhi(vr.y), bflo(vr.z), bfhi(vr.z), bflo(vr.w), bfhi(vr.w)};
        float gg[8] = {bflo(gr.x), bfhi(gr.x), bflo(gr.y), bfhi(gr.y), bflo(gr.z), bfhi(gr.z), bflo(gr.w), bfhi(gr.w)};
        float o[8];
#pragma unroll
        for (int k = 0; k < 8; ++k) o[k] = (yv[k] * rstd * lg[lane * 8 + k] + lb[lane * 8 + k] + cbv * vv[k]) * gg[k];
        u32x4 ow; ow.x = pk2(o[0], o[1]); ow.y = pk2(o[2], o[3]); ow.z = pk2(o[4], o[5]); ow.w = pk2(o[6], o[7]);
        st16_wt(gp, ow);
    }
}

__device__ __forceinline__ void conv_item(const Frame& F, int item, int o) {
    const int b = item >> 6, tt = item & 63, t0 = tt * 32, c = F.tid, lane = F.lane, wave = F.wave;
    const bf16_t* z = (const bf16_t*)(F.ws + WS_ACT);
    bf16_t* ymix = (bf16_t*)(F.ws + WS_YMIX);
    const float* cw = inp<31>() + (size_t)o * 31 * 512; const float* cbias = inp<32>() + o * 512;
    const float* lg = inp<33>() + o * 512; const float* lb = inp<34>() + o * 512;
    LAS float* co = (LAS float*)F.lds;
    const size_t tokb = (size_t)b * SEQ;
    float hv[62];
#pragma unroll
    for (int i = 0; i < 62; ++i) {
        const int t = t0 - 30 + i; float hval = 0.f;
        if (t >= 0) { const bf16_t* zp = z + (tokb + t) * POP + 416 + c; const float za = bf1(zp[0]), zg = bf1(zp[512]); hval = za * sigmoidf_(zg); }
        hv[i] = hval;
    }
    float wv[31];
#pragma unroll
    for (int k = 0; k < 31; ++k) wv[k] = cw[k * 512 + c];
    const float bias = cbias[c];
#pragma unroll
    for (int i = 0; i < 32; ++i) {
        float a = bias;
#pragma unroll
        for (int k = 0; k < 31; ++k) a += wv[k] * hv[i + k];
        co[i * 512 + c] = a;
    }
    {
        const int token = F.tid >> 4, i = F.tid & 15, t = t0 + token;
        const bf16_t* zp = z + (tokb + t) * POP + 384;
        const float x1 = bf1(zp[i]), x2 = bf1(zp[16 + i]);
        const float cs = ((const float*)(F.ws + WS_COS))[t * 16 + i], sn = ((const float*)(F.ws + WS_SIN))[t * 16 + i];
        bf16_t* kr = (bf16_t*)(F.ws + WS_SC + SC_KR) + (tokb + t) * 32;
        const int kp_ = 8 * (i >> 2) + (i & 3);
        kr[kp_] = (bf16_t)(pk2(x1 * cs - x2 * sn, 0.f) & 0xffffu); kr[kp_ + 4] = (bf16_t)(pk2(x1 * sn + x2 * cs, 0.f) & 0xffffu);
    }
    __syncthreads();
#pragma unroll
    for (int j = 0; j < 4; ++j) {
        const int ti = wave * 4 + j;
        const f32x4 v0 = *(const LAS f32x4*)(co + ti * 512 + lane * 8), v1 = *(const LAS f32x4*)(co + ti * 512 + lane * 8 + 4);
        float v[8] = {v0[0], v0[1], v0[2], v0[3], v1[0], v1[1], v1[2], v1[3]};
        float s = 0.f;
#pragma unroll
        for (int k = 0; k < 8; ++k) s += v[k];
        const float mean = wave_sum(s) * (1.0f / 512.0f); float qv = 0.f;
#pragma unroll
        for (int k = 0; k < 8; ++k) { v[k] -= mean; qv += v[k] * v[k]; }
        const float rstd = rsqrtf(wave_sum(qv) * (1.0f / 512.0f) + 1e-5f);
        float ov[8];
#pragma unroll
        for (int k = 0; k < 8; ++k) { const float y = v[k] * rstd * lg[lane * 8 + k] + lb[lane * 8 + k]; ov[k] = y * sigmoidf_(y); }
        u32x4 ow; ow.x = pk2(ov[0], ov[1]); ow.y = pk2(ov[2], ov[3]); ow.z = pk2(ov[4], ov[5]); ow.w = pk2(ov[6], ov[7]);
        st16_wt(ymix + (tokb + t0 + ti) * DM + 512 + lane * 8, ow);
    }
    __syncthreads();
}

constexpr int AT_KS = 104, AT_VS = 80, AT_KB = 64 * AT_KS * 2, AT_VB = 64 * AT_VS * 2, AT_BUF = AT_KB + AT_VB;
typedef short v4i16_t __attribute__((ext_vector_type(4)));
__device__ __forceinline__ void attn_unit(const Frame& F, int b, int h, int qb) {
    const int lane = F.lane, wave = F.wave, tid = F.tid, fr = lane & 15, fq = lane >> 4;
    const bf16_t* Q = (const bf16_t*)(F.ws + WS_SC + SC_Q); const bf16_t* KV = (const bf16_t*)(F.ws + WS_SC + SC_KV); const bf16_t* KR = (const bf16_t*)(F.ws + WS_SC + SC_KR);
    bf16_t* ymix = (bf16_t*)(F.ws + WS_YMIX);
    const size_t tokb = (size_t)b * SEQ;
    const int q0 = qb * 256 + wave * 32;
    const int ntb = 4 * qb + 4, ntw = 4 * qb + 1 + (wave >> 1);
    bf16x8 qf[2][3];
#pragma unroll
    for (int mt = 0; mt < 2; ++mt)
#pragma unroll
        for (int ks = 0; ks < 3; ++ks) qf[mt][ks] = *(const bf16x8*)(Q + (tokb + q0 + mt * 16 + fr) * 768 + h * 96 + ks * 32 + fq * 8);
    const int key0 = tid / 12, ch0 = tid % 12, key1 = (tid + 512) / 12, ch1 = (tid + 512) % 12;
    const bool has1 = tid < 256;
    const int vkey = tid >> 3, vch = tid & 7;
    const bf16_t* ksrc0 = (ch0 < 8) ? KV + (tokb + key0) * 1024 + h * 128 + ch0 * 8 : KR + (tokb + key0) * 32 + (ch0 - 8) * 8;
    const bf16_t* ksrc1 = (ch1 < 8) ? KV + (tokb + key1) * 1024 + h * 128 + ch1 * 8 : KR + (tokb + key1) * 32 + (ch1 - 8) * 8;
    const int kstr0 = (ch0 < 8) ? 64 * 1024 : 64 * 32, kstr1 = (ch1 < 8) ? 64 * 1024 : 64 * 32;
    const bf16_t* vsrc = KV + (tokb + vkey) * 1024 + h * 128 + 64 + vch * 8;
    const unsigned kdst0 = key0 * (AT_KS * 2) + ch0 * 16, kdst1 = key1 * (AT_KS * 2) + ch1 * 16;
    u32x4 rk0[2], rk1[2], rv[2];
#pragma unroll
    for (int k = 0; k < 2; ++k) { rk0[k] = (u32x4){0u, 0u, 0u, 0u}; rk1[k] = rk0[k]; rv[k] = rk0[k]; }
#define AT_GLOAD(j, st) do { rk0[st] = *(const u32x4*)(ksrc0 + (size_t)(j) * kstr0); if (has1) rk1[st] = *(const u32x4*)(ksrc1 + (size_t)(j) * kstr1); rv[st] = *(const u32x4*)(vsrc + (size_t)(j) * 64 * 1024); } while (0)
#define AT_LSTORE(bi, st) do { LAS unsigned char* kb_ = F.lds + (bi) * AT_BUF; LAS bf16_t* vb_ = (LAS bf16_t*)(kb_ + AT_KB); \
        *(LAS u32x4*)(kb_ + kdst0) = rk0[st]; if (has1) *(LAS u32x4*)(kb_ + kdst1) = rk1[st]; \
        *(LAS u32x4*)(vb_ + vkey * AT_VS + vch * 8) = rv[st]; } while (0)
    f32x4 o[2][4];
#pragma unroll
    for (int mt = 0; mt < 2; ++mt)
#pragma unroll
        for (int dt = 0; dt < 4; ++dt) o[mt][dt] = (f32x4){0.f, 0.f, 0.f, 0.f};
    float mrun[2] = {-INFINITY, -INFINITY}, lsum[2] = {0.f, 0.f};
#pragma unroll
    for (int k = 0; k < 2; ++k) AT_GLOAD(k, k);
    for (int j0 = 0; j0 < ntb; j0 += 2) {
      AT_LSTORE(j0 & 3, 0); AT_LSTORE((j0 & 3) + 1, 1);
      __syncthreads();
      if (j0 + 2 < ntb) { AT_GLOAD(j0 + 2, 0); AT_GLOAD(j0 + 3, 1); }
#pragma unroll
      for (int kk = 0; kk < 2; ++kk) {
        const int j = j0 + kk;
        if (j < ntw) {
            const LAS unsigned char* kb = F.lds + (j & 3) * AT_BUF; const LAS bf16_t* vb = (const LAS bf16_t*)(kb + AT_KB);
            f32x4 st[2][4];
#pragma unroll
            for (int kt = 0; kt < 4; ++kt) {
                st[0][kt] = (f32x4){0.f, 0.f, 0.f, 0.f}; st[1][kt] = st[0][kt];
#pragma unroll
                for (int ks = 0; ks < 3; ++ks) {
                    const bf16x8 X = *(const LAS bf16x8*)(kb + (kt * 16 + fr) * (AT_KS * 2) + (ks * 32 + fq * 8) * 2);
                    st[0][kt] = __builtin_amdgcn_mfma_f32_16x16x32_bf16(X, qf[0][ks], st[0][kt], 0, 0, 0);
                    st[1][kt] = __builtin_amdgcn_mfma_f32_16x16x32_bf16(X, qf[1][ks], st[1][kt], 0, 0, 0);
                }
            }
            bf16x8 Yp[2][2];
#pragma unroll
            for (int mt = 0; mt < 2; ++mt) {
                float mx = fmaxf(fmaxf(st[mt][0][0], st[mt][0][1]), fmaxf(st[mt][0][2], st[mt][0][3]));
#pragma unroll
                for (int kt = 1; kt < 4; ++kt) mx = fmaxf(mx, fmaxf(fmaxf(st[mt][kt][0], st[mt][kt][1]), fmaxf(st[mt][kt][2], st[mt][kt][3])));
                mx = fmaxf(mx, __shfl_xor(mx, 16)); mx = xor32_max(mx);
                const float mnew = fmaxf(mrun[mt], mx), alpha = __builtin_amdgcn_exp2f(mrun[mt] - mnew);
                mrun[mt] = mnew;
                float ps = 0.f;
#pragma unroll
                for (int kt = 0; kt < 4; ++kt)
#pragma unroll
                    for (int k = 0; k < 4; ++k) { st[mt][kt][k] = __builtin_amdgcn_exp2f(st[mt][kt][k] - mnew); ps += st[mt][kt][k]; }
                lsum[mt] = lsum[mt] * alpha + ps;
#pragma unroll
                for (int dt = 0; dt < 4; ++dt) o[mt][dt] = o[mt][dt] * alpha;
#pragma unroll
                for (int g2 = 0; g2 < 2; ++g2) {
                    u32x4 pw; pw.x = pk2(st[mt][2 * g2][0], st[mt][2 * g2][1]); pw.y = pk2(st[mt][2 * g2][2], st[mt][2 * g2][3]); pw.z = pk2(st[mt][2 * g2 + 1][0], st[mt][2 * g2 + 1][1]); pw.w = pk2(st[mt][2 * g2 + 1][2], st[mt][2 * g2 + 1][3]);
                    Yp[mt][g2] = __builtin_bit_cast(bf16x8, pw);
                }
            }
#pragma unroll
            for (int g2 = 0; g2 < 2; ++g2)
#pragma unroll
                for (int dt = 0; dt < 4; ++dt) {
                    const LAS bf16_t* vp = vb + (g2 * 32 + fq * 4 + (fr >> 2)) * AT_VS + 32 * (dt >> 1) + 8 * (fr & 3) + 4 * (dt & 1);
                    const v4i16_t lo = __builtin_amdgcn_ds_read_tr16_b64_v4i16((LAS v4i16_t*)vp), hi = __builtin_amdgcn_ds_read_tr16_b64_v4i16((LAS v4i16_t*)(vp + 16 * AT_VS));
                    const bf16x8 Xv = (bf16x8){lo[0], lo[1], lo[2], lo[3], hi[0], hi[1], hi[2], hi[3]};
                    o[0][dt] = __builtin_amdgcn_mfma_f32_16x16x32_bf16(Xv, Yp[0][g2], o[0][dt], 0, 0, 0);
                    o[1][dt] = __builtin_amdgcn_mfma_f32_16x16x32_bf16(Xv, Yp[1][g2], o[1][dt], 0, 0, 0);
                }
        }
      }
    }
#undef AT_GLOAD
#undef AT_LSTORE
#pragma unroll
    for (int mt = 0; mt < 2; ++mt) {
        float ls = lsum[mt]; ls += __shfl_xor(ls, 16); ls = xor32_add(ls);
        const float il = 1.0f / ls;
#pragma unroll
        for (int a2 = 0; a2 < 2; ++a2) { const u32x2 p0 = pack4(o[mt][2 * a2] * il), p1 = pack4(o[mt][2 * a2 + 1] * il);
            st16_wt(ymix + (tokb + q0 + mt * 16 + fr) * DM + h * 64 + 32 * a2 + 8 * fq, (u32x4){p0.x, p0.y, p1.x, p1.y}); }
    }
    __syncthreads();
}

constexpr int NPHASE = 1 + 9 * DEPTH + 1;
__global__ void __launch_bounds__(512, 2) mk_fwd(Args args) {
    extern __shared__ __attribute__((aligned(16))) unsigned char lds_raw[];
    Frame F;
    F.lds = (LAS unsigned char*)lds_raw;
    F.tid = threadIdx.x; F.lane = F.tid & 63; F.wave = __builtin_amdgcn_readfirstlane(F.tid >> 6);
    F.G = gridDim.x; F.bid = blockIdx.x; F.out = args.out; F.ws = args.ws;
    const int lo = args.ph_lo, hi = args.ph_hi;
    cg::grid_group grid = cg::this_grid();
    volatile LAS unsigned* bst = (volatile LAS unsigned*)(F.lds + 135168);
    if (threadIdx.x < 8) bst[threadIdx.x] = 0u;
    __syncthreads();
    XcdBarrier xbar = xcd_barrier_post((unsigned*)args.ws, bst);
    int vbid = blockIdx.x; bool regular = false;
#define IN(k) (lo <= (k) && (k) < hi)
#define ENTER() do { int t_ = threadIdx.x; int b_ = vbid; asm volatile("" : "+v"(t_), "+s"(b_)); F.tid = t_; F.lane = t_ & 63; F.wave = __builtin_amdgcn_readfirstlane(t_ >> 6); F.bid = b_; } while (0)
#define SEAM(k) do { if (IN(k) && IN((k) + 1)) { if (regular && (k) != 0 && (((k) - 1) % 9) != 8) xcd_local_barrier(xbar); else xcd_barrier(xbar); } } while (0)

    if (lo > hi) grid.sync();
    if (IN(0)) { ENTER(); { convert_layer(F, 0, 0, 1, F.bid, F.G); x_prologue(F); } }
    SEAM(0);
    if (IN(0) && IN(1)) {
        const unsigned reg_ = bst[2], rank_ = bst[3];
        regular = __builtin_amdgcn_readfirstlane((int)reg_) != 0;
        if (regular) vbid = __builtin_amdgcn_readfirstlane((int)(rank_ * 8u + xbar.x));
    }
    for (int l = 0; l < DEPTH; ++l) {
        const int p0 = 1 + 9 * l; const bool odd = l & 1; const int hl = l >> 1;
        size_t z0 = 0; asm volatile("" : "+s"(z0));
        unsigned char* ws = args.ws + z0;
        F.ws = ws;
        float* ssq = (float*)(ws + WS_SSQ);
        bf16_t* xb = (bf16_t*)(ws + WS_XB); bf16_t* ymix = (bf16_t*)(ws + WS_YMIX); bf16_t* act = (bf16_t*)(ws + WS_ACT);
        const unsigned char* wb = ws + WS_WBUF0 + (size_t)(l & 1) * WBUF_BYTES;
        if (IN(p0 + 0)) {
            ENTER();
            pg8::Gemm g{xb, (const bf16_t*)(wb + WB_W1IN), T, 2 * FF, DM, DM, DM}; pg8::StaticOrder S; S.init(T, 2 * FF, F.G, F.bid);
            EpiSwiGLU E{act, ssq}; pg8::gemm_phase(F.lds, g, S, E);
            ENTER();
            if (l + 1 < DEPTH) {
                const int nfull = ((T / 256) * (2 * FF / 256)) % F.G;
                if (nfull == 0) { __syncthreads(); convert_layer(F, l + 1, 0, 2, F.bid, F.G); }
                else if (F.bid >= nfull) { __syncthreads(); convert_layer(F, l + 1, 0, 2, F.bid - nfull, F.G - nfull); }
            }
        }
        SEAM(p0 + 0);
        if (IN(p0 + 1)) {
            ENTER();
            pg8::Gemm g{act, (const bf16_t*)(wb + WB_W1OUT), T, DM, FF, FF, FF}; pg8::StaticOrder S; S.init(T, DM, F.G, F.bid);
            EpiResid E{xb, ssq, 0.5f}; pg8::gemm_phase(F.lds, g, S, E);
        }
        SEAM(p0 + 1);
        if (IN(p0 + 2)) {
            ENTER();
            if (odd) { pg8::Gemm g{xb, (const bf16_t*)(wb + WB_WMIN), T, POP, DM, DM, DM}; pg8::StaticOrder S; S.init(T, POP, F.G, F.bid);
                EpiZ<true> E{act, POP, ssq, (float*)(ws + WS_PQ), (float*)(ws + WS_PKV)}; pg8::gemm_phase(F.lds, g, S, E); }
            else { pg8::Gemm g{xb, (const bf16_t*)(wb + WB_WMIN), T, PE, DM, DM, DM}; pg8::StaticOrder S; S.init(T, PE, F.G, F.bid);
                EpiZ<false> E{act, PE, ssq, nullptr, nullptr}; pg8::gemm_phase(F.lds, g, S, E); }
        }
        SEAM(p0 + 2);
        if (IN(p0 + 3)) {
            ENTER();
            if (odd) {
                pg8::Gemm g{act, (const bf16_t*)(wb + WB_WX), T, 1792, 384, POP, 384}; pg8::StaticOrder S; S.init(T, 1792, F.G, F.bid);
                EpiUp E{(bf16_t*)(ws + WS_SC + SC_Q), (bf16_t*)(ws + WS_SC + SC_KV), (const float*)(ws + WS_PQ), (const float*)(ws + WS_PKV), (const float*)(ws + WS_COS), (const float*)(ws + WS_SIN)};
                pg8::gemm_phase(F.lds, g, S, E);
                __syncthreads();
                ENTER();
                for (int j = F.bid >> 3; j < 64; j += F.G >> 3) conv_item(F, (F.bid & 7) * 64 + j, hl);
            } else {
                for (int j = F.bid >> 3; j < 64; j += F.G >> 3) prep_item(F, (F.bid & 7) * 64 + j, hl, wb);
                for (int j = F.bid >> 3; j < 64; j += F.G >> 3) gsu_item(F, (F.bid & 7) * 64 + j, hl);
            }
        }
        SEAM(p0 + 3);
        if (IN(p0 + 4)) {
            ENTER();
            if (odd) {
                for (int j = F.bid >> 3; j < 32; j += F.G >> 3) {
                    const int bh = (F.bid & 7) * 8 + (j & 7), pr = j >> 3;
                    attn_unit(F, bh >> 3, bh & 7, pr);
                    attn_unit(F, bh >> 3, bh & 7, 7 - pr);
                }
            } else {
                for (int j = F.bid >> 3; j < 32; j += F.G >> 3) scan_item(F, (F.bid & 7) * 32 + j);
            }
        }
        SEAM(p0 + 4);
        if (IN(p0 + 5)) { ENTER(); if (!odd) post_rows(F, hl); }
        if (!odd) SEAM(p0 + 5);
        if (IN(p0 + 6)) {
            ENTER();
            pg8::Gemm g{ymix, (const bf16_t*)(wb + WB_WMOUT), T, DM, DM, DM, DM}; pg8::StaticOrder S; S.init(T, DM, F.G, F.bid);
            EpiResid E{xb, ssq, 1.0f}; pg8::gemm_phase(F.lds, g, S, E);
        }
        SEAM(p0 + 6);
        if (IN(p0 + 7)) {
            ENTER();
            pg8::Gemm g{xb, (const bf16_t*)(wb + WB_W2IN), T, 2 * FF, DM, DM, DM}; pg8::StaticOrder S; S.init(T, 2 * FF, F.G, F.bid);
            EpiSwiGLU E{act, ssq}; pg8::gemm_phase(F.lds, g, S, E);
            ENTER();
            if (l + 1 < DEPTH) {
                const int nfull = ((T / 256) * (2 * FF / 256)) % F.G;
                if (nfull == 0) { __syncthreads(); convert_layer(F, l + 1, 1, 2, F.bid, F.G); }
                else if (F.bid >= nfull) { __syncthreads(); convert_layer(F, l + 1, 1, 2, F.bid - nfull, F.G - nfull); }
            }
        }
        SEAM(p0 + 7);
        if (IN(p0 + 8)) {
            ENTER();
            pg8::Gemm g{act, (const bf16_t*)(wb + WB_W2OUT), T, DM, FF, FF, FF}; pg8::StaticOrder S; S.init(T, DM, F.G, F.bid);
            EpiResid E{xb, ssq, 0.5f}; pg8::gemm_phase(F.lds, g, S, E);
        }
        SEAM(p0 + 8);
    }
    if (IN(NPHASE - 1)) { ENTER(); final_norm(F); }
#undef IN
#undef SEAM
#undef ENTER
}

extern "C" void kernel_launch(void* const* d_in, const int* in_sizes, int n_in, void* d_out, int out_size, void* d_ws, size_t ws_size, hipStream_t stream) {
    static int grid = 0;
    if (grid == 0) {
        if (n_in != 36 || out_size != T * DM || ws_size < WS_END) { fprintf(stderr, "kernel_launch: unexpected shapes (n_in %d out %d ws %zu)\n", n_in, out_size, ws_size); grid = -1; return; }
        int dev = 0, cus = 0, per_cu = 0;
        (void)hipGetDevice(&dev); (void)hipDeviceGetAttribute(&cus, hipDeviceAttributeMultiprocessorCount, dev);
        (void)hipFuncSetAttribute((const void*)mk_fwd, hipFuncAttributeMaxDynamicSharedMemorySize, LDS_BYTES);
        (void)hipOccupancyMaxActiveBlocksPerMultiprocessor(&per_cu, (const void*)mk_fwd, 512, LDS_BYTES);
        if (per_cu < 1) per_cu = 1;
        grid = cus * per_cu; if (grid > 256) grid = 256; if (grid < 1) grid = 256;
        (void)hipGetLastError();
    }
    if (grid < 0) return;
    (void)hipMemsetAsync(d_ws, 0, 32768, stream);
    Args a{};
    for (int i = 0; i < 36; ++i) a.in[i] = (const float*)d_in[i];
    a.out = (float*)d_out; a.ws = (unsigned char*)d_ws;
#if MK_MULTI
    for (int p = 0; p < NPHASE; ++p) {
        if (p >= 1 && p < NPHASE - 1) { const int l = (p - 1) / 9, k = (p - 1) % 9; if ((l & 1) && k == 5) continue; }
        a.ph_lo = p; a.ph_hi = p + 1;
        hipLaunchKernelGGL(mk_fwd, dim3(grid), dim3(512), LDS_BYTES, stream, a);
    }
#else
    a.ph_lo = 0; a.ph_hi = NPHASE;
    void* kargs[] = {&a};
    hipError_t e = hipLaunchCooperativeKernel((const void*)mk_fwd, dim3(grid), dim3(512), kargs, LDS_BYTES, stream);
    if (e != hipSuccess) fprintf(stderr, "cooperative launch failed: %s (grid %d)\n", hipGetErrorString(e), grid);
#endif
}
```

```cpp
#include <hip/hip_runtime.h>
#include <hip/hip_cooperative_groups.h>
#include <cstdio>
#include <cstdint>
namespace cg = cooperative_groups;

#ifndef MK_MULTI
#define MK_MULTI 0
#endif

#define LAS __attribute__((address_space(3)))
typedef unsigned short bf16_t;
typedef short bf16x8 __attribute__((ext_vector_type(8)));
typedef float f32x4 __attribute__((ext_vector_type(4)));
typedef float f32x2 __attribute__((ext_vector_type(2)));
typedef unsigned u32x4 __attribute__((ext_vector_type(4)));
typedef unsigned u32x2 __attribute__((ext_vector_type(2)));
typedef __bf16 bf16x2_t __attribute__((ext_vector_type(2)));

constexpr int T = 16384, DM = 1024, FF = 2816, SEQ = 2048, NBATCH = 8, DEPTH = 4;
constexpr int PE = 2816, PO = 1440, POP = 1536;
constexpr int PB = 1792;
constexpr float RMS_EPS = 1e-6f;
constexpr float QSCALE = 0.10206207261596575f * 1.4426950408889634f;

constexpr size_t MiB = 1u << 20;
constexpr size_t WS_SSQ = 1 * MiB;
constexpr size_t WS_PQ = 2 * MiB;
constexpr size_t WS_PKV = 2 * MiB + 256 * 1024;
constexpr size_t WS_COS = 2 * MiB + 512 * 1024;
constexpr size_t WS_SIN = 2 * MiB + 640 * 1024;
constexpr size_t WS_CB = 3 * MiB;
constexpr size_t WS_WBUF0 = 4 * MiB, WBUF_BYTES = 42 * MiB;
constexpr size_t WS_XB = 88 * MiB;
constexpr size_t WS_YMIX = 120 * MiB;
constexpr size_t WS_ACT = 152 * MiB;
constexpr size_t WS_SC = 240 * MiB;
constexpr size_t WS_Y = 336 * MiB;
constexpr size_t WS_END = 368 * MiB;
constexpr size_t WB_W1IN = 0, WB_W1OUT = 11534336, WB_W2IN = 17301504, WB_W2OUT = 28835840, WB_WMIN = 34603008, WB_WMOUT = 40370176, WB_WX = 42467328;
constexpr size_t SC_Q = 0, SC_KV = 24 * MiB, SC_KR = 56 * MiB;

constexpr int LDS_BYTES = 147456;

__device__ __forceinline__ unsigned pk2(float lo, float hi) { f32x2 v = {lo, hi}; bf16x2_t b = __builtin_convertvector(v, bf16x2_t); return __builtin_bit_cast(unsigned, b); }
__device__ __forceinline__ float bflo(unsigned u) { return __uint_as_float(u << 16); }
__device__ __forceinline__ float bfhi(unsigned u) { return __uint_as_float(u & 0xffff0000u); }
__device__ __forceinline__ float bf1(bf16_t h) { return __uint_as_float((unsigned)h << 16); }
__device__ __forceinline__ f32x4 unpack4(u32x2 u) { return (f32x4){bflo(u.x), bfhi(u.x), bflo(u.y), bfhi(u.y)}; }
__device__ __forceinline__ u32x2 pack4(f32x4 v) { u32x2 r; r.x = pk2(v[0], v[1]); r.y = pk2(v[2], v[3]); return r; }
template <int CTRL> __device__ __forceinline__ float dpp_f(float x) { return __int_as_float(__builtin_amdgcn_update_dpp(0, __float_as_int(x), CTRL, 0xF, 0xF, true)); }
__device__ __forceinline__ float red16(float x) {
    x += dpp_f<0x140>(x);
    x += dpp_f<0x141>(x);
    x += dpp_f<0xB1>(x);
    x += dpp_f<0x4E>(x);
    return x;
}
__device__ __forceinline__ void st16_wt(void* p, u32x4 v) { asm volatile("global_store_dwordx4 %0, %1, off\n\ts_nop 1" :: "v"(p), "v"(v) : "memory"); }
__device__ __forceinline__ void st8_wt(void* p, u32x2 v) { asm volatile("global_store_dwordx2 %0, %1, off" :: "v"(p), "v"(v) : "memory"); }
__device__ __forceinline__ float xor32_add(float x) { auto rr = __builtin_amdgcn_permlane32_swap(__float_as_uint(x), __float_as_uint(x), false, false); return __uint_as_float(rr[0]) + __uint_as_float(rr[1]); }
__device__ __forceinline__ float xor32_max(float x) { auto rr = __builtin_amdgcn_permlane32_swap(__float_as_uint(x), __float_as_uint(x), false, false); return fmaxf(__uint_as_float(rr[0]), __uint_as_float(rr[1])); }
__device__ __forceinline__ float wave_sum(float v) {
    v = red16(v);
    v += __shfl_xor(v, 16); v = xor32_add(v);
    return v;
}
__device__ __forceinline__ float sigmoidf_(float x) { return __builtin_amdgcn_rcpf(1.0f + __expf(-x)); }
__device__ __forceinline__ float gelu_tanh(float x) { const float u = 1.5957691216057308f * (x + 0.044715f * x * x * x); return x * __builtin_amdgcn_rcpf(1.0f + __expf(-u)); }
__device__ __forceinline__ float tanh_(float x) { return 1.0f - 2.0f * __builtin_amdgcn_rcpf(1.0f + __expf(2.0f * x)); }

namespace pg8 {
constexpr int BM = 256, BK = 64, HALF = 128, HTB = HALF * BK * 2, STAGE_BYTES = 8 * HTB, NXCD = 8, WGM = 8;
__host__ __device__ __forceinline__ int lds_byte(int r, int c) { const int st = (r >> 4) * 2 + (c >> 5), rr = r & 15, cc = c & 31, ob = rr * 64 + cc * 2; return st * 1024 + (ob ^ (((ob >> 9) & 1) << 5)); }
__host__ __device__ __forceinline__ int perm32(int rho) { const int n = rho >> 4, i = rho & 15; return 8 * (i >> 2) + 4 * n + (i & 3); }
__host__ __device__ __forceinline__ void stage_rc(int b, int& R, int& C) { const int st = b / 1024, sb = b % 1024, swz = sb ^ (((sb >> 9) & 1) << 5); R = (st >> 1) * 16 + swz / 64; C = (st & 1) * 32 + (swz % 64) / 2; }
struct Unit { int pm, pn; };
struct Gemm { const bf16_t* A; const bf16_t* Bt; int M, N, K, lda, ldb; };
struct StaticOrder {
    int nM, nN, nwg, G, c;
    __device__ void init(int M, int N, int G_, int c_) { nM = M / BM; nN = N / BM; nwg = nM * nN; G = G_; c = c_; }
    __device__ bool next(int i, Unit& u) const {
        const int L = i * G + c; if (L >= nwg) return false;
        int wgid = L; { const int q = nwg / NXCD, r = nwg % NXCD, xcd = wgid % NXCD, off = wgid / NXCD; wgid = (xcd < r ? xcd * (q + 1) : r * (q + 1) + (xcd - r) * q) + off; }
        const int nig = WGM * nN, gid = wgid / nig, fm = gid * WGM, gsz = (nM - fm) < WGM ? (nM - fm) : WGM;
        u.pm = fm + ((wgid % nig) % gsz); u.pn = (wgid % nig) / gsz; return true;
    }
};
template <class Epi>
__device__ __forceinline__ void gemm_phase(LAS unsigned char* lds, const Gemm g, const StaticOrder& S, const Epi& E) {
    int tid_ = threadIdx.x; asm volatile("" : "+v"(tid_));
    const int tid = tid_, wid = __builtin_amdgcn_readfirstlane(tid >> 6), lane = tid & 63, wr = wid >> 2, wc = wid & 3, fr = lane & 15, fq = lane >> 4;
    const int K = g.K, nt = K / BK;
    unsigned voffA[2], voffB[2];
#pragma unroll
    for (int i = 0; i < 2; ++i) { int R, C; stage_rc(tid * 16 + i * 8192, R, C); const int Rb = Epi::PERM ? ((R & ~31) + perm32(R & 31)) : R; voffA[i] = (unsigned)(R * g.lda + C) * 2u; voffB[i] = (unsigned)(Rb * g.ldb + C) * 2u; }
    const size_t kstep = (size_t)(BK * 2);
    const size_t hsA = (size_t)HALF * g.lda * 2, hsB = (size_t)HALF * g.ldb * 2;
    const size_t tsA = 2 * hsA, tsB = 2 * hsB;
    const unsigned ldsw = (unsigned)wid * 1024u;
    const int aoff = lds_byte(wr * 64 + fr, fq * 8), boff = lds_byte(wc * 32 + fr, fq * 8);
#define PG8_SA(b, h) (((b) * 2 + (h)) * HTB)
#define PG8_SB(b, h) ((4 + (b) * 2 + (h)) * HTB)
#define PG8_STAGE(bufoff, gbase, voff) do { _Pragma("unroll") for (int _i = 0; _i < 2; ++_i) \
        __builtin_amdgcn_global_load_lds((const unsigned*)((const char*)(gbase) + (voff)[_i]), (LAS unsigned*)(lds + (bufoff) + ldsw + _i * 8192), 16, 0, 0); } while (0)
#define PG8_LDA(dst, b, h) do { _Pragma("unroll") for (int m = 0; m < 4; ++m) _Pragma("unroll") for (int k = 0; k < 2; ++k) dst[m][k] = *(const LAS bf16x8*)(lds + PG8_SA(b, h) + aoff + m * 2048 + k * 1024); } while (0)
#define PG8_LDB(dst, b, h) do { _Pragma("unroll") for (int n = 0; n < 2; ++n) _Pragma("unroll") for (int k = 0; k < 2; ++k) dst[n][k] = *(const LAS bf16x8*)(lds + PG8_SB(b, h) + boff + n * 2048 + k * 1024); } while (0)
#define PG8_MMA(ai, bj, At, Bt) do { __builtin_amdgcn_s_setprio(1); _Pragma("unroll") for (int m = 0; m < 4; ++m) _Pragma("unroll") for (int n = 0; n < 2; ++n) _Pragma("unroll") for (int k = 0; k < 2; ++k) \
        acc[ai][bj][m][n] = __builtin_amdgcn_mfma_f32_16x16x32_bf16(Bt[n][k], At[m][k], acc[ai][bj][m][n], 0, 0, 0); __builtin_amdgcn_s_setprio(0); } while (0)
#define PG8_WAIT_V(n) asm volatile("s_waitcnt vmcnt(" #n ")" ::: "memory")
#define PG8_WAIT_L(n) asm volatile("s_waitcnt lgkmcnt(" #n ")" ::: "memory")
#define PG8_BAR __builtin_amdgcn_s_barrier()
#define PG8_SCHED __builtin_amdgcn_sched_barrier(0)
    Unit cur, nxt; int ui = 0;
    if (!S.next(0, cur)) return;
    f32x4 acc[2][2][4][2];
#pragma unroll
    for (int a = 0; a < 2; ++a)
#pragma unroll
        for (int b = 0; b < 2; ++b)
#pragma unroll
            for (int m = 0; m < 4; ++m)
#pragma unroll
                for (int n = 0; n < 2; ++n) acc[a][b][m][n] = (f32x4){0.f, 0.f, 0.f, 0.f};
    bf16x8 At[4][2], B0[2][2], B1[2][2];
    const char* cA = (const char*)g.A + (size_t)cur.pm * tsA; const char* cB = (const char*)g.Bt + (size_t)cur.pn * tsB;
    PG8_STAGE(PG8_SB(0, 0), cB, voffB); PG8_STAGE(PG8_SB(0, 1), cB + hsB, voffB); PG8_STAGE(PG8_SA(0, 0), cA, voffA); PG8_STAGE(PG8_SA(0, 1), cA + hsA, voffA);
    if (wr == 1) PG8_BAR;
    PG8_WAIT_V(2); PG8_BAR;
    PG8_STAGE(PG8_SB(1, 0), cB + kstep, voffB); PG8_STAGE(PG8_SA(1, 0), cA + kstep, voffA); PG8_STAGE(PG8_SB(1, 1), cB + hsB + kstep, voffB);
    PG8_WAIT_V(6); PG8_BAR;
    for (;;) {
        const bool has_next = S.next(ui + 1, nxt);
        const char* nA = has_next ? (const char*)g.A + (size_t)nxt.pm * tsA : cA; const char* nB = has_next ? (const char*)g.Bt + (size_t)nxt.pn * tsB : cB;
#pragma unroll 1
        for (int t = 0; t < nt; t += 2) {
            const bool last = (t == nt - 2);
            const char* a1 = cA + (size_t)(t + 1) * kstep;
            const char* a2 = last ? nA : cA + (size_t)(t + 2) * kstep; const char* b2 = last ? nB : cB + (size_t)(t + 2) * kstep;
            const char* a3 = a2 + kstep; const char* b3 = b2 + kstep;
            PG8_LDB(B0, 0, 0); PG8_LDB(B1, 0, 1); PG8_SCHED; PG8_LDA(At, 0, 0); PG8_STAGE(PG8_SA(1, 1), a1 + hsA, voffA);
            PG8_WAIT_V(8); PG8_WAIT_L(0); PG8_BAR; PG8_MMA(0, 0, At, B0); PG8_MMA(0, 1, At, B1); PG8_BAR; PG8_SCHED;
            PG8_LDA(At, 0, 1); PG8_STAGE(PG8_SB(0, 0), b2, voffB); PG8_STAGE(PG8_SB(0, 1), b2 + hsB, voffB); PG8_STAGE(PG8_SA(0, 0), a2, voffA);
            PG8_WAIT_V(8); PG8_WAIT_L(0); PG8_BAR; PG8_MMA(1, 0, At, B0); PG8_MMA(1, 1, At, B1); PG8_BAR; PG8_SCHED;
            PG8_LDB(B0, 1, 0); PG8_LDB(B1, 1, 1); PG8_SCHED; PG8_LDA(At, 1, 0); PG8_STAGE(PG8_SA(0, 1), a2 + hsA, voffA);
            PG8_WAIT_V(8); PG8_WAIT_L(0); PG8_BAR; PG8_MMA(0, 0, At, B0); PG8_MMA(0, 1, At, B1); PG8_BAR; PG8_SCHED;
            PG8_LDA(At, 1, 1); PG8_STAGE(PG8_SB(1, 0), b3, voffB); PG8_STAGE(PG8_SB(1, 1), b3 + hsB, voffB); PG8_STAGE(PG8_SA(1, 0), a3, voffA);
            PG8_WAIT_V(8); PG8_WAIT_L(0); PG8_BAR; PG8_MMA(1, 0, At, B0); PG8_MMA(1, 1, At, B1); PG8_BAR; PG8_SCHED;
        }
        if (wr == 0) PG8_BAR;
        E(acc, cur, wr, wc, fr, fq);
        if (!has_next) break;
#pragma unroll
        for (int a = 0; a < 2; ++a)
#pragma unroll
            for (int b = 0; b < 2; ++b)
#pragma unroll
                for (int m = 0; m < 4; ++m)
#pragma unroll
                    for (int n = 0; n < 2; ++n) acc[a][b][m][n] = (f32x4){0.f, 0.f, 0.f, 0.f};
        cur = nxt; cA = nA; cB = nB; ++ui;
        if (wr == 1) PG8_BAR;
    }
    PG8_WAIT_V(0);
    PG8_BAR;
#undef PG8_SA
#undef PG8_SB
#undef PG8_STAGE
#undef PG8_LDA
#undef PG8_LDB
#undef PG8_MMA
#undef PG8_WAIT_V
#undef PG8_WAIT_L
#undef PG8_BAR
#undef PG8_SCHED
}
}
using pg8::Unit;

__device__ __forceinline__ void rows_rstd16(const float* ssq, int row0, int fq, float (&rs)[8]) {
    float p[8][4];
#pragma unroll
    for (int i = 0; i < 8; ++i) { const unsigned o = (unsigned)(4 * fq) * T + row0 + (i >> 2) * 128 + (i & 3) * 16;
#pragma unroll
        for (int k = 0; k < 4; ++k) p[i][k] = ssq[o + k * T]; }
#pragma unroll
    for (int i = 0; i < 8; ++i) { float s = (p[i][0] + p[i][1]) + (p[i][2] + p[i][3]); s += __shfl_xor(s, 16); s = xor32_add(s); rs[i] = rsqrtf(s * (1.0f / 1024.0f) + RMS_EPS); }
}
__device__ __forceinline__ void rows_rstd4(const float* pp, int row0, int fq, float invw, float mul, float (&rs)[8]) {
    float p[8];
#pragma unroll
    for (int i = 0; i < 8; ++i) p[i] = pp[(unsigned)fq * T + (unsigned)(row0 + (i >> 2) * 128 + (i & 3) * 16)];
#pragma unroll
    for (int i = 0; i < 8; ++i) { float s = p[i]; s += __shfl_xor(s, 16); s = xor32_add(s); rs[i] = rsqrtf(s * invw + RMS_EPS) * mul; }
}

struct EpiSwiGLU {
    static constexpr bool PERM = false;
    bf16_t* act; const float* ssq;
    __device__ __forceinline__ void operator()(const f32x4 (&acc)[2][2][4][2], const Unit& u, int wr, int wc, int fr, int fq) const {
        const int row0 = u.pm * 256 + wr * 64 + fr;
        const unsigned off0 = (unsigned)row0 * FF + u.pn * 128 + wc * 32 + fq * 8;
        float rsv[8]; rows_rstd16(ssq, row0, fq, rsv);
#pragma unroll
        for (int ai = 0; ai < 2; ++ai)
#pragma unroll
            for (int m = 0; m < 4; ++m) {
                const float rs = rsv[ai * 4 + m];
                u32x4 w;
#pragma unroll
                for (int bj = 0; bj < 2; ++bj) {
                    const f32x4 gt = acc[ai][bj][m][0] * rs, up = acc[ai][bj][m][1] * rs; f32x4 o;
#pragma unroll
                    for (int k = 0; k < 4; ++k) o[k] = gt[k] * up[k] * __builtin_amdgcn_rcpf(1.0f + __expf(-gt[k]));
                    const u32x2 pw = pack4(o); if (bj == 0) { w.x = pw.x; w.y = pw.y; } else { w.z = pw.x; w.w = pw.y; }
                }
                st16_wt(act + (off0 + (unsigned)((ai * 128 + m * 16) * FF)), w);
            }
    }
};
struct EpiResid {
    static constexpr bool PERM = true;
    bf16_t* xb; float* ssq; float scale;
    __device__ __forceinline__ void operator()(const f32x4 (&acc)[2][2][4][2], const Unit& u, int wr, int wc, int fr, int fq) const {
        const int row0 = u.pm * 256 + wr * 64 + fr;
        const unsigned off0 = (unsigned)row0 * DM + u.pn * 256 + wc * 32 + fq * 8;
        const unsigned so = (unsigned)(u.pn * 4 + wc) * T + row0;
#pragma unroll
        for (int ai = 0; ai < 2; ++ai) {
            u32x4 bv[4][2];
#pragma unroll
            for (int m = 0; m < 4; ++m)
#pragma unroll
                for (int bj = 0; bj < 2; ++bj) bv[m][bj] = *(const u32x4*)(xb + (off0 + (unsigned)((ai * 128 + m * 16) * DM + bj * 128)));
#pragma unroll
            for (int m = 0; m < 4; ++m) {
                float ss = 0.f;
#pragma unroll
                for (int bj = 0; bj < 2; ++bj) {
                    const unsigned o2 = off0 + (unsigned)((ai * 128 + m * 16) * DM + bj * 128);
                    const f32x4 v0 = unpack4((u32x2){bv[m][bj].x, bv[m][bj].y}) + acc[ai][bj][m][0] * scale;
                    const f32x4 v1 = unpack4((u32x2){bv[m][bj].z, bv[m][bj].w}) + acc[ai][bj][m][1] * scale;
                    const u32x2 p0 = pack4(v0), p1 = pack4(v1);
                    st16_wt(xb + o2, (u32x4){p0.x, p0.y, p1.x, p1.y});
                    ss += ((v0[0] * v0[0] + v0[1] * v0[1]) + (v0[2] * v0[2] + v0[3] * v0[3])) + ((v1[0] * v1[0] + v1[1] * v1[1]) + (v1[2] * v1[2] + v1[3] * v1[3]));
                }
                ss += __shfl_xor(ss, 16); ss = xor32_add(ss);
                if (fq == 0) ssq[so + (unsigned)(ai * 128 + m * 16)] = ss;
            }
            asm volatile("" ::: "memory");
        }
    }
};
template <bool ODD> struct EpiZ {
    static constexpr bool PERM = true;
    bf16_t* z; int ldz; const float* ssq; float* pq; float* pkv;
    __device__ __forceinline__ void operator()(const f32x4 (&acc)[2][2][4][2], const Unit& u, int wr, int wc, int fr, int fq) const {
        const int row0 = u.pm * 256 + wr * 64 + fr;
        const unsigned off0 = (unsigned)row0 * ldz + u.pn * 256 + wc * 32 + fq * 8;
        float rsv[8]; rows_rstd16(ssq, row0, fq, rsv);
#pragma unroll
        for (int ai = 0; ai < 2; ++ai)
#pragma unroll
            for (int m = 0; m < 4; ++m) {
                const int row = row0 + ai * 128 + m * 16;
                const float rs = rsv[ai * 4 + m];
                float s0 = 0.f, s1 = 0.f;
#pragma unroll
                for (int bj = 0; bj < 2; ++bj) {
                    const f32x4 v0 = acc[ai][bj][m][0] * rs, v1 = acc[ai][bj][m][1] * rs;
                    const u32x2 p0 = pack4(v0), p1 = pack4(v1);
                    st16_wt(z + (off0 + (unsigned)((ai * 128 + m * 16) * ldz + bj * 128)), (u32x4){p0.x, p0.y, p1.x, p1.y});
                    const float q = ((v0[0] * v0[0] + v0[1] * v0[1]) + (v0[2] * v0[2] + v0[3] * v0[3])) + ((v1[0] * v1[0] + v1[1] * v1[1]) + (v1[2] * v1[2] + v1[3] * v1[3]));
                    if (bj == 0) s0 += q; else s1 += q;
                }
                if (ODD) {
                    if (u.pn == 0) { float s = s0 + s1; s += __shfl_xor(s, 16); s = xor32_add(s); if (fq == 0) pq[(unsigned)wc * T + row] = s; }
                    else if (u.pn == 1) { float s = s0; s += __shfl_xor(s, 16); s = xor32_add(s); if (fq == 0) pkv[(unsigned)wc * T + row] = s; }
                }
            }
    }
};
struct EpiUp {
    static constexpr bool PERM = true;
    bf16_t* q; bf16_t* kv; const float* pq; const float* pkv; const float* cosT; const float* sinT;
    __device__ __forceinline__ void operator()(const f32x4 (&acc)[2][2][4][2], const Unit& u, int wr, int wc, int fr, int fq) const {
        const int row0 = u.pm * 256 + wr * 64 + fr;
        float rsv[8];
        if (u.pn < 3) {
            rows_rstd4(pq, row0, fq, 1.0f / 256.0f, QSCALE, rsv);
#pragma unroll
            for (int bj = 0; bj < 2; ++bj) {
                const int G = u.pn * 8 + bj * 4 + wc;
                const bool rope = (G % 3) == 2;
#pragma unroll
                for (int ai = 0; ai < 2; ++ai)
#pragma unroll
                    for (int m = 0; m < 4; ++m) {
                        const int row = row0 + ai * 128 + m * 16; const float rs = rsv[ai * 4 + m];
                        f32x4 v0 = acc[ai][bj][m][0] * rs, v1 = acc[ai][bj][m][1] * rs;
                        if (rope) {
                            const int pos = row & (SEQ - 1);
                            const f32x4 c4 = *(const f32x4*)(cosT + (unsigned)(pos * 16 + fq * 4)), s4 = *(const f32x4*)(sinT + (unsigned)(pos * 16 + fq * 4));
                            const f32x4 o0 = v0 * c4 - v1 * s4, o1 = v0 * s4 + v1 * c4; v0 = o0; v1 = o1;
                        }
                        const u32x2 p0 = pack4(v0), p1 = pack4(v1);
                        st16_wt(q + (unsigned)(row * 768 + G * 32 + fq * 8), (u32x4){p0.x, p0.y, p1.x, p1.y});
                    }
            }
        } else {
            rows_rstd4(pkv, row0, fq, 1.0f / 128.0f, 1.0f, rsv);
#pragma unroll
            for (int ai = 0; ai < 2; ++ai)
#pragma unroll
                for (int m = 0; m < 4; ++m) {
                    const int row = row0 + ai * 128 + m * 16; const float rs = rsv[ai * 4 + m];
#pragma unroll
                    for (int bj = 0; bj < 2; ++bj) {
                        const u32x2 p0 = pack4(acc[ai][bj][m][0] * rs), p1 = pack4(acc[ai][bj][m][1] * rs);
                        st16_wt(kv + (unsigned)(row * 1024 + (u.pn - 3) * 256 + bj * 128 + wc * 32 + fq * 8), (u32x4){p0.x, p0.y, p1.x, p1.y});
                    }
                }
        }
    }
};

#define XB_TMO      128
#define XB_XCNT(j)  (256  + 64 * (j))
#define XB_XSUB(j)  (1280 + 64 * (j))
#define XB_XGEN(j)  (2304 + 64 * (j))
#define XB_TOP      3328
#define XB_TOPGEN   3392
#define XCD_BAR_WORDS 3456
#define XB_LSUB(j)  (3456 + 64 * (j))
#define XB_LGEN(j)  (4480 + 64 * (j))
#define XB_SPIN_CAP (1u << 18)
__device__ __forceinline__ unsigned xb_ld(unsigned* p)              { return __hip_atomic_load(p, __ATOMIC_RELAXED, __HIP_MEMORY_SCOPE_AGENT); }
__device__ __forceinline__ unsigned xb_add(unsigned* p, unsigned v) { return __hip_atomic_fetch_add(p, v, __ATOMIC_RELAXED, __HIP_MEMORY_SCOPE_AGENT); }
__device__ __forceinline__ unsigned xb_xcc_id() { return (unsigned)__builtin_amdgcn_s_getreg((3 << 11) | 20) & 0xFu; }
#define XB_SPIN(cond, bar) do { unsigned _sp = 0; while (cond) { __builtin_amdgcn_s_sleep(1); \
    if ((++_sp & 255u) == 0u) { if (xb_ld(&(bar)[XB_TMO])) break; if (_sp > XB_SPIN_CAP) { atomicAdd(&(bar)[XB_TMO], 1u); break; } } } } while (0)
struct XcdBarrier { unsigned* bar; unsigned x; volatile LAS unsigned* st; };
__device__ __forceinline__ XcdBarrier xcd_barrier_post(unsigned* bar, volatile LAS unsigned* st) {
    XcdBarrier b; b.bar = bar; b.x = xb_xcc_id(); b.st = st;
    if (threadIdx.x == 0) st[3] = xb_add(&bar[XB_XCNT(b.x)], 1u);
    return b;
}
__device__ __forceinline__ void xcd_barrier_complete(unsigned* bar, unsigned x, unsigned& nloc, unsigned& nx, unsigned& regular) {
    const unsigned G = gridDim.x * gridDim.y * gridDim.z;
    unsigned sum, cnt, mine, sp = 0u;
    for (;;) {
        sum = 0u; cnt = 0u; mine = 0u;
#pragma unroll
        for (unsigned j = 0; j < 16; ++j) { const unsigned c = xb_ld(&bar[XB_XCNT(j)]); sum += c; cnt += (c > 0u) ? 1u : 0u; mine = (j == x) ? c : mine; }
        if (sum == G) break;
        __builtin_amdgcn_s_sleep(1);
        if ((++sp & 255u) == 0u) { if (xb_ld(&bar[XB_TMO])) break; if (sp > XB_SPIN_CAP) { atomicAdd(&bar[XB_TMO], 1u); break; } }
    }
    nloc = mine > 0u ? mine : 1u; nx = cnt > 0u ? cnt : 1u;
    unsigned reg = (G == 256u) ? 1u : 0u;
#pragma unroll
    for (unsigned j = 0; j < 16; ++j) { const unsigned c = xb_ld(&bar[XB_XCNT(j)]); if (c != (j < 8u ? 32u : 0u)) reg = 0u; }
    regular = reg;
}
__device__ __forceinline__ void xcd_barrier(const XcdBarrier& b) {
    asm volatile("s_waitcnt vmcnt(0)" ::: "memory");
    __syncthreads();
    if (threadIdx.x == 0) {
        unsigned* bar = b.bar;
        __builtin_amdgcn_s_waitcnt(0);
        unsigned nloc = b.st[0], nx = b.st[1];
        if (nloc == 0u) { unsigned reg_; xcd_barrier_complete(bar, b.x, nloc, nx, reg_); b.st[0] = nloc; b.st[1] = nx; b.st[2] = reg_; }
        const unsigned old = xb_add(&bar[XB_XSUB(b.x)], 1u);
        const unsigned gen = old / nloc;
        if (old + 1u == (gen + 1u) * nloc) {
            __builtin_amdgcn_fence(__ATOMIC_RELEASE, "agent");
            asm volatile("s_waitcnt vmcnt(0)" ::: "memory");
            const unsigned og = xb_add(&bar[XB_TOP], 1u);
            const unsigned tg = og / nx;
            if (og + 1u == (tg + 1u) * nx) xb_add(&bar[XB_TOPGEN], 1u);
            else XB_SPIN(xb_ld(&bar[XB_TOPGEN]) == tg, bar);
            __builtin_amdgcn_fence(__ATOMIC_ACQUIRE, "agent");
            xb_add(&bar[XB_XGEN(b.x)], 1u);
            asm volatile("s_waitcnt vmcnt(0)" ::: "memory");
        } else {
            XB_SPIN(xb_ld(&bar[XB_XGEN(b.x)]) == gen, bar);
            __builtin_amdgcn_fence(__ATOMIC_ACQUIRE, "agent");
            asm volatile("s_waitcnt vmcnt(0)" ::: "memory");
        }
    }
    __syncthreads();
}
__device__ __forceinline__ void xcd_local_barrier(const XcdBarrier& b) {
    asm volatile("s_waitcnt vmcnt(0)" ::: "memory");
    __syncthreads();
    if (threadIdx.x == 0) {
        unsigned* bar = b.bar;
        __builtin_amdgcn_s_waitcnt(0);
        const unsigned nloc = b.st[0];
        const unsigned old = xb_add(&bar[XB_LSUB(b.x)], 1u);
        const unsigned gen = old / nloc;
        if (old + 1u == (gen + 1u) * nloc) xb_add(&bar[XB_LGEN(b.x)], 1u);
        else XB_SPIN(xb_ld(&bar[XB_LGEN(b.x)]) == gen, bar);
        __builtin_amdgcn_fence(__ATOMIC_ACQUIRE, "agent");
        asm volatile("s_waitcnt vmcnt(0)" ::: "memory");
    }
    __syncthreads();
}
template <int K> __device__ __forceinline__ const float* inp() {
    unsigned long long v;
    const unsigned long long kp_ = (unsigned long long)__builtin_amdgcn_kernarg_segment_ptr();
    const unsigned long long kps_ = ((unsigned long long)(unsigned)__builtin_amdgcn_readfirstlane((int)(unsigned)(kp_ >> 32)) << 32) | (unsigned)__builtin_amdgcn_readfirstlane((int)(unsigned)kp_);
    asm volatile("s_load_dwordx2 %0, %1, %2\n\ts_waitcnt lgkmcnt(0)" : "=s"(v) : "s"(kps_), "n"(K * 8) : "memory");
    return (const float*)(const __attribute__((address_space(1))) float*)v;
}
struct Args { const float* in[36]; float* out; unsigned char* ws; int ph_lo, ph_hi; };
struct Frame {
    LAS unsigned char* lds;
    int tid, lane, wave, G, bid;
    float* out; unsigned char* ws;
};

struct CvtDesc { const float* W; const float* gain; bf16_t* WT; int N, ldt, kdst, mode, item; };
__device__ __forceinline__ void cvt_load(const CvtDesc& d, int lane, f32x4 (&v)[8], float (&g)[8]) {
    const int nblk = d.N / 32, kb = d.item / nblk, nb = d.item % nblk, k0 = 64 * kb, n0 = 32 * nb;
    const int kq = lane >> 3, nq = (lane & 7) * 4;
#pragma unroll
    for (int i = 0; i < 8; ++i) v[i] = *(const f32x4*)(d.W + (size_t)(k0 + i * 8 + kq) * d.N + n0 + nq);
#pragma unroll
    for (int i = 0; i < 8; ++i) g[i] = d.gain ? d.gain[k0 + i * 8 + kq] : 1.0f;
}
__device__ __forceinline__ void cvt_finish(const CvtDesc& d, int lane, LAS float* scr, const f32x4 (&v)[8], const float (&g)[8]) {
    const int nblk = d.N / 32, kb = d.item / nblk, nb = d.item % nblk, k0 = 64 * kb, n0 = 32 * nb;
    const int kq = lane >> 3, nq = (lane & 7) * 4;
#pragma unroll
    for (int i = 0; i < 8; ++i) { const int kk = i * 8 + kq; const float gk = g[i]; LAS float* dd = scr + kk * 33 + nq; dd[0] = v[i][0] * gk; dd[1] = v[i][1] * gk; dd[2] = v[i][2] * gk; dd[3] = v[i][3] * gk; }
    asm volatile("s_waitcnt lgkmcnt(0)" ::: "memory");
    const int c = lane & 7;
#pragma unroll
    for (int j = 0; j < 4; ++j) {
        const int n = (lane >> 3) + 8 * j; const LAS float* sp_ = scr + (8 * c) * 33 + n;
        u32x4 o; o.x = pk2(sp_[0 * 33], sp_[1 * 33]); o.y = pk2(sp_[2 * 33], sp_[3 * 33]); o.z = pk2(sp_[4 * 33], sp_[5 * 33]); o.w = pk2(sp_[6 * 33], sp_[7 * 33]);
        int nn = n0 + n;
        if (d.mode == 1) { const int which = nn >= FF ? 1 : 0, h = nn - which * FF, hl = h & 127; nn = 256 * (h >> 7) + 128 * ((hl >> 2) & 1) + 32 * (hl >> 5) + 16 * which + 4 * ((hl >> 3) & 3) + (hl & 3); }
        if (d.mode == 2) { const int hd = nn / 96, dd = nn % 96; if (dd >= 64) { const int r_ = dd - 64, n_ = r_ >> 4, i_ = r_ & 15; nn = hd * 96 + 64 + 8 * (i_ >> 2) + 4 * n_ + (i_ & 3); } }
        st16_wt(d.WT + (size_t)nn * d.ldt + d.kdst + k0 + 8 * c, o);
    }
    asm volatile("s_waitcnt lgkmcnt(0)" ::: "memory");
}
__device__ __forceinline__ void zero_fill16(unsigned char* base, int row_bytes_stride, int col_byte0, int chunks_per_row, int nrows, int gtid, int gthreads) {
    const int total = nrows * chunks_per_row;
    unsigned zz = 0u; asm volatile("" : "+v"(zz));
    const u32x4 z4 = (u32x4){zz, zz, zz, zz};
    for (int i = gtid; i < total; i += gthreads) { const int r = i / chunks_per_row, c = i % chunks_per_row; st16_wt(base + (size_t)r * row_bytes_stride + col_byte0 + c * 16, z4); }
}
__device__ __forceinline__ void convert_layer(const Frame& F, int l, int part, int nparts, int vb, int nvb) {
    unsigned char* wb = F.ws + WS_WBUF0 + (size_t)(l & 1) * WBUF_BYTES;
    LAS float* scr = (LAS float*)(F.lds + F.wave * 16384);
    const int gw = vb * 8 + F.wave, NGW = nvb * 8;
    const int hl = l >> 1; const bool odd = l & 1;
    constexpr int I_IN = 16 * 176, I_OUT = 44 * 32, I_MO = 16 * 32;
    const int I_MI = odd ? 16 * 45 : 16 * 88;
    const int I_X = odd ? (4 * 24 + 2 * 32) : (16 + 16 + 32);
    const int total = 2 * I_IN + 2 * I_OUT + I_MI + I_MO + I_X;
    const int it_lo = (int)((long)total * part / nparts), it_hi = (int)((long)total * (part + 1) / nparts);
    auto desc = [&](int it) -> CvtDesc {
        CvtDesc d; d.kdst = 0; d.mode = 0; d.gain = nullptr;
        int r = it;
        if (r < I_IN) { d.W = inp<2>() + (size_t)l * DM * 2 * FF; d.N = 2 * FF; d.gain = inp<1>() + l * DM; d.WT = (bf16_t*)(wb + WB_W1IN); d.ldt = DM; d.mode = 1; d.item = r; return d; } r -= I_IN;
        if (r < I_IN) { d.W = inp<6>() + (size_t)l * DM * 2 * FF; d.N = 2 * FF; d.gain = inp<5>() + l * DM; d.WT = (bf16_t*)(wb + WB_W2IN); d.ldt = DM; d.mode = 1; d.item = r; return d; } r -= I_IN;
        if (r < I_OUT) { d.W = inp<3>() + (size_t)l * FF * DM; d.N = DM; d.WT = (bf16_t*)(wb + WB_W1OUT); d.ldt = FF; d.item = r; return d; } r -= I_OUT;
        if (r < I_OUT) { d.W = inp<7>() + (size_t)l * FF * DM; d.N = DM; d.WT = (bf16_t*)(wb + WB_W2OUT); d.ldt = FF; d.item = r; return d; } r -= I_OUT;
        if (r < I_MI) {
            if (odd) { d.W = inp<25>() + (size_t)hl * DM * PO; d.N = PO; } else { d.W = inp<8>() + (size_t)hl * DM * PE; d.N = PE; }
            d.gain = inp<4>() + l * DM; d.WT = (bf16_t*)(wb + WB_WMIN); d.ldt = DM; d.item = r; return d; } r -= I_MI;
        if (r < I_MO) { d.W = (odd ? inp<26>() : inp<9>()) + (size_t)hl * DM * DM; d.N = DM; d.WT = (bf16_t*)(wb + WB_WMOUT); d.ldt = DM; d.item = r; return d; } r -= I_MO;
        if (odd) {
            if (r < 96) { d.W = inp<28>() + (size_t)hl * 256 * 768; d.N = 768; d.gain = inp<27>() + hl * 256; d.WT = (bf16_t*)(wb + WB_WX); d.ldt = 384; d.mode = 2; d.item = r; return d; } r -= 96;
            d.W = inp<30>() + (size_t)hl * 128 * 1024; d.N = 1024; d.gain = inp<29>() + hl * 128; d.WT = (bf16_t*)(wb + WB_WX) + (size_t)768 * 384; d.ldt = 384; d.kdst = 256; d.item = r; return d;
        }
        if (r < 16) { d.W = inp<16>() + (size_t)hl * 64 * 512; d.N = 512; d.WT = (bf16_t*)(wb + WB_WX); d.ldt = 64; d.item = r; return d; } r -= 16;
        if (r < 16) { d.W = inp<18>() + (size_t)hl * 64 * 512; d.N = 512; d.WT = (bf16_t*)(wb + WB_WX) + 512 * 64; d.ldt = 64; d.item = r; return d; } r -= 16;
        d.W = inp<19>() + (size_t)hl * 128 * 512; d.N = 512; d.WT = (bf16_t*)(wb + WB_WX) + 2 * 512 * 64; d.ldt = 128; d.item = r; return d;
    };
    {
        int it = it_lo + gw;
        if (it < it_hi) {
            CvtDesc d0 = desc(it), d1 = d0; f32x4 va[8], vc[8]; float ga[8], gc[8];
            cvt_load(d0, F.lane, va, ga);
            for (;;) {
                const int it1 = it + NGW; const bool h1 = it1 < it_hi;
                if (h1) { d1 = desc(it1); cvt_load(d1, F.lane, vc, gc); }
                cvt_finish(d0, F.lane, scr, va, ga);
                if (!h1) break;
                const int it2 = it1 + NGW; const bool h2 = it2 < it_hi;
                if (h2) { d0 = desc(it2); cvt_load(d0, F.lane, va, ga); }
                cvt_finish(d1, F.lane, scr, vc, gc);
                if (!h2) break;
                it = it2;
            }
        }
    }
    if (odd && part == 0) {
        const int gtid = vb * 512 + F.tid, gth = nvb * 512;
        zero_fill16(wb + WB_WMIN + (size_t)PO * DM * 2, DM * 2, 0, 128, POP - PO, gtid, gth);
        zero_fill16(wb + WB_WX, 384 * 2, 512, 16, 768, gtid, gth);
        zero_fill16(wb + WB_WX + (size_t)768 * 384 * 2, 384 * 2, 0, 32, 1024, gtid, gth);
    }
}

__device__ __forceinline__ void x_prologue(const Frame& F) {
    const float* x = inp<0>(); bf16_t* xb = (bf16_t*)(F.ws + WS_XB); float* ssq = (float*)(F.ws + WS_SSQ);
    const int gw = F.bid * 8 + F.wave, NGW = F.G * 8, lane = F.lane;
    for (int m = gw; m < T; m += NGW) {
        const f32x4* xr = (const f32x4*)(x + (size_t)m * DM) + lane;
        f32x4 v[4]; float s = 0.f;
#pragma unroll
        for (int j = 0; j < 4; ++j) { v[j] = xr[64 * j]; s += (v[j][0] * v[j][0] + v[j][1] * v[j][1]) + (v[j][2] * v[j][2] + v[j][3] * v[j][3]); }
        s = wave_sum(s);
        u32x2* o = (u32x2*)(xb + (size_t)m * DM) + lane;
#pragma unroll
        for (int j = 0; j < 4; ++j) st8_wt(o + 64 * j, pack4(v[j]));
        if (lane < 16) ssq[(size_t)lane * T + m] = (lane == 0) ? s : 0.f;
    }
    float* cosT = (float*)(F.ws + WS_COS); float* sinT = (float*)(F.ws + WS_SIN);
    for (int i = F.bid * 512 + F.tid; i < SEQ * 16; i += F.G * 512) {
        const int pos = i >> 4, k = i & 15;
        const float inv = exp2f(-(float)k * 0.8304820237218407f);
        const float ang = (float)pos * inv;
        const double rev = (double)ang * 0.15915494309189535;
        const float fr = (float)(rev - floor(rev));
        cosT[i] = __builtin_amdgcn_cosf(fr); sinT[i] = __builtin_amdgcn_sinf(fr);
    }
}
__device__ __forceinline__ void final_norm(const Frame& F) {
    const float* g = inp<35>(); float* x = F.out; const bf16_t* xb = (const bf16_t*)(F.ws + WS_XB);
    const int gw = F.bid * 8 + F.wave, NGW = F.G * 8, lane = F.lane;
    for (int m = gw; m < T; m += NGW) {
        f32x4* xr = (f32x4*)(x + (size_t)m * DM) + lane;
        const u32x2* br = (const u32x2*)(xb + (size_t)m * DM) + lane;
        f32x4 v[4]; float s = 0.f;
#pragma unroll
        for (int j = 0; j < 4; ++j) { v[j] = unpack4(br[64 * j]); s += (v[j][0] * v[j][0] + v[j][1] * v[j][1]) + (v[j][2] * v[j][2] + v[j][3] * v[j][3]); }
        s = wave_sum(s);
        const float rs = rsqrtf(s * (1.0f / 1024.0f) + RMS_EPS);
#pragma unroll
        for (int j = 0; j < 4; ++j) { const f32x4 gg = *((const f32x4*)g + lane + 64 * j); xr[64 * j] = v[j] * rs * gg; }
    }
}

__device__ __forceinline__ void gsu_item(const Frame& F, int item, int e) {
    const int nb = item >> 2, g = item & 3, tok0 = nb * 128, lane = F.lane, wave = F.wave, fr = lane & 15, fq = lane >> 4;
    const bf16_t* z = (const bf16_t*)(F.ws + WS_ACT);
    bf16_t* ymix = (bf16_t*)(F.ws + WS_YMIX);
    const float* ws = inp<10>() + (size_t)(e * 4 + g) * 128 * 128; const float* bs = inp<11>() + (e * 4 + g) * 128;
    const float* lng = inp<12>() + e * 512; const float* lnb = inp<13>() + e * 512;
    LAS bf16_t* vn = (LAS bf16_t*)F.lds;
    u32x4 zrs[16];
#pragma unroll
    for (int fi = 0; fi < 16; ++fi) zrs[fi] = *(const u32x4*)(z + (size_t)(tok0 + wave * 16 + fi) * PE + 512 + lane * 8);
    float lgv[8], lbv[8];
#pragma unroll
    for (int k = 0; k < 8; ++k) { lgv[k] = lng[lane * 8 + k]; lbv[k] = lnb[lane * 8 + k]; }
#pragma unroll
    for (int fi = 0; fi < 16; ++fi) {
        const int frame = wave * 16 + fi;
        const u32x4 zr = zrs[fi];
        float gv[8]; gv[0] = bflo(zr.x); gv[1] = bfhi(zr.x); gv[2] = bflo(zr.y); gv[3] = bfhi(zr.y); gv[4] = bflo(zr.z); gv[5] = bfhi(zr.z); gv[6] = bflo(zr.w); gv[7] = bfhi(zr.w);
        float s = 0.f;
#pragma unroll
        for (int k = 0; k < 8; ++k) { gv[k] = gelu_tanh(gv[k]); s += gv[k]; }
        const float mean = wave_sum(s) * (1.0f / 512.0f); float qv = 0.f;
#pragma unroll
        for (int k = 0; k < 8; ++k) { gv[k] -= mean; qv += gv[k] * gv[k]; }
        const float rstd = rsqrtf(wave_sum(qv) * (1.0f / 512.0f) + 1e-5f);
        if ((lane >> 4) == g) {
            const int cl = (lane & 15) * 8;
#pragma unroll
            for (int k = 0; k < 8; ++k) { const float o = gv[k] * rstd * lgv[k] + lbv[k]; vn[(cl + k) * 136 + frame] = (bf16_t)(pk2(o, 0.f) & 0xffffu); }
        }
    }
    __syncthreads();
    const int i = wave * 16 + fr; const int nks = (wave < 4) ? 2 : 4;
    f32x4 acc[8];
#pragma unroll
    for (int ct = 0; ct < 8; ++ct) acc[ct] = (f32x4){0.f, 0.f, 0.f, 0.f};
    for (int ks = 0; ks < nks; ++ks) {
        const float* wp = ws + (size_t)i * 128 + ks * 32 + fq * 8;
        const f32x4 w0 = *(const f32x4*)wp, w1 = *(const f32x4*)(wp + 4);
        u32x4 wy; wy.x = pk2(w0[0], w0[1]); wy.y = pk2(w0[2], w0[3]); wy.z = pk2(w1[0], w1[1]); wy.w = pk2(w1[2], w1[3]);
        const bf16x8 Y = __builtin_bit_cast(bf16x8, wy);
#pragma unroll
        for (int ct = 0; ct < 8; ++ct) {
            const bf16x8 X = *(const LAS bf16x8*)(vn + (ct * 16 + fr) * 136 + ks * 32 + fq * 8);
            acc[ct] = __builtin_amdgcn_mfma_f32_16x16x32_bf16(X, Y, acc[ct], 0, 0, 0);
        }
    }
    const size_t tok = tok0 + i; const float bsv = bs[i];
#pragma unroll
    for (int ct = 0; ct < 8; ++ct) {
        const int c = g * 128 + ct * 16 + fq * 4;
        const f32x4 uz = unpack4(*(const u32x2*)(z + tok * PE + c)); f32x4 o;
#pragma unroll
        for (int k = 0; k < 4; ++k) o[k] = gelu_tanh(uz[k]) * (acc[ct][k] + bsv);
        st8_wt(ymix + tok * DM + c, pack4(o));
    }
    __syncthreads();
}

__device__ __forceinline__ void prep_item(const Frame& F, int item, int e, const unsigned char* wb, bool stage) {
    const int tok0 = item * 32, b = tok0 / SEQ, t0 = tok0 % SEQ, lane = F.lane, h = F.wave, fr = lane & 15, fq = lane >> 4, tid = F.tid;
    const bf16_t* z = (const bf16_t*)(F.ws + WS_ACT);
    bf16_t* ymix = (bf16_t*)(F.ws + WS_YMIX); bf16_t* sc = (bf16_t*)(F.ws + WS_SC); float* cb = (float*)(F.ws + WS_CB);
    const float* mu = inp<14>() + e * PB; const float* w0p = inp<15>() + e * 512; const float* a0p = inp<17>() + e * 512;
    const float* kkp = inp<20>() + e * 512; const float* kap = inp<21>() + e * 512; const float* rkp = inp<22>() + e * 512;
    LAS bf16_t* At = (LAS bf16_t*)F.lds;
    LAS float* PRM = (LAS float*)(F.lds + 32768);
    if (stage) {
        PRM[0 * 512 + tid] = mu[tid]; PRM[1 * 512 + tid] = mu[512 + tid]; PRM[2 * 512 + tid] = mu[1024 + tid];
        PRM[3 * 512 + tid] = kkp[tid]; PRM[4 * 512 + tid] = kap[tid]; PRM[5 * 512 + tid] = rkp[tid];
        PRM[6 * 512 + tid] = w0p[tid]; PRM[7 * 512 + tid] = a0p[tid];
    }
    {
        const int token = tid >> 4, chunk = tid & 15, t = t0 + token; const size_t tok = tok0 + token;
        const bf16_t* zp = z + tok * PE + 2560 + chunk * 16;
        const u32x4 c0 = *(const u32x4*)zp, c1 = *(const u32x4*)(zp + 8);
        const bf16_t* zq = (t > 0) ? zp - PE : zp;
        u32x4 p0 = *(const u32x4*)zq, p1 = *(const u32x4*)(zq + 8);
        if (t == 0) { p0 = (u32x4){0u, 0u, 0u, 0u}; p1 = p0; }
        float cv[16], pv[16];
#pragma unroll
        for (int k = 0; k < 4; ++k) { cv[2 * k] = bflo(c0[k]); cv[2 * k + 1] = bfhi(c0[k]); cv[8 + 2 * k] = bflo(c1[k]); cv[9 + 2 * k] = bfhi(c1[k]);
                                      pv[2 * k] = bflo(p0[k]); pv[2 * k + 1] = bfhi(p0[k]); pv[8 + 2 * k] = bflo(p1[k]); pv[9 + 2 * k] = bfhi(p1[k]); }
        const f32x4* mup = (const f32x4*)(mu + 1536 + chunk * 16);
        const f32x4 m0 = mup[0], m1 = mup[1], m2 = mup[2], m3 = mup[3];
        const float mv_[16] = {m0[0], m0[1], m0[2], m0[3], m1[0], m1[1], m1[2], m1[3], m2[0], m2[1], m2[2], m2[3], m3[0], m3[1], m3[2], m3[3]};
#pragma unroll
        for (int k = 0; k < 16; ++k) cv[k] = cv[k] + mv_[k] * (pv[k] - cv[k]);
        if (chunk < 4) {
#pragma unroll
            for (int k = 0; k < 16; ++k) cv[k] = tanh_(cv[k]);
        } else if (chunk >= 8) {
#pragma unroll
            for (int k = 0; k < 16; ++k) cv[k] = sigmoidf_(cv[k]);
        }
        u32x4 o0, o1;
#pragma unroll
        for (int k = 0; k < 4; ++k) { o0[k] = pk2(cv[2 * k], cv[2 * k + 1]); o1[k] = pk2(cv[8 + 2 * k], cv[9 + 2 * k]); }
        *(LAS u32x4*)(At + token * 264 + chunk * 16) = o0; *(LAS u32x4*)(At + token * 264 + chunk * 16 + 8) = o1;
    }
    __syncthreads();
    const bf16_t* DUt = (const bf16_t*)(wb + WB_WX); const bf16_t* IUt = DUt + 512 * 64; const bf16_t* GUt = DUt + 2 * 512 * 64;
#pragma unroll
    for (int mt = 0; mt < 2; ++mt) {
        const LAS bf16_t* Ar = At + (mt * 16 + fr) * 264 + fq * 8;
        const int t = t0 + mt * 16 + fr; const size_t tok = tok0 + mt * 16 + fr; const bool hp = t > 0;
        f32x4 ev[4], av[4];
        {
            f32x4 acc[4];
#pragma unroll
            for (int nt = 0; nt < 4; ++nt) acc[nt] = (f32x4){0.f, 0.f, 0.f, 0.f};
#pragma unroll
            for (int ks = 0; ks < 2; ++ks) {
                const bf16x8 Yv = *(const LAS bf16x8*)(Ar + 0 + ks * 32);
#pragma unroll
                for (int nt = 0; nt < 4; ++nt) {
                    const bf16x8 X = *(const bf16x8*)(DUt + (size_t)(h * 64 + 32 * (nt >> 1) + 8 * (fr >> 2) + 4 * (nt & 1) + (fr & 3)) * 64 + ks * 32 + fq * 8);
                    acc[nt] = __builtin_amdgcn_mfma_f32_16x16x32_bf16(X, Yv, acc[nt], 0, 0, 0);
                }
            }
#pragma unroll
            for (int nt = 0; nt < 4; ++nt) {
                const f32x4 w0 = *(const LAS f32x4*)(PRM + 6 * 512 + h * 64 + 32 * (nt >> 1) + 8 * fq + 4 * (nt & 1));
#pragma unroll
                for (int k = 0; k < 4; ++k) ev[nt][k] = 0.6065306597126334f * __builtin_amdgcn_rcpf(1.0f + __expf(-(w0[k] + acc[nt][k])));
            }
        }
        {
            f32x4 acc[4];
#pragma unroll
            for (int nt = 0; nt < 4; ++nt) acc[nt] = (f32x4){0.f, 0.f, 0.f, 0.f};
#pragma unroll
            for (int ks = 0; ks < 2; ++ks) {
                const bf16x8 Yv = *(const LAS bf16x8*)(Ar + 64 + ks * 32);
#pragma unroll
                for (int nt = 0; nt < 4; ++nt) {
                    const bf16x8 X = *(const bf16x8*)(IUt + (size_t)(h * 64 + 32 * (nt >> 1) + 8 * (fr >> 2) + 4 * (nt & 1) + (fr & 3)) * 64 + ks * 32 + fq * 8);
                    acc[nt] = __builtin_amdgcn_mfma_f32_16x16x32_bf16(X, Yv, acc[nt], 0, 0, 0);
                }
            }
#pragma unroll
            for (int nt = 0; nt < 4; ++nt) {
                const f32x4 a0 = *(const LAS f32x4*)(PRM + 7 * 512 + h * 64 + 32 * (nt >> 1) + 8 * fq + 4 * (nt & 1));
#pragma unroll
                for (int k = 0; k < 4; ++k) av[nt][k] = sigmoidf_(a0[k] + acc[nt][k]);
            }
        }
        {
            f32x4 acc[4];
#pragma unroll
            for (int nt = 0; nt < 4; ++nt) acc[nt] = (f32x4){0.f, 0.f, 0.f, 0.f};
#pragma unroll
            for (int ks = 0; ks < 4; ++ks) {
                const bf16x8 Yv = *(const LAS bf16x8*)(Ar + 128 + ks * 32);
#pragma unroll
                for (int nt = 0; nt < 4; ++nt) {
                    const bf16x8 X = *(const bf16x8*)(GUt + (size_t)(h * 64 + 32 * (nt >> 1) + 8 * (fr >> 2) + 4 * (nt & 1) + (fr & 3)) * 128 + ks * 32 + fq * 8);
                    acc[nt] = __builtin_amdgcn_mfma_f32_16x16x32_bf16(X, Yv, acc[nt], 0, 0, 0);
                }
            }
#pragma unroll
            for (int a2 = 0; a2 < 2; ++a2) { const u32x2 p0 = pack4(acc[2 * a2]), p1 = pack4(acc[2 * a2 + 1]);
                st16_wt(ymix + tok * DM + 512 + h * 64 + 32 * a2 + 8 * fq, (u32x4){p0.x, p0.y, p1.x, p1.y}); }
        }
        f32x4 rv[4], kv[4], kk[4]; float ssq = 0.f;
        bf16_t* sp = sc + ((size_t)(b * 8 + h) * SEQ + t) * 384;
#define PK8(lo4, hi4) ({ const u32x2 p0_ = pack4(lo4), p1_ = pack4(hi4); (u32x4){p0_.x, p0_.y, p1_.x, p1_.y}; })
#pragma unroll
        for (int a2 = 0; a2 < 2; ++a2) {
            const int cl = 32 * a2 + 8 * fq, c = h * 64 + cl;
            const bf16_t* zp = z + tok * PE + 1024 + c;
            const u32x4 zr = *(const u32x4*)zp, zk = *(const u32x4*)(zp + 512), zv = *(const u32x4*)(zp + 1024);
            const bf16_t* zq = hp ? zp - PE : zp; const float hm = hp ? 1.0f : 0.0f;
            const u32x4 qr = *(const u32x4*)zq, qk = *(const u32x4*)(zq + 512), qv = *(const u32x4*)(zq + 1024);
            f32x4 vv[2];
#pragma unroll
            for (int hh = 0; hh < 2; ++hh) {
                const int nt = 2 * a2 + hh, c4 = c + 4 * hh;
                const f32x4 cr = unpack4(hh ? (u32x2){zr.z, zr.w} : (u32x2){zr.x, zr.y}), ck = unpack4(hh ? (u32x2){zk.z, zk.w} : (u32x2){zk.x, zk.y}), cvv = unpack4(hh ? (u32x2){zv.z, zv.w} : (u32x2){zv.x, zv.y});
                const f32x4 pr = unpack4(hh ? (u32x2){qr.z, qr.w} : (u32x2){qr.x, qr.y}) * hm, pk = unpack4(hh ? (u32x2){qk.z, qk.w} : (u32x2){qk.x, qk.y}) * hm, pvv = unpack4(hh ? (u32x2){qv.z, qv.w} : (u32x2){qv.x, qv.y}) * hm;
                const f32x4 mr = *(const LAS f32x4*)(PRM + c4), mk = *(const LAS f32x4*)(PRM + 512 + c4), mv = *(const LAS f32x4*)(PRM + 1024 + c4);
                rv[nt] = cr + mr * (pr - cr); kv[nt] = ck + mk * (pk - ck); vv[hh] = cvv + mv * (pvv - cvv);
                kk[nt] = kv[nt] * *(const LAS f32x4*)(PRM + 3 * 512 + c4);
                ssq += (kk[nt][0] * kk[nt][0] + kk[nt][1] * kk[nt][1]) + (kk[nt][2] * kk[nt][2] + kk[nt][3] * kk[nt][3]);
            }
            st16_wt(sp + 5 * 64 + cl, PK8(vv[0], vv[1]));
            st16_wt(sp + 4 * 64 + cl, PK8(rv[2 * a2], rv[2 * a2 + 1]));
            st16_wt(sp + 0 * 64 + cl, PK8(ev[2 * a2], ev[2 * a2 + 1]));
        }
        ssq += __shfl_xor(ssq, 16); ssq = xor32_add(ssq);
        const float inv = 1.0f / fmaxf(sqrtf(ssq), 1e-12f);
        float cbp = 0.f;
#pragma unroll
        for (int a2 = 0; a2 < 2; ++a2) {
            const int cl = 32 * a2 + 8 * fq, c = h * 64 + cl;
            f32x4 kp[2], nk[2], nb[2];
#pragma unroll
            for (int hh = 0; hh < 2; ++hh) {
                const int nt = 2 * a2 + hh, c4 = c + 4 * hh;
                const f32x4 a = av[nt], kkn = kk[nt] * inv;
                const f32x4 ka = *(const LAS f32x4*)(PRM + 4 * 512 + c4), rk = *(const LAS f32x4*)(PRM + 5 * 512 + c4);
                kp[hh] = kv[nt] * (1.0f + (a - 1.0f) * ka);
                const f32x4 pr = rv[nt] * kp[hh] * rk; cbp += (pr[0] + pr[1]) + (pr[2] + pr[3]);
                nk[hh] = -kkn; nb[hh] = kkn * a;
            }
            st16_wt(sp + 1 * 64 + cl, PK8(kp[0], kp[1]));
            st16_wt(sp + 2 * 64 + cl, PK8(nk[0], nk[1]));
            st16_wt(sp + 3 * 64 + cl, PK8(nb[0], nb[1]));
        }
#undef PK8
        cbp += __shfl_xor(cbp, 16); cbp = xor32_add(cbp);
        if (fq == 0) cb[tok * 8 + h] = cbp;
    }
    __syncthreads();
}

__device__ __forceinline__ void red16x2(float& a, float& b) {
    a += dpp_f<0x140>(a); b += dpp_f<0x140>(b);
    a += dpp_f<0x141>(a); b += dpp_f<0x141>(b);
    a += dpp_f<0xB1>(a);  b += dpp_f<0xB1>(b);
    a += dpp_f<0x4E>(a);  b += dpp_f<0x4E>(b);
}
__device__ __forceinline__ void red16x4(float& a, float& b, float& c, float& d) {
    a += dpp_f<0x140>(a); b += dpp_f<0x140>(b); c += dpp_f<0x140>(c); d += dpp_f<0x140>(d);
    a += dpp_f<0x141>(a); b += dpp_f<0x141>(b); c += dpp_f<0x141>(c); d += dpp_f<0x141>(d);
    a += dpp_f<0xB1>(a);  b += dpp_f<0xB1>(b);  c += dpp_f<0xB1>(c);  d += dpp_f<0xB1>(d);
    a += dpp_f<0x4E>(a);  b += dpp_f<0x4E>(b);  c += dpp_f<0x4E>(c);  d += dpp_f<0x4E>(d);
}
__device__ __forceinline__ void scan_item(const Frame& F, int item) {
    const int bh = item >> 2, rq = item & 3, b = bh >> 3, h = bh & 7, lane = F.lane, wave = F.wave;
    const bf16_t* sc = (const bf16_t*)(F.ws + WS_SC) + (size_t)bh * SEQ * 384;
    float* Y = (float*)(F.ws + WS_Y);
    LAS float* buf = (LAS float*)F.lds;
    constexpr int CH = 32, NP = CH / 2, PSTR = 712, CHF = NP * PSTR;
    const int ltid = F.tid - 256;
    const int lpair = ltid >> 4, lsub = ltid & 15;
    u32x2 raw0A[6], raw1A[6], raw0B[6], raw1B[6];
#define SCAN_GL(S, c) do { const bf16_t* src_ = sc + ((size_t)(c) * CH + 2 * lpair) * 384 + lsub * 4; \
        _Pragma("unroll") for (int p = 0; p < 6; ++p) { raw0##S[p] = *(const u32x2*)(src_ + p * 64); raw1##S[p] = *(const u32x2*)(src_ + 384 + p * 64); } } while (0)
#define SCAN_LW(S, bi) do { LAS float* pp_ = buf + (bi) * CHF + lpair * PSTR; LAS float* dst_ = pp_ + lsub * 4; \
        f32x4 e0_ = unpack4(raw0##S[0]), k0_ = unpack4(raw0##S[1]), a0_ = unpack4(raw0##S[2]), b0_ = unpack4(raw0##S[3]), r0_ = unpack4(raw0##S[4]), v0_ = unpack4(raw0##S[5]); \
        f32x4 e1_ = unpack4(raw1##S[0]), k1_ = unpack4(raw1##S[1]), a1_ = unpack4(raw1##S[2]), b1_ = unpack4(raw1##S[3]), r1_ = unpack4(raw1##S[4]), v1_ = unpack4(raw1##S[5]); \
        f32x4 w0_, w1_; _Pragma("unroll") for (int k = 0; k < 4; ++k) { w0_[k] = __expf(-e0_[k]); w1_[k] = __expf(-e1_[k]); } \
        const f32x4 ba_ = b0_ * a1_, ka_ = k0_ * a1_, br_ = b0_ * r0_, kr_ = k0_ * r0_; \
        float s0_ = (ba_[0] + ba_[1]) + (ba_[2] + ba_[3]), s1_ = (ka_[0] + ka_[1]) + (ka_[2] + ka_[3]), s2_ = (br_[0] + br_[1]) + (br_[2] + br_[3]), s3_ = (kr_[0] + kr_[1]) + (kr_[2] + kr_[3]); \
        red16x4(s0_, s1_, s2_, s3_); \
        *(LAS f32x4*)(dst_) = a0_; *(LAS f32x4*)(dst_ + 64) = w0_ * a1_; *(LAS f32x4*)(dst_ + 128) = w0_ * r0_; *(LAS f32x4*)(dst_ + 192) = r1_; \
        *(LAS f32x4*)(dst_ + 256) = w0_ * w1_; *(LAS f32x4*)(dst_ + 320) = b0_ * w1_; *(LAS f32x4*)(dst_ + 384) = k0_ * w1_; *(LAS f32x4*)(dst_ + 448) = b1_; \
        *(LAS f32x4*)(dst_ + 512) = k1_; *(LAS f32x4*)(dst_ + 576) = v0_; *(LAS f32x4*)(dst_ + 640) = v1_; \
        if (lsub == 0) *(LAS f32x4*)(pp_ + 704) = (f32x4){s0_, s1_, s2_, s3_}; } while (0)
    if (wave >= 4) { SCAN_GL(A, 0); SCAN_GL(B, 1); SCAN_LW(A, 0); SCAN_GL(A, 2); }
    __syncthreads();
    const int l16 = lane & 15, rl = wave * 4 + (lane >> 4), row = rq * 16 + rl, c4 = l16 * 4;
    f32x2 s01 = (f32x2){0.f, 0.f}, s23 = s01;
    f32x4 rprev = (f32x4){0.f, 0.f, 0.f, 0.f};
    float ykeep = 0.f;
    LAS float* ybuf = buf + 2 * CHF;
    LAS float* ywr = ybuf + l16 * 16 + rl;
    float* yflush = Y + ((size_t)b * SEQ + (ltid >> 2)) * 512 + h * 64 + rq * 16 + (ltid & 3) * 4;
#define SCAN_FLUSH(f) do { if (ltid < 128) { const f32x4 yv_ = *(const LAS f32x4*)(ybuf + ((f) & 3) * 512 + (ltid >> 2) * 16 + (ltid & 3) * 4); st16_wt(yflush + (size_t)(f) * 32 * 512, __builtin_bit_cast(u32x4, yv_)); } } while (0)
#define DOT4(x) ({ f32x2 p_ = s01 * (f32x2){(x)[0], (x)[1]}; p_ = __builtin_elementwise_fma(s23, (f32x2){(x)[2], (x)[3]}, p_); p_[0] + p_[1]; })
#define LDP(P, q) const f32x4 P##a = *(const LAS f32x4*)((q) + c4), P##wa = *(const LAS f32x4*)((q) + 64 + c4), P##wr = *(const LAS f32x4*)((q) + 128 + c4), P##r1 = *(const LAS f32x4*)((q) + 192 + c4), \
        P##ww = *(const LAS f32x4*)((q) + 256 + c4), P##bw = *(const LAS f32x4*)((q) + 320 + c4), P##kw = *(const LAS f32x4*)((q) + 384 + c4), P##b1 = *(const LAS f32x4*)((q) + 448 + c4), \
        P##k1 = *(const LAS f32x4*)((q) + 512 + c4), P##sc = *(const LAS f32x4*)((q) + 704); const float P##v0 = (q)[576 + row], P##v1 = (q)[640 + row]
    for (int c = 0; c < SEQ / CH; ++c) {
        if (wave >= 4) {
            if (c + 1 < SEQ / CH) {
                if ((c + 1) & 1) { SCAN_LW(B, 1); if (c + 3 < SEQ / CH) SCAN_GL(B, c + 3); }
                else { SCAN_LW(A, 0); if (c + 3 < SEQ / CH) SCAN_GL(A, c + 3); }
            }
            if (c >= 2) SCAN_FLUSH(c - 2);
        }
        else {
            const LAS float* bp = buf + (c & 1) * CHF;
            f32x4 Ca, Cwa, Cwr, Cr1, Cww, Cbw, Ckw, Cb1, Ck1, Csc; float Cv0, Cv1;
            { LDP(T, bp); Ca = Ta; Cwa = Twa; Cwr = Twr; Cr1 = Tr1; Cww = Tww; Cbw = Tbw; Ckw = Tkw; Cb1 = Tb1; Ck1 = Tk1; Csc = Tsc; Cv0 = Tv0; Cv1 = Tv1; }
#pragma unroll 1
            for (int hb = 0; hb < 2; ++hb) {
#pragma unroll
                for (int i = 0; i < 8; ++i) {
                    const int p = hb * 8 + i;
                    const LAS float* qn = bp + ((p + 1 < NP) ? (p + 1) : (NP - 1)) * PSTR;
                    LDP(N, qn);
                    float d0 = DOT4(rprev), d1 = DOT4(Ca), d2 = DOT4(Cwa), d3 = DOT4(Cwr);
                    red16x4(d0, d1, d2, d3);
                    ykeep = (l16 == ((2 * i + 15) & 15)) ? d0 : ykeep;
                    if (i == 0) { const int blk = 2 * c + hb - 1; if (blk >= 0) ywr[((blk >> 1) & 3) * 512 + (blk & 1) * 256] = ykeep; }
                    const float sa0 = d1;
                    const float yt = __builtin_fmaf(sa0, Csc[2], __builtin_fmaf(Cv0, Csc[3], d3));
                    ykeep = (l16 == (2 * i)) ? yt : ykeep;
                    const float sa1 = __builtin_fmaf(sa0, Csc[0], __builtin_fmaf(Cv0, Csc[1], d2));
                    const f32x2 a0v = (f32x2){sa0, sa0}, a1v = (f32x2){sa1, sa1}, v0v = (f32x2){Cv0, Cv0}, v1v = (f32x2){Cv1, Cv1};
                    f32x2 t01 = (f32x2){Ckw[0], Ckw[1]} * v0v, t23 = (f32x2){Ckw[2], Ckw[3]} * v0v;
                    t01 = __builtin_elementwise_fma((f32x2){Cbw[0], Cbw[1]}, a0v, t01); t23 = __builtin_elementwise_fma((f32x2){Cbw[2], Cbw[3]}, a0v, t23);
                    t01 = __builtin_elementwise_fma((f32x2){Ck1[0], Ck1[1]}, v1v, t01); t23 = __builtin_elementwise_fma((f32x2){Ck1[2], Ck1[3]}, v1v, t23);
                    t01 = __builtin_elementwise_fma((f32x2){Cb1[0], Cb1[1]}, a1v, t01); t23 = __builtin_elementwise_fma((f32x2){Cb1[2], Cb1[3]}, a1v, t23);
                    s01 = __builtin_elementwise_fma(s01, (f32x2){Cww[0], Cww[1]}, t01); s23 = __builtin_elementwise_fma(s23, (f32x2){Cww[2], Cww[3]}, t23);
                    rprev = Cr1;
                    Ca = Na; Cwa = Nwa; Cwr = Nwr; Cr1 = Nr1; Cww = Nww; Cbw = Nbw; Ckw = Nkw; Cb1 = Nb1; Ck1 = Nk1; Csc = Nsc; Cv0 = Nv0; Cv1 = Nv1;
                }
            }
        }
        __syncthreads();
    }
    if (wave < 4) {
        float d0 = DOT4(rprev), z1 = 0.f, z2 = 0.f, z3 = 0.f; red16x4(d0, z1, z2, z3);
        ykeep = (l16 == 15) ? d0 : ykeep;
        ywr[3 * 512 + 256] = ykeep;
    }
    __syncthreads();
    if (wave >= 4) { SCAN_FLUSH(SEQ / CH - 2); SCAN_FLUSH(SEQ / CH - 1); }
    __syncthreads();
#undef SCAN_FLUSH
#undef SCAN_GL
#undef SCAN_LW
#undef DOT4
#undef LDP
}
__device__ __forceinline__ void post_rows(const Frame& F, int e) {
    const float* Y = (const float*)(F.ws + WS_Y); const bf16_t* sc = (const bf16_t*)(F.ws + WS_SC); const float* cb = (const float*)(F.ws + WS_CB);
    bf16_t* ymix = (bf16_t*)(F.ws + WS_YMIX);
    const float* lg = inp<23>() + e * 512; const float* lb = inp<24>() + e * 512;
    const int lane = F.lane, hh = lane >> 3;
    for (int tl = (F.bid >> 3) * 8 + F.wave; tl < SEQ; tl += F.G) {
        const int tok = (F.bid & 7) * SEQ + tl;
        const int b = tok / SEQ, t = tok % SEQ;
        const f32x4 y0 = *(const f32x4*)(Y + (size_t)tok * 512 + lane * 8), y1 = *(const f32x4*)(Y + (size_t)tok * 512 + lane * 8 + 4);
        float yv[8] = {y0[0], y0[1], y0[2], y0[3], y1[0], y1[1], y1[2], y1[3]};
        float s = 0.f;
#pragma unroll
        for (int k = 0; k < 8; ++k) s += yv[k];
        s += __shfl_xor(s, 1); s += __shfl_xor(s, 2); s += __shfl_xor(s, 4);
        const float mean = s * (1.0f / 64.0f); float qv = 0.f;
#pragma unroll
        for (int k = 0; k < 8; ++k) { yv[k] -= mean; qv += yv[k] * yv[k]; }
        qv += __shfl_xor(qv, 1); qv += __shfl_xor(qv, 2); qv += __shfl_xor(qv, 4);
        const float rstd = rsqrtf(qv * (1.0f / 64.0f) + 64e-5f);
        const u32x4 vr = *(const u32x4*)(sc + ((size_t)(b * 8 + hh) * SEQ + t) * 384 + 5 * 64 + (lane & 7) * 8);
        bf16_t* gp = ymix + (size_t)tok * DM + 512 + lane * 8;
        const u32x4 gr = *(const u32x4*)gp;
        const float cbv = cb[(size_t)tok * 8 + hh];
        float vv[8] = {bflo(vr.x), bfhi(vr.x), bflo(vr.y), bfhi(vr.y), bflo(vr.z), bfhi(vr.z), bflo(vr.w), bfhi(vr.w)};
        float gg[8] = {bflo(gr.x), bfhi(gr.x), bflo(gr.y), bfhi(gr.y), bflo(gr.z), bfhi(gr.z), bflo(gr.w), bfhi(gr.w)};
        float o[8];
#pragma unroll
        for (int k = 0; k < 8; ++k) o[k] = (yv[k] * rstd * lg[lane * 8 + k] + lb[lane * 8 + k] + cbv * vv[k]) * gg[k];
        u32x4 ow; ow.x = pk2(o[0], o[1]); ow.y = pk2(o[2], o[3]); ow.z = pk2(o[4], o[5]); ow.w = pk2(o[6], o[7]);
        st16_wt(gp, ow);
    }
}

__device__ __forceinline__ void conv_item(const Frame& F, int item, int o) {
    const int b = item >> 6, tt = item & 63, t0 = tt * 32, c = F.tid, lane = F.lane, wave = F.wave;
    const bf16_t* z = (const bf16_t*)(F.ws + WS_ACT);
    bf16_t* ymix = (bf16_t*)(F.ws + WS_YMIX);
    const float* cw = inp<31>() + (size_t)o * 31 * 512; const float* cbias = inp<32>() + o * 512;
    const float* lg = inp<33>() + o * 512; const float* lb = inp<34>() + o * 512;
    LAS float* co = (LAS float*)F.lds;
    const size_t tokb = (size_t)b * SEQ;
    float hv[62];
#pragma unroll
    for (int i = 0; i < 62; ++i) {
        const int t = t0 - 30 + i; float hval = 0.f;
        if (t >= 0) { const bf16_t* zp = z + (tokb + t) * POP + 416 + c; const float za = bf1(zp[0]), zg = bf1(zp[512]); hval = za * sigmoidf_(zg); }
        hv[i] = hval;
    }
    float wv[31];
#pragma unroll
    for (int k = 0; k < 31; ++k) wv[k] = cw[k * 512 + c];
    const float bias = cbias[c];
#pragma unroll
    for (int i = 0; i < 32; ++i) {
        float a = bias;
#pragma unroll
        for (int k = 0; k < 31; ++k) a += wv[k] * hv[i + k];
        co[i * 512 + c] = a;
    }
    {
        const int token = F.tid >> 4, i = F.tid & 15, t = t0 + token;
        const bf16_t* zp = z + (tokb + t) * POP + 384;
        const float x1 = bf1(zp[i]), x2 = bf1(zp[16 + i]);
        const float cs = ((const float*)(F.ws + WS_COS))[t * 16 + i], sn = ((const float*)(F.ws + WS_SIN))[t * 16 + i];
        bf16_t* kr = (bf16_t*)(F.ws + WS_SC + SC_KR) + (tokb + t) * 32;
        const int kp_ = 8 * (i >> 2) + (i & 3);
        kr[kp_] = (bf16_t)(pk2(x1 * cs - x2 * sn, 0.f) & 0xffffu); kr[kp_ + 4] = (bf16_t)(pk2(x1 * sn + x2 * cs, 0.f) & 0xffffu);
    }
    __syncthreads();
#pragma unroll
    for (int j = 0; j < 4; ++j) {
        const int ti = wave * 4 + j;
        const f32x4 v0 = *(const LAS f32x4*)(co + ti * 512 + lane * 8), v1 = *(const LAS f32x4*)(co + ti * 512 + lane * 8 + 4);
        float v[8] = {v0[0], v0[1], v0[2], v0[3], v1[0], v1[1], v1[2], v1[3]};
        float s = 0.f;
#pragma unroll
        for (int k = 0; k < 8; ++k) s += v[k];
        const float mean = wave_sum(s) * (1.0f / 512.0f); float qv = 0.f;
#pragma unroll
        for (int k = 0; k < 8; ++k) { v[k] -= mean; qv += v[k] * v[k]; }
        const float rstd = rsqrtf(wave_sum(qv) * (1.0f / 512.0f) + 1e-5f);
        float ov[8];
#pragma unroll
        for (int k = 0; k < 8; ++k) { const float y = v[k] * rstd * lg[lane * 8 + k] + lb[lane * 8 + k]; ov[k] = y * sigmoidf_(y); }
        u32x4 ow; ow.x = pk2(ov[0], ov[1]); ow.y = pk2(ov[2], ov[3]); ow.z = pk2(ov[4], ov[5]); ow.w = pk2(ov[6], ov[7]);
        st16_wt(ymix + (tokb + t0 + ti) * DM + 512 + lane * 8, ow);
    }
    __syncthreads();
}

constexpr int AT_KS = 104, AT_VS = 80, AT_KB = 64 * AT_KS * 2, AT_VB = 64 * AT_VS * 2, AT_BUF = AT_KB + AT_VB;
typedef short v4i16_t __attribute__((ext_vector_type(4)));
__device__ __forceinline__ void attn_unit(const Frame& F, int b, int h, int qb) {
    const int lane = F.lane, wave = F.wave, tid = F.tid, fr = lane & 15, fq = lane >> 4;
    const bf16_t* Q = (const bf16_t*)(F.ws + WS_SC + SC_Q); const bf16_t* KV = (const bf16_t*)(F.ws + WS_SC + SC_KV); const bf16_t* KR = (const bf16_t*)(F.ws + WS_SC + SC_KR);
    bf16_t* ymix = (bf16_t*)(F.ws + WS_YMIX);
    const size_t tokb = (size_t)b * SEQ;
    const int q0 = qb * 256 + wave * 32;
    const int ntb = 4 * qb + 4, ntw = 4 * qb + 1 + (wave >> 1);
    bf16x8 qf[2][3];
#pragma unroll
    for (int mt = 0; mt < 2; ++mt)
#pragma unroll
        for (int ks = 0; ks < 3; ++ks) qf[mt][ks] = *(const bf16x8*)(Q + (tokb + q0 + mt * 16 + fr) * 768 + h * 96 + ks * 32 + fq * 8);
    const int key0 = tid / 12, ch0 = tid % 12, key1 = (tid + 512) / 12, ch1 = (tid + 512) % 12;
    const bool has1 = tid < 256;
    const int vkey = tid >> 3, vch = tid & 7;
    const bf16_t* ksrc0 = (ch0 < 8) ? KV + (tokb + key0) * 1024 + h * 128 + ch0 * 8 : KR + (tokb + key0) * 32 + (ch0 - 8) * 8;
    const bf16_t* ksrc1 = (ch1 < 8) ? KV + (tokb + key1) * 1024 + h * 128 + ch1 * 8 : KR + (tokb + key1) * 32 + (ch1 - 8) * 8;
    const int kstr0 = (ch0 < 8) ? 64 * 1024 : 64 * 32, kstr1 = (ch1 < 8) ? 64 * 1024 : 64 * 32;
    const bf16_t* vsrc = KV + (tokb + vkey) * 1024 + h * 128 + 64 + vch * 8;
    const unsigned kdst0 = key0 * (AT_KS * 2) + ch0 * 16, kdst1 = key1 * (AT_KS * 2) + ch1 * 16;
    u32x4 rk0[2], rk1[2], rv[2];
#pragma unroll
    for (int k = 0; k < 2; ++k) { rk0[k] = (u32x4){0u, 0u, 0u, 0u}; rk1[k] = rk0[k]; rv[k] = rk0[k]; }
#define AT_GLOAD(j, st) do { rk0[st] = *(const u32x4*)(ksrc0 + (size_t)(j) * kstr0); if (has1) rk1[st] = *(const u32x4*)(ksrc1 + (size_t)(j) * kstr1); rv[st] = *(const u32x4*)(vsrc + (size_t)(j) * 64 * 1024); } while (0)
#define AT_LSTORE(bi, st) do { LAS unsigned char* kb_ = F.lds + (bi) * AT_BUF; LAS bf16_t* vb_ = (LAS bf16_t*)(kb_ + AT_KB); \
        *(LAS u32x4*)(kb_ + kdst0) = rk0[st]; if (has1) *(LAS u32x4*)(kb_ + kdst1) = rk1[st]; \
        *(LAS u32x4*)(vb_ + vkey * AT_VS + vch * 8) = rv[st]; } while (0)
    f32x4 o[2][4];
#pragma unroll
    for (int mt = 0; mt < 2; ++mt)
#pragma unroll
        for (int dt = 0; dt < 4; ++dt) o[mt][dt] = (f32x4){0.f, 0.f, 0.f, 0.f};
    float mrun[2] = {-INFINITY, -INFINITY}, lsum[2] = {0.f, 0.f};
#pragma unroll
    for (int k = 0; k < 2; ++k) AT_GLOAD(k, k);
    for (int j0 = 0; j0 < ntb; j0 += 2) {
      AT_LSTORE(j0 & 3, 0); AT_LSTORE((j0 & 3) + 1, 1);
      __syncthreads();
      if (j0 + 2 < ntb) { AT_GLOAD(j0 + 2, 0); AT_GLOAD(j0 + 3, 1); }
#pragma unroll
      for (int kk = 0; kk < 2; ++kk) {
        const int j = j0 + kk;
        if (j < ntw) {
            const LAS unsigned char* kb = F.lds + (j & 3) * AT_BUF; const LAS bf16_t* vb = (const LAS bf16_t*)(kb + AT_KB);
            f32x4 st[2][4];
#pragma unroll
            for (int kt = 0; kt < 4; ++kt) {
                st[0][kt] = (f32x4){0.f, 0.f, 0.f, 0.f}; st[1][kt] = st[0][kt];
#pragma unroll
                for (int ks = 0; ks < 3; ++ks) {
                    const bf16x8 X = *(const LAS bf16x8*)(kb + (kt * 16 + fr) * (AT_KS * 2) + (ks * 32 + fq * 8) * 2);
                    st[0][kt] = __builtin_amdgcn_mfma_f32_16x16x32_bf16(X, qf[0][ks], st[0][kt], 0, 0, 0);
                    st[1][kt] = __builtin_amdgcn_mfma_f32_16x16x32_bf16(X, qf[1][ks], st[1][kt], 0, 0, 0);
                }
            }
            bf16x8 Yp[2][2];
#pragma unroll
            for (int mt = 0; mt < 2; ++mt) {
                float mx = fmaxf(fmaxf(st[mt][0][0], st[mt][0][1]), fmaxf(st[mt][0][2], st[mt][0][3]));
#pragma unroll
                for (int kt = 1; kt < 4; ++kt) mx = fmaxf(mx, fmaxf(fmaxf(st[mt][kt][0], st[mt][kt][1]), fmaxf(st[mt][kt][2], st[mt][kt][3])));
                mx = fmaxf(mx, __shfl_xor(mx, 16)); mx = xor32_max(mx);
                const float mnew = fmaxf(mrun[mt], mx), alpha = __builtin_amdgcn_exp2f(mrun[mt] - mnew);
                mrun[mt] = mnew;
                float ps = 0.f;
#pragma unroll
                for (int kt = 0; kt < 4; ++kt)
#pragma unroll
                    for (int k = 0; k < 4; ++k) { st[mt][kt][k] = __builtin_amdgcn_exp2f(st[mt][kt][k] - mnew); ps += st[mt][kt][k]; }
                lsum[mt] = lsum[mt] * alpha + ps;
#pragma unroll
                for (int dt = 0; dt < 4; ++dt) o[mt][dt] = o[mt][dt] * alpha;
#pragma unroll
                for (int g2 = 0; g2 < 2; ++g2) {
                    u32x4 pw; pw.x = pk2(st[mt][2 * g2][0], st[mt][2 * g2][1]); pw.y = pk2(st[mt][2 * g2][2], st[mt][2 * g2][3]); pw.z = pk2(st[mt][2 * g2 + 1][0], st[mt][2 * g2 + 1][1]); pw.w = pk2(st[mt][2 * g2 + 1][2], st[mt][2 * g2 + 1][3]);
                    Yp[mt][g2] = __builtin_bit_cast(bf16x8, pw);
                }
            }
#pragma unroll
            for (int g2 = 0; g2 < 2; ++g2)
#pragma unroll
                for (int dt = 0; dt < 4; ++dt) {
                    const LAS bf16_t* vp = vb + (g2 * 32 + fq * 4 + (fr >> 2)) * AT_VS + 32 * (dt >> 1) + 8 * (fr & 3) + 4 * (dt & 1);
                    const v4i16_t lo = __builtin_amdgcn_ds_read_tr16_b64_v4i16((LAS v4i16_t*)vp), hi = __builtin_amdgcn_ds_read_tr16_b64_v4i16((LAS v4i16_t*)(vp + 16 * AT_VS));
                    const bf16x8 Xv = (bf16x8){lo[0], lo[1], lo[2], lo[3], hi[0], hi[1], hi[2], hi[3]};
                    o[0][dt] = __builtin_amdgcn_mfma_f32_16x16x32_bf16(Xv, Yp[0][g2], o[0][dt], 0, 0, 0);
                    o[1][dt] = __builtin_amdgcn_mfma_f32_16x16x32_bf16(Xv, Yp[1][g2], o[1][dt], 0, 0, 0);
                }
        }
      }
    }
#undef AT_GLOAD
#undef AT_LSTORE
#pragma unroll
    for (int mt = 0; mt < 2; ++mt) {
        float ls = lsum[mt]; ls += __shfl_xor(ls, 16); ls = xor32_add(ls);
        const float il = 1.0f / ls;
#pragma unroll
        for (int a2 = 0; a2 < 2; ++a2) { const u32x2 p0 = pack4(o[mt][2 * a2] * il), p1 = pack4(o[mt][2 * a2 + 1] * il);
            st16_wt(ymix + (tokb + q0 + mt * 16 + fr) * DM + h * 64 + 32 * a2 + 8 * fq, (u32x4){p0.x, p0.y, p1.x, p1.y}); }
    }
    __syncthreads();
}

constexpr int NPHASE = 1 + 9 * DEPTH + 1;
__global__ void __launch_bounds__(512, 2) mk_fwd(Args args) {
    extern __shared__ __attribute__((aligned(16))) unsigned char lds_raw[];
    Frame F;
    F.lds = (LAS unsigned char*)lds_raw;
    F.tid = threadIdx.x; F.lane = F.tid & 63; F.wave = __builtin_amdgcn_readfirstlane(F.tid >> 6);
    F.G = gridDim.x; F.bid = blockIdx.x; F.out = args.out; F.ws = args.ws;
    const int lo = args.ph_lo, hi = args.ph_hi;
    cg::grid_group grid = cg::this_grid();
    volatile LAS unsigned* bst = (volatile LAS unsigned*)(F.lds + 135168);
    if (threadIdx.x < 8) bst[threadIdx.x] = 0u;
    __syncthreads();
    XcdBarrier xbar = xcd_barrier_post((unsigned*)args.ws, bst);
    int vbid = blockIdx.x; bool regular = false;
#define IN(k) (lo <= (k) && (k) < hi)
#define ENTER() do { int t_ = threadIdx.x; int b_ = vbid; asm volatile("" : "+v"(t_), "+s"(b_)); F.tid = t_; F.lane = t_ & 63; F.wave = __builtin_amdgcn_readfirstlane(t_ >> 6); F.bid = b_; } while (0)
#define SEAM(k) do { if (IN(k) && IN((k) + 1)) { if (regular && (k) != 0 && (((k) - 1) % 9) != 8) xcd_local_barrier(xbar); else xcd_barrier(xbar); } } while (0)

    if (lo > hi) grid.sync();
    if (IN(0)) { ENTER(); { convert_layer(F, 0, 0, 1, F.bid, F.G); x_prologue(F); } }
    SEAM(0);
    if (IN(0) && IN(1)) {
        const unsigned reg_ = bst[2], rank_ = bst[3];
        regular = __builtin_amdgcn_readfirstlane((int)reg_) != 0;
        if (regular) vbid = __builtin_amdgcn_readfirstlane((int)(rank_ * 8u + xbar.x));
    }
    for (int l = 0; l < DEPTH; ++l) {
        const int p0 = 1 + 9 * l; const bool odd = l & 1; const int hl = l >> 1;
        size_t z0 = 0; asm volatile("" : "+s"(z0));
        unsigned char* ws = args.ws + z0;
        F.ws = ws;
        float* ssq = (float*)(ws + WS_SSQ);
        bf16_t* xb = (bf16_t*)(ws + WS_XB); bf16_t* ymix = (bf16_t*)(ws + WS_YMIX); bf16_t* act = (bf16_t*)(ws + WS_ACT);
        const unsigned char* wb = ws + WS_WBUF0 + (size_t)(l & 1) * WBUF_BYTES;
        if (IN(p0 + 0)) {
            ENTER();
            pg8::Gemm g{xb, (const bf16_t*)(wb + WB_W1IN), T, 2 * FF, DM, DM, DM}; pg8::StaticOrder S; S.init(T, 2 * FF, F.G, F.bid);
            EpiSwiGLU E{act, ssq}; pg8::gemm_phase(F.lds, g, S, E);
            ENTER();
            if (l + 1 < DEPTH) {
                const int nfull = ((T / 256) * (2 * FF / 256)) % F.G;
                if (nfull == 0) { __syncthreads(); convert_layer(F, l + 1, 0, 2, F.bid, F.G); }
                else if (F.bid >= nfull) { __syncthreads(); convert_layer(F, l + 1, 0, 2, F.bid - nfull, F.G - nfull); }
            }
        }
        SEAM(p0 + 0);
        if (IN(p0 + 1)) {
            ENTER();
            pg8::Gemm g{act, (const bf16_t*)(wb + WB_W1OUT), T, DM, FF, FF, FF}; pg8::StaticOrder S; S.init(T, DM, F.G, F.bid);
            EpiResid E{xb, ssq, 0.5f}; pg8::gemm_phase(F.lds, g, S, E);
        }
        SEAM(p0 + 1);
        if (IN(p0 + 2)) {
            ENTER();
            if (odd) { pg8::Gemm g{xb, (const bf16_t*)(wb + WB_WMIN), T, POP, DM, DM, DM}; pg8::StaticOrder S; S.init(T, POP, F.G, F.bid);
                EpiZ<true> E{act, POP, ssq, (float*)(ws + WS_PQ), (float*)(ws + WS_PKV)}; pg8::gemm_phase(F.lds, g, S, E); }
            else { pg8::Gemm g{xb, (const bf16_t*)(wb + WB_WMIN), T, PE, DM, DM, DM}; pg8::StaticOrder S; S.init(T, PE, F.G, F.bid);
                EpiZ<false> E{act, PE, ssq, nullptr, nullptr}; pg8::gemm_phase(F.lds, g, S, E); }
        }
        SEAM(p0 + 2);
        if (IN(p0 + 3)) {
            ENTER();
            if (odd) {
                pg8::Gemm g{act, (const bf16_t*)(wb + WB_WX), T, 1792, 384, POP, 384}; pg8::StaticOrder S; S.init(T, 1792, F.G, F.bid);
                EpiUp E{(bf16_t*)(ws + WS_SC + SC_Q), (bf16_t*)(ws + WS_SC + SC_KV), (const float*)(ws + WS_PQ), (const float*)(ws + WS_PKV), (const float*)(ws + WS_COS), (const float*)(ws + WS_SIN)};
                pg8::gemm_phase(F.lds, g, S, E);
                __syncthreads();
                ENTER();
                for (int j = F.bid >> 3; j < 64; j += F.G >> 3) conv_item(F, (F.bid & 7) * 64 + j, hl);
            } else {
                for (int j = F.bid >> 3; j < 64; j += F.G >> 3) prep_item(F, (F.bid & 7) * 64 + j, hl, wb, j == (F.bid >> 3));
                for (int j = F.bid >> 3; j < 64; j += F.G >> 3) gsu_item(F, (F.bid & 7) * 64 + j, hl);
            }
        }
        SEAM(p0 + 3);
        if (IN(p0 + 4)) {
            ENTER();
            if (odd) {
                for (int j = F.bid >> 3; j < 32; j += F.G >> 3) {
                    const int bh = (F.bid & 7) * 8 + (j & 7), pr = j >> 3;
                    attn_unit(F, bh >> 3, bh & 7, pr);
                    attn_unit(F, bh >> 3, bh & 7, 7 - pr);
                }
            } else {
                for (int j = F.bid >> 3; j < 32; j += F.G >> 3) scan_item(F, (F.bid & 7) * 32 + j);
            }
        }
        SEAM(p0 + 4);
        if (IN(p0 + 5)) { ENTER(); if (!odd) post_rows(F, hl); }
        if (!odd) SEAM(p0 + 5);
        if (IN(p0 + 6)) {
            ENTER();
            pg8::Gemm g{ymix, (const bf16_t*)(wb + WB_WMOUT), T, DM, DM, DM, DM}; pg8::StaticOrder S; S.init(T, DM, F.G, F.bid);
            EpiResid E{xb, ssq, 1.0f}; pg8::gemm_phase(F.lds, g, S, E);
        }
        SEAM(p0 + 6);
        if (IN(p0 + 7)) {
            ENTER();
            pg8::Gemm g{xb, (const bf16_t*)(wb + WB_W2IN), T, 2 * FF, DM, DM, DM}; pg8::StaticOrder S; S.init(T, 2 * FF, F.G, F.bid);
            EpiSwiGLU E{act, ssq}; pg8::gemm_phase(F.lds, g, S, E);
            ENTER();
            if (l + 1 < DEPTH) {
                const int nfull = ((T / 256) * (2 * FF / 256)) % F.G;
                if (nfull == 0) { __syncthreads(); convert_layer(F, l + 1, 1, 2, F.bid, F.G); }
                else if (F.bid >= nfull) { __syncthreads(); convert_layer(F, l + 1, 1, 2, F.bid - nfull, F.G - nfull); }
            }
        }
        SEAM(p0 + 7);
        if (IN(p0 + 8)) {
            ENTER();
            pg8::Gemm g{act, (const bf16_t*)(wb + WB_W2OUT), T, DM, FF, FF, FF}; pg8::StaticOrder S; S.init(T, DM, F.G, F.bid);
            EpiResid E{xb, ssq, 0.5f}; pg8::gemm_phase(F.lds, g, S, E);
        }
        SEAM(p0 + 8);
    }
    if (IN(NPHASE - 1)) { ENTER(); final_norm(F); }
#undef IN
#undef SEAM
#undef ENTER
}

extern "C" void kernel_launch(void* const* d_in, const int* in_sizes, int n_in, void* d_out, int out_size, void* d_ws, size_t ws_size, hipStream_t stream) {
    static int grid = 0;
    if (grid == 0) {
        if (n_in != 36 || out_size != T * DM || ws_size < WS_END) { fprintf(stderr, "kernel_launch: unexpected shapes (n_in %d out %d ws %zu)\n", n_in, out_size, ws_size); grid = -1; return; }
        int dev = 0, cus = 0, per_cu = 0;
        (void)hipGetDevice(&dev); (void)hipDeviceGetAttribute(&cus, hipDeviceAttributeMultiprocessorCount, dev);
        (void)hipFuncSetAttribute((const void*)mk_fwd, hipFuncAttributeMaxDynamicSharedMemorySize, LDS_BYTES);
        (void)hipOccupancyMaxActiveBlocksPerMultiprocessor(&per_cu, (const void*)mk_fwd, 512, LDS_BYTES);
        if (per_cu < 1) per_cu = 1;
        grid = cus * per_cu; if (grid > 256) grid = 256; if (grid < 1) grid = 256;
        (void)hipGetLastError();
    }
    if (grid < 0) return;
    (void)hipMemsetAsync(d_ws, 0, 32768, stream);
    Args a{};
    for (int i = 0; i < 36; ++i) a.in[i] = (const float*)d_in[i];
    a.out = (float*)d_out; a.ws = (unsigned char*)d_ws;
#if MK_MULTI
    for (int p = 0; p < NPHASE; ++p) {
        if (p >= 1 && p < NPHASE - 1) { const int l = (p - 1) / 9, k = (p - 1) % 9; if ((l & 1) && k == 5) continue; }
        a.ph_lo = p; a.ph_hi = p + 1;
        hipLaunchKernelGGL(mk_fwd, dim3(grid), dim3(512), LDS_BYTES, stream, a);
    }
#else
    a.ph_lo = 0; a.ph_hi = NPHASE;
    void* kargs[] = {&a};
    hipError_t e = hipLaunchCooperativeKernel((const void*)mk_fwd, dim3(grid), dim3(512), kargs, LDS_BYTES, stream);
    if (e != hipSuccess) fprintf(stderr, "cooperative launch failed: %s (grid %d)\n", hipGetErrorString(e), grid);
#endif
}
```

```cpp
#include <hip/hip_runtime.h>
#include <hip/hip_cooperative_groups.h>
#include <cstdio>
#include <cstdint>
namespace cg = cooperative_groups;

#ifndef MK_MULTI
#define MK_MULTI 0
#endif

#define LAS __attribute__((address_space(3)))
typedef unsigned short bf16_t;
typedef short bf16x8 __attribute__((ext_vector_type(8)));
typedef float f32x4 __attribute__((ext_vector_type(4)));
typedef float f32x2 __attribute__((ext_vector_type(2)));
typedef unsigned u32x4 __attribute__((ext_vector_type(4)));
typedef unsigned u32x2 __attribute__((ext_vector_type(2)));
typedef __bf16 bf16x2_t __attribute__((ext_vector_type(2)));

constexpr int T = 16384, DM = 1024, FF = 2816, SEQ = 2048, NBATCH = 8, DEPTH = 4;
constexpr int PE = 2816, PO = 1440, POP = 1536;
constexpr int PB = 1792;
constexpr float RMS_EPS = 1e-6f;
constexpr float QSCALE = 0.10206207261596575f * 1.4426950408889634f;

constexpr size_t MiB = 1u << 20;
constexpr size_t WS_SSQ = 1 * MiB;
constexpr size_t WS_PQ = 2 * MiB;
constexpr size_t WS_PKV = 2 * MiB + 256 * 1024;
constexpr size_t WS_COS = 2 * MiB + 512 * 1024;
constexpr size_t WS_SIN = 2 * MiB + 640 * 1024;
constexpr size_t WS_CB = 3 * MiB;
constexpr size_t WS_WBUF0 = 4 * MiB, WBUF_BYTES = 42 * MiB;
constexpr size_t WS_XB = 88 * MiB;
constexpr size_t WS_YMIX = 120 * MiB;
constexpr size_t WS_ACT = 152 * MiB;
constexpr size_t WS_SC = 240 * MiB;
constexpr size_t WS_Y = 336 * MiB;
constexpr size_t WS_END = 368 * MiB;
constexpr size_t WB_W1IN = 0, WB_W1OUT = 11534336, WB_W2IN = 17301504, WB_W2OUT = 28835840, WB_WMIN = 34603008, WB_WMOUT = 40370176, WB_WX = 42467328;
constexpr size_t SC_Q = 0, SC_KV = 24 * MiB, SC_KR = 56 * MiB;

constexpr int LDS_BYTES = 147456;

__device__ __forceinline__ unsigned pk2(float lo, float hi) { f32x2 v = {lo, hi}; bf16x2_t b = __builtin_convertvector(v, bf16x2_t); return __builtin_bit_cast(unsigned, b); }
__device__ __forceinline__ float bflo(unsigned u) { return __uint_as_float(u << 16); }
__device__ __forceinline__ float bfhi(unsigned u) { return __uint_as_float(u & 0xffff0000u); }
__device__ __forceinline__ float bf1(bf16_t h) { return __uint_as_float((unsigned)h << 16); }
__device__ __forceinline__ f32x4 unpack4(u32x2 u) { return (f32x4){bflo(u.x), bfhi(u.x), bflo(u.y), bfhi(u.y)}; }
__device__ __forceinline__ u32x2 pack4(f32x4 v) { u32x2 r; r.x = pk2(v[0], v[1]); r.y = pk2(v[2], v[3]); return r; }
template <int CTRL> __device__ __forceinline__ float dpp_f(float x) { return __int_as_float(__builtin_amdgcn_update_dpp(0, __float_as_int(x), CTRL, 0xF, 0xF, true)); }
__device__ __forceinline__ float red16(float x) {
    x += dpp_f<0x140>(x);
    x += dpp_f<0x141>(x);
    x += dpp_f<0xB1>(x);
    x += dpp_f<0x4E>(x);
    return x;
}
__device__ __forceinline__ void st16_wt(void* p, u32x4 v) { asm volatile("global_store_dwordx4 %0, %1, off\n\ts_nop 1" :: "v"(p), "v"(v) : "memory"); }
__device__ __forceinline__ void st8_wt(void* p, u32x2 v) { asm volatile("global_store_dwordx2 %0, %1, off" :: "v"(p), "v"(v) : "memory"); }
__device__ __forceinline__ float xor32_add(float x) { auto rr = __builtin_amdgcn_permlane32_swap(__float_as_uint(x), __float_as_uint(x), false, false); return __uint_as_float(rr[0]) + __uint_as_float(rr[1]); }
__device__ __forceinline__ float xor32_max(float x) { auto rr = __builtin_amdgcn_permlane32_swap(__float_as_uint(x), __float_as_uint(x), false, false); return fmaxf(__uint_as_float(rr[0]), __uint_as_float(rr[1])); }
__device__ __forceinline__ float wave_sum(float v) {
    v = red16(v);
    v += __shfl_xor(v, 16); v = xor32_add(v);
    return v;
}
__device__ __forceinline__ float sigmoidf_(float x) { return __builtin_amdgcn_rcpf(1.0f + __expf(-x)); }
__device__ __forceinline__ float gelu_tanh(float x) { const float u = 1.5957691216057308f * (x + 0.044715f * x * x * x); return x * __builtin_amdgcn_rcpf(1.0f + __expf(-u)); }
__device__ __forceinline__ float tanh_(float x) { return 1.0f - 2.0f * __builtin_amdgcn_rcpf(1.0f + __expf(2.0f * x)); }

namespace pg8 {
constexpr int BM = 256, BK = 64, HALF = 128, HTB = HALF * BK * 2, STAGE_BYTES = 8 * HTB, NXCD = 8, WGM = 8;
__host__ __device__ __forceinline__ int lds_byte(int r, int c) { const int st = (r >> 4) * 2 + (c >> 5), rr = r & 15, cc = c & 31, ob = rr * 64 + cc * 2; return st * 1024 + (ob ^ (((ob >> 9) & 1) << 5)); }
__host__ __device__ __forceinline__ int perm32(int rho) { const int n = rho >> 4, i = rho & 15; return 8 * (i >> 2) + 4 * n + (i & 3); }
__host__ __device__ __forceinline__ void stage_rc(int b, int& R, int& C) { const int st = b / 1024, sb = b % 1024, swz = sb ^ (((sb >> 9) & 1) << 5); R = (st >> 1) * 16 + swz / 64; C = (st & 1) * 32 + (swz % 64) / 2; }
struct Unit { int pm, pn; };
struct Gemm { const bf16_t* A; const bf16_t* Bt; int M, N, K, lda, ldb; };
struct StaticOrder {
    int nM, nN, nwg, G, c;
    __device__ void init(int M, int N, int G_, int c_) { nM = M / BM; nN = N / BM; nwg = nM * nN; G = G_; c = c_; }
    __device__ bool next(int i, Unit& u) const {
        const int L = i * G + c; if (L >= nwg) return false;
        int wgid = L; { const int q = nwg / NXCD, r = nwg % NXCD, xcd = wgid % NXCD, off = wgid / NXCD; wgid = (xcd < r ? xcd * (q + 1) : r * (q + 1) + (xcd - r) * q) + off; }
        const int nig = WGM * nN, gid = wgid / nig, fm = gid * WGM, gsz = (nM - fm) < WGM ? (nM - fm) : WGM;
        u.pm = fm + ((wgid % nig) % gsz); u.pn = (wgid % nig) / gsz; return true;
    }
};
template <class Epi>
__device__ __forceinline__ void gemm_phase(LAS unsigned char* lds, const Gemm g, const StaticOrder& S, const Epi& E) {
    int tid_ = threadIdx.x; asm volatile("" : "+v"(tid_));
    const int tid = tid_, wid = __builtin_amdgcn_readfirstlane(tid >> 6), lane = tid & 63, wr = wid >> 2, wc = wid & 3, fr = lane & 15, fq = lane >> 4;
    const int K = g.K, nt = K / BK;
    unsigned voffA[2], voffB[2];
#pragma unroll
    for (int i = 0; i < 2; ++i) { int R, C; stage_rc(tid * 16 + i * 8192, R, C); const int Rb = Epi::PERM ? ((R & ~31) + perm32(R & 31)) : R; voffA[i] = (unsigned)(R * g.lda + C) * 2u; voffB[i] = (unsigned)(Rb * g.ldb + C) * 2u; }
    const size_t kstep = (size_t)(BK * 2);
    const size_t hsA = (size_t)HALF * g.lda * 2, hsB = (size_t)HALF * g.ldb * 2;
    const size_t tsA = 2 * hsA, tsB = 2 * hsB;
    const unsigned ldsw = (unsigned)wid * 1024u;
    const int aoff = lds_byte(wr * 64 + fr, fq * 8), boff = lds_byte(wc * 32 + fr, fq * 8);
#define PG8_SA(b, h) (((b) * 2 + (h)) * HTB)
#define PG8_SB(b, h) ((4 + (b) * 2 + (h)) * HTB)
#define PG8_STAGE(bufoff, gbase, voff) do { _Pragma("unroll") for (int _i = 0; _i < 2; ++_i) \
        __builtin_amdgcn_global_load_lds((const unsigned*)((const char*)(gbase) + (voff)[_i]), (LAS unsigned*)(lds + (bufoff) + ldsw + _i * 8192), 16, 0, 0); } while (0)
#define PG8_LDA(dst, b, h) do { _Pragma("unroll") for (int m = 0; m < 4; ++m) _Pragma("unroll") for (int k = 0; k < 2; ++k) dst[m][k] = *(const LAS bf16x8*)(lds + PG8_SA(b, h) + aoff + m * 2048 + k * 1024); } while (0)
#define PG8_LDB(dst, b, h) do { _Pragma("unroll") for (int n = 0; n < 2; ++n) _Pragma("unroll") for (int k = 0; k < 2; ++k) dst[n][k] = *(const LAS bf16x8*)(lds + PG8_SB(b, h) + boff + n * 2048 + k * 1024); } while (0)
#define PG8_MMA(ai, bj, At, Bt) do { __builtin_amdgcn_s_setprio(1); _Pragma("unroll") for (int m = 0; m < 4; ++m) _Pragma("unroll") for (int n = 0; n < 2; ++n) _Pragma("unroll") for (int k = 0; k < 2; ++k) \
        acc[ai][bj][m][n] = __builtin_amdgcn_mfma_f32_16x16x32_bf16(Bt[n][k], At[m][k], acc[ai][bj][m][n], 0, 0, 0); __builtin_amdgcn_s_setprio(0); } while (0)
#define PG8_WAIT_V(n) asm volatile("s_waitcnt vmcnt(" #n ")" ::: "memory")
#define PG8_WAIT_L(n) asm volatile("s_waitcnt lgkmcnt(" #n ")" ::: "memory")
#define PG8_BAR __builtin_amdgcn_s_barrier()
#define PG8_SCHED __builtin_amdgcn_sched_barrier(0)
    Unit cur, nxt; int ui = 0;
    if (!S.next(0, cur)) return;
    f32x4 acc[2][2][4][2];
#pragma unroll
    for (int a = 0; a < 2; ++a)
#pragma unroll
        for (int b = 0; b < 2; ++b)
#pragma unroll
            for (int m = 0; m < 4; ++m)
#pragma unroll
                for (int n = 0; n < 2; ++n) acc[a][b][m][n] = (f32x4){0.f, 0.f, 0.f, 0.f};
    bf16x8 At[4][2], B0[2][2], B1[2][2];
    const char* cA = (const char*)g.A + (size_t)cur.pm * tsA; const char* cB = (const char*)g.Bt + (size_t)cur.pn * tsB;
    PG8_STAGE(PG8_SB(0, 0), cB, voffB); PG8_STAGE(PG8_SB(0, 1), cB + hsB, voffB); PG8_STAGE(PG8_SA(0, 0), cA, voffA); PG8_STAGE(PG8_SA(0, 1), cA + hsA, voffA);
    if (wr == 1) PG8_BAR;
    PG8_WAIT_V(2); PG8_BAR;
    PG8_STAGE(PG8_SB(1, 0), cB + kstep, voffB); PG8_STAGE(PG8_SA(1, 0), cA + kstep, voffA); PG8_STAGE(PG8_SB(1, 1), cB + hsB + kstep, voffB);
    PG8_WAIT_V(6); PG8_BAR;
    for (;;) {
        const bool has_next = S.next(ui + 1, nxt);
        const char* nA = has_next ? (const char*)g.A + (size_t)nxt.pm * tsA : cA; const char* nB = has_next ? (const char*)g.Bt + (size_t)nxt.pn * tsB : cB;
#pragma unroll 1
        for (int t = 0; t < nt; t += 2) {
            const bool last = (t == nt - 2);
            const char* a1 = cA + (size_t)(t + 1) * kstep;
            const char* a2 = last ? nA : cA + (size_t)(t + 2) * kstep; const char* b2 = last ? nB : cB + (size_t)(t + 2) * kstep;
            const char* a3 = a2 + kstep; const char* b3 = b2 + kstep;
            PG8_LDB(B0, 0, 0); PG8_LDB(B1, 0, 1); PG8_SCHED; PG8_LDA(At, 0, 0); PG8_STAGE(PG8_SA(1, 1), a1 + hsA, voffA);
            PG8_WAIT_V(8); PG8_WAIT_L(0); PG8_BAR; PG8_MMA(0, 0, At, B0); PG8_MMA(0, 1, At, B1); PG8_BAR; PG8_SCHED;
            PG8_LDA(At, 0, 1); PG8_STAGE(PG8_SB(0, 0), b2, voffB); PG8_STAGE(PG8_SB(0, 1), b2 + hsB, voffB); PG8_STAGE(PG8_SA(0, 0), a2, voffA);
            PG8_WAIT_V(8); PG8_WAIT_L(0); PG8_BAR; PG8_MMA(1, 0, At, B0); PG8_MMA(1, 1, At, B1); PG8_BAR; PG8_SCHED;
            PG8_LDB(B0, 1, 0); PG8_LDB(B1, 1, 1); PG8_SCHED; PG8_LDA(At, 1, 0); PG8_STAGE(PG8_SA(0, 1), a2 + hsA, voffA);
            PG8_WAIT_V(8); PG8_WAIT_L(0); PG8_BAR; PG8_MMA(0, 0, At, B0); PG8_MMA(0, 1, At, B1); PG8_BAR; PG8_SCHED;
            PG8_LDA(At, 1, 1); PG8_STAGE(PG8_SB(1, 0), b3, voffB); PG8_STAGE(PG8_SB(1, 1), b3 + hsB, voffB); PG8_STAGE(PG8_SA(1, 0), a3, voffA);
            PG8_WAIT_V(8); PG8_WAIT_L(0); PG8_BAR; PG8_MMA(1, 0, At, B0); PG8_MMA(1, 1, At, B1); PG8_BAR; PG8_SCHED;
        }
        if (wr == 0) PG8_BAR;
        E(acc, cur, wr, wc, fr, fq);
        if (!has_next) break;
#pragma unroll
        for (int a = 0; a < 2; ++a)
#pragma unroll
            for (int b = 0; b < 2; ++b)
#pragma unroll
                for (int m = 0; m < 4; ++m)
#pragma unroll
                    for (int n = 0; n < 2; ++n) acc[a][b][m][n] = (f32x4){0.f, 0.f, 0.f, 0.f};
        cur = nxt; cA = nA; cB = nB; ++ui;
        if (wr == 1) PG8_BAR;
    }
    PG8_WAIT_V(0);
    PG8_BAR;
#undef PG8_SA
#undef PG8_SB
#undef PG8_STAGE
#undef PG8_LDA
#undef PG8_LDB
#undef PG8_MMA
#undef PG8_WAIT_V
#undef PG8_WAIT_L
#undef PG8_BAR
#undef PG8_SCHED
}
}
using pg8::Unit;

__device__ __forceinline__ void rows_rstd16(const float* ssq, int row0, int fq, float (&rs)[8]) {
    float p[8][4];
#pragma unroll
    for (int i = 0; i < 8; ++i) { const unsigned o = (unsigned)(4 * fq) * T + row0 + (i >> 2) * 128 + (i & 3) * 16;
#pragma unroll
        for (int k = 0; k < 4; ++k) p[i][k] = ssq[o + k * T]; }
#pragma unroll
    for (int i = 0; i < 8; ++i) { float s = (p[i][0] + p[i][1]) + (p[i][2] + p[i][3]); s += __shfl_xor(s, 16); s = xor32_add(s); rs[i] = rsqrtf(s * (1.0f / 1024.0f) + RMS_EPS); }
}
__device__ __forceinline__ void rows_rstd4(const float* pp, int row0, int fq, float invw, float mul, float (&rs)[8]) {
    float p[8];
#pragma unroll
    for (int i = 0; i < 8; ++i) p[i] = pp[(unsigned)fq * T + (unsigned)(row0 + (i >> 2) * 128 + (i & 3) * 16)];
#pragma unroll
    for (int i = 0; i < 8; ++i) { float s = p[i]; s += __shfl_xor(s, 16); s = xor32_add(s); rs[i] = rsqrtf(s * invw + RMS_EPS) * mul; }
}

struct EpiSwiGLU {
    static constexpr bool PERM = false;
    bf16_t* act; const float* ssq;
    __device__ __forceinline__ void operator()(const f32x4 (&acc)[2][2][4][2], const Unit& u, int wr, int wc, int fr, int fq) const {
        const int row0 = u.pm * 256 + wr * 64 + fr;
        const unsigned off0 = (unsigned)row0 * FF + u.pn * 128 + wc * 32 + fq * 8;
        float rsv[8]; rows_rstd16(ssq, row0, fq, rsv);
#pragma unroll
        for (int ai = 0; ai < 2; ++ai)
#pragma unroll
            for (int m = 0; m < 4; ++m) {
                const float rs = rsv[ai * 4 + m];
                u32x4 w;
#pragma unroll
                for (int bj = 0; bj < 2; ++bj) {
                    const f32x4 gt = acc[ai][bj][m][0] * rs, up = acc[ai][bj][m][1] * rs; f32x4 o;
#pragma unroll
                    for (int k = 0; k < 4; ++k) o[k] = gt[k] * up[k] * __builtin_amdgcn_rcpf(1.0f + __expf(-gt[k]));
                    const u32x2 pw = pack4(o); if (bj == 0) { w.x = pw.x; w.y = pw.y; } else { w.z = pw.x; w.w = pw.y; }
                }
                st16_wt(act + (off0 + (unsigned)((ai * 128 + m * 16) * FF)), w);
            }
    }
};
struct EpiResid {
    static constexpr bool PERM = true;
    bf16_t* xb; float* ssq; float scale;
    __device__ __forceinline__ void operator()(const f32x4 (&acc)[2][2][4][2], const Unit& u, int wr, int wc, int fr, int fq) const {
        const int row0 = u.pm * 256 + wr * 64 + fr;
        const unsigned off0 = (unsigned)row0 * DM + u.pn * 256 + wc * 32 + fq * 8;
        const unsigned so = (unsigned)(u.pn * 4 + wc) * T + row0;
#pragma unroll
        for (int ai = 0; ai < 2; ++ai) {
            u32x4 bv[4][2];
#pragma unroll
            for (int m = 0; m < 4; ++m)
#pragma unroll
                for (int bj = 0; bj < 2; ++bj) bv[m][bj] = *(const u32x4*)(xb + (off0 + (unsigned)((ai * 128 + m * 16) * DM + bj * 128)));
#pragma unroll
            for (int m = 0; m < 4; ++m) {
                float ss = 0.f;
#pragma unroll
                for (int bj = 0; bj < 2; ++bj) {
                    const unsigned o2 = off0 + (unsigned)((ai * 128 + m * 16) * DM + bj * 128);
                    const f32x4 v0 = unpack4((u32x2){bv[m][bj].x, bv[m][bj].y}) + acc[ai][bj][m][0] * scale;
                    const f32x4 v1 = unpack4((u32x2){bv[m][bj].z, bv[m][bj].w}) + acc[ai][bj][m][1] * scale;
                    const u32x2 p0 = pack4(v0), p1 = pack4(v1);
                    st16_wt(xb + o2, (u32x4){p0.x, p0.y, p1.x, p1.y});
                    ss += ((v0[0] * v0[0] + v0[1] * v0[1]) + (v0[2] * v0[2] + v0[3] * v0[3])) + ((v1[0] * v1[0] + v1[1] * v1[1]) + (v1[2] * v1[2] + v1[3] * v1[3]));
                }
                ss += __shfl_xor(ss, 16); ss = xor32_add(ss);
                if (fq == 0) ssq[so + (unsigned)(ai * 128 + m * 16)] = ss;
            }
            asm volatile("" ::: "memory");
        }
    }
};
template <bool ODD> struct EpiZ {
    static constexpr bool PERM = true;
    bf16_t* z; int ldz; const float* ssq; float* pq; float* pkv;
    __device__ __forceinline__ void operator()(const f32x4 (&acc)[2][2][4][2], const Unit& u, int wr, int wc, int fr, int fq) const {
        const int row0 = u.pm * 256 + wr * 64 + fr;
        const unsigned off0 = (unsigned)row0 * ldz + u.pn * 256 + wc * 32 + fq * 8;
        float rsv[8]; rows_rstd16(ssq, row0, fq, rsv);
#pragma unroll
        for (int ai = 0; ai < 2; ++ai)
#pragma unroll
            for (int m = 0; m < 4; ++m) {
                const int row = row0 + ai * 128 + m * 16;
                const float rs = rsv[ai * 4 + m];
                float s0 = 0.f, s1 = 0.f;
#pragma unroll
                for (int bj = 0; bj < 2; ++bj) {
                    const f32x4 v0 = acc[ai][bj][m][0] * rs, v1 = acc[ai][bj][m][1] * rs;
                    const u32x2 p0 = pack4(v0), p1 = pack4(v1);
                    st16_wt(z + (off0 + (unsigned)((ai * 128 + m * 16) * ldz + bj * 128)), (u32x4){p0.x, p0.y, p1.x, p1.y});
                    const float q = ((v0[0] * v0[0] + v0[1] * v0[1]) + (v0[2] * v0[2] + v0[3] * v0[3])) + ((v1[0] * v1[0] + v1[1] * v1[1]) + (v1[2] * v1[2] + v1[3] * v1[3]));
                    if (bj == 0) s0 += q; else s1 += q;
                }
                if (ODD) {
                    if (u.pn == 0) { float s = s0 + s1; s += __shfl_xor(s, 16); s = xor32_add(s); if (fq == 0) pq[(unsigned)wc * T + row] = s; }
                    else if (u.pn == 1) { float s = s0; s += __shfl_xor(s, 16); s = xor32_add(s); if (fq == 0) pkv[(unsigned)wc * T + row] = s; }
                }
            }
    }
};
struct EpiUp {
    static constexpr bool PERM = true;
    bf16_t* q; bf16_t* kv; const float* pq; const float* pkv; const float* cosT; const float* sinT;
    __device__ __forceinline__ void operator()(const f32x4 (&acc)[2][2][4][2], const Unit& u, int wr, int wc, int fr, int fq) const {
        const int row0 = u.pm * 256 + wr * 64 + fr;
        float rsv[8];
        if (u.pn < 3) {
            rows_rstd4(pq, row0, fq, 1.0f / 256.0f, QSCALE, rsv);
#pragma unroll
            for (int bj = 0; bj < 2; ++bj) {
                const int G = u.pn * 8 + bj * 4 + wc;
                const bool rope = (G % 3) == 2;
#pragma unroll
                for (int ai = 0; ai < 2; ++ai)
#pragma unroll
                    for (int m = 0; m < 4; ++m) {
                        const int row = row0 + ai * 128 + m * 16; const float rs = rsv[ai * 4 + m];
                        f32x4 v0 = acc[ai][bj][m][0] * rs, v1 = acc[ai][bj][m][1] * rs;
                        if (rope) {
                            const int pos = row & (SEQ - 1);
                            const f32x4 c4 = *(const f32x4*)(cosT + (unsigned)(pos * 16 + fq * 4)), s4 = *(const f32x4*)(sinT + (unsigned)(pos * 16 + fq * 4));
                            const f32x4 o0 = v0 * c4 - v1 * s4, o1 = v0 * s4 + v1 * c4; v0 = o0; v1 = o1;
                        }
                        const u32x2 p0 = pack4(v0), p1 = pack4(v1);
                        st16_wt(q + (unsigned)(row * 768 + G * 32 + fq * 8), (u32x4){p0.x, p0.y, p1.x, p1.y});
                    }
            }
        } else {
            rows_rstd4(pkv, row0, fq, 1.0f / 128.0f, 1.0f, rsv);
#pragma unroll
            for (int ai = 0; ai < 2; ++ai)
#pragma unroll
                for (int m = 0; m < 4; ++m) {
                    const int row = row0 + ai * 128 + m * 16; const float rs = rsv[ai * 4 + m];
#pragma unroll
                    for (int bj = 0; bj < 2; ++bj) {
                        const u32x2 p0 = pack4(acc[ai][bj][m][0] * rs), p1 = pack4(acc[ai][bj][m][1] * rs);
                        st16_wt(kv + (unsigned)(row * 1024 + (u.pn - 3) * 256 + bj * 128 + wc * 32 + fq * 8), (u32x4){p0.x, p0.y, p1.x, p1.y});
                    }
                }
        }
    }
};

#define XB_TMO      128
#define XB_XCNT(j)  (256  + 64 * (j))
#define XB_XSUB(j)  (1280 + 64 * (j))
#define XB_XGEN(j)  (2304 + 64 * (j))
#define XB_TOP      3328
#define XB_TOPGEN   3392
#define XCD_BAR_WORDS 3456
#define XB_LSUB(j)  (3456 + 64 * (j))
#define XB_LGEN(j)  (4480 + 64 * (j))
#define XB_SPIN_CAP (1u << 18)
__device__ __forceinline__ unsigned xb_ld(unsigned* p)              { return __hip_atomic_load(p, __ATOMIC_RELAXED, __HIP_MEMORY_SCOPE_AGENT); }
__device__ __forceinline__ unsigned xb_add(unsigned* p, unsigned v) { return __hip_atomic_fetch_add(p, v, __ATOMIC_RELAXED, __HIP_MEMORY_SCOPE_AGENT); }
__device__ __forceinline__ unsigned xb_xcc_id() { return (unsigned)__builtin_amdgcn_s_getreg((3 << 11) | 20) & 0xFu; }
#define XB_SPIN(cond, bar) do { unsigned _sp = 0; while (cond) { __builtin_amdgcn_s_sleep(1); \
    if ((++_sp & 255u) == 0u) { if (xb_ld(&(bar)[XB_TMO])) break; if (_sp > XB_SPIN_CAP) { atomicAdd(&(bar)[XB_TMO], 1u); break; } } } } while (0)
struct XcdBarrier { unsigned* bar; unsigned x; volatile LAS unsigned* st; };
__device__ __forceinline__ XcdBarrier xcd_barrier_post(unsigned* bar, volatile LAS unsigned* st) {
    XcdBarrier b; b.bar = bar; b.x = xb_xcc_id(); b.st = st;
    if (threadIdx.x == 0) st[3] = xb_add(&bar[XB_XCNT(b.x)], 1u);
    return b;
}
__device__ __forceinline__ void xcd_barrier_complete(unsigned* bar, unsigned x, unsigned& nloc, unsigned& nx, unsigned& regular) {
    const unsigned G = gridDim.x * gridDim.y * gridDim.z;
    unsigned sum, cnt, mine, sp = 0u;
    for (;;) {
        sum = 0u; cnt = 0u; mine = 0u;
#pragma unroll
        for (unsigned j = 0; j < 16; ++j) { const unsigned c = xb_ld(&bar[XB_XCNT(j)]); sum += c; cnt += (c > 0u) ? 1u : 0u; mine = (j == x) ? c : mine; }
        if (sum == G) break;
        __builtin_amdgcn_s_sleep(1);
        if ((++sp & 255u) == 0u) { if (xb_ld(&bar[XB_TMO])) break; if (sp > XB_SPIN_CAP) { atomicAdd(&bar[XB_TMO], 1u); break; } }
    }
    nloc = mine > 0u ? mine : 1u; nx = cnt > 0u ? cnt : 1u;
    unsigned reg = (G == 256u) ? 1u : 0u;
#pragma unroll
    for (unsigned j = 0; j < 16; ++j) { const unsigned c = xb_ld(&bar[XB_XCNT(j)]); if (c != (j < 8u ? 32u : 0u)) reg = 0u; }
    regular = reg;
}
__device__ __forceinline__ void xcd_barrier(const XcdBarrier& b) {
    asm volatile("s_waitcnt vmcnt(0)" ::: "memory");
    __syncthreads();
    if (threadIdx.x == 0) {
        unsigned* bar = b.bar;
        __builtin_amdgcn_s_waitcnt(0);
        unsigned nloc = b.st[0], nx = b.st[1];
        if (nloc == 0u) { unsigned reg_; xcd_barrier_complete(bar, b.x, nloc, nx, reg_); b.st[0] = nloc; b.st[1] = nx; b.st[2] = reg_; }
        const unsigned old = xb_add(&bar[XB_XSUB(b.x)], 1u);
        const unsigned gen = old / nloc;
        if (old + 1u == (gen + 1u) * nloc) {
            __builtin_amdgcn_fence(__ATOMIC_RELEASE, "agent");
            asm volatile("s_waitcnt vmcnt(0)" ::: "memory");
            const unsigned og = xb_add(&bar[XB_TOP], 1u);
            const unsigned tg = og / nx;
            if (og + 1u == (tg + 1u) * nx) xb_add(&bar[XB_TOPGEN], 1u);
            else XB_SPIN(xb_ld(&bar[XB_TOPGEN]) == tg, bar);
            __builtin_amdgcn_fence(__ATOMIC_ACQUIRE, "agent");
            xb_add(&bar[XB_XGEN(b.x)], 1u);
            asm volatile("s_waitcnt vmcnt(0)" ::: "memory");
        } else {
            XB_SPIN(xb_ld(&bar[XB_XGEN(b.x)]) == gen, bar);
            __builtin_amdgcn_fence(__ATOMIC_ACQUIRE, "agent");
            asm volatile("s_waitcnt vmcnt(0)" ::: "memory");
        }
    }
    __syncthreads();
}
__device__ __forceinline__ void xcd_local_barrier(const XcdBarrier& b) {
    asm volatile("s_waitcnt vmcnt(0)" ::: "memory");
    __syncthreads();
    if (threadIdx.x == 0) {
        unsigned* bar = b.bar;
        __builtin_amdgcn_s_waitcnt(0);
        const unsigned nloc = b.st[0];
        const unsigned old = xb_add(&bar[XB_LSUB(b.x)], 1u);
        const unsigned gen = old / nloc;
        if (old + 1u == (gen + 1u) * nloc) xb_add(&bar[XB_LGEN(b.x)], 1u);
        else XB_SPIN(xb_ld(&bar[XB_LGEN(b.x)]) == gen, bar);
        __builtin_amdgcn_fence(__ATOMIC_ACQUIRE, "agent");
        asm volatile("s_waitcnt vmcnt(0)" ::: "memory");
    }
    __syncthreads();
}
template <int K> __device__ __forceinline__ const float* inp() {
    unsigned long long v;
    const unsigned long long kp_ = (unsigned long long)__builtin_amdgcn_kernarg_segment_ptr();
    const unsigned long long kps_ = ((unsigned long long)(unsigned)__builtin_amdgcn_readfirstlane((int)(unsigned)(kp_ >> 32)) << 32) | (unsigned)__builtin_amdgcn_readfirstlane((int)(unsigned)kp_);
    asm volatile("s_load_dwordx2 %0, %1, %2\n\ts_waitcnt lgkmcnt(0)" : "=s"(v) : "s"(kps_), "n"(K * 8) : "memory");
    return (const float*)(const __attribute__((address_space(1))) float*)v;
}
struct Args { const float* in[36]; float* out; unsigned char* ws; int ph_lo, ph_hi; };
struct Frame {
    LAS unsigned char* lds;
    int tid, lane, wave, G, bid;
    float* out; unsigned char* ws;
};

struct CvtDesc { const float* W; const float* gain; bf16_t* WT; int N, ldt, kdst, mode, item; };
__device__ __forceinline__ void cvt_load(const CvtDesc& d, int lane, f32x4 (&v)[8], float (&g)[8]) {
    const int nblk = d.N / 32, kb = d.item / nblk, nb = d.item % nblk, k0 = 64 * kb, n0 = 32 * nb;
    const int kq = lane >> 3, nq = (lane & 7) * 4;
#pragma unroll
    for (int i = 0; i < 8; ++i) v[i] = *(const f32x4*)(d.W + (size_t)(k0 + i * 8 + kq) * d.N + n0 + nq);
#pragma unroll
    for (int i = 0; i < 8; ++i) g[i] = d.gain ? d.gain[k0 + i * 8 + kq] : 1.0f;
}
__device__ __forceinline__ void cvt_finish(const CvtDesc& d, int lane, LAS float* scr, const f32x4 (&v)[8], const float (&g)[8]) {
    const int nblk = d.N / 32, kb = d.item / nblk, nb = d.item % nblk, k0 = 64 * kb, n0 = 32 * nb;
    const int kq = lane >> 3, nq = (lane & 7) * 4;
#pragma unroll
    for (int i = 0; i < 8; ++i) { const int kk = i * 8 + kq; const float gk = g[i]; LAS float* dd = scr + kk * 33 + nq; dd[0] = v[i][0] * gk; dd[1] = v[i][1] * gk; dd[2] = v[i][2] * gk; dd[3] = v[i][3] * gk; }
    asm volatile("s_waitcnt lgkmcnt(0)" ::: "memory");
    const int c = lane & 7;
#pragma unroll
    for (int j = 0; j < 4; ++j) {
        const int n = (lane >> 3) + 8 * j; const LAS float* sp_ = scr + (8 * c) * 33 + n;
        u32x4 o; o.x = pk2(sp_[0 * 33], sp_[1 * 33]); o.y = pk2(sp_[2 * 33], sp_[3 * 33]); o.z = pk2(sp_[4 * 33], sp_[5 * 33]); o.w = pk2(sp_[6 * 33], sp_[7 * 33]);
        int nn = n0 + n;
        if (d.mode == 1) { const int which = nn >= FF ? 1 : 0, h = nn - which * FF, hl = h & 127; nn = 256 * (h >> 7) + 128 * ((hl >> 2) & 1) + 32 * (hl >> 5) + 16 * which + 4 * ((hl >> 3) & 3) + (hl & 3); }
        if (d.mode == 2) { const int hd = nn / 96, dd = nn % 96; if (dd >= 64) { const int r_ = dd - 64, n_ = r_ >> 4, i_ = r_ & 15; nn = hd * 96 + 64 + 8 * (i_ >> 2) + 4 * n_ + (i_ & 3); } }
        st16_wt(d.WT + (size_t)nn * d.ldt + d.kdst + k0 + 8 * c, o);
    }
    asm volatile("s_waitcnt lgkmcnt(0)" ::: "memory");
}
__device__ __forceinline__ void zero_fill16(unsigned char* base, int row_bytes_stride, int col_byte0, int chunks_per_row, int nrows, int gtid, int gthreads) {
    const int total = nrows * chunks_per_row;
    unsigned zz = 0u; asm volatile("" : "+v"(zz));
    const u32x4 z4 = (u32x4){zz, zz, zz, zz};
    for (int i = gtid; i < total; i += gthreads) { const int r = i / chunks_per_row, c = i % chunks_per_row; st16_wt(base + (size_t)r * row_bytes_stride + col_byte0 + c * 16, z4); }
}
__device__ __forceinline__ void convert_layer(const Frame& F, int l, int part, int nparts, int vb, int nvb) {
    unsigned char* wb = F.ws + WS_WBUF0 + (size_t)(l & 1) * WBUF_BYTES;
    LAS float* scr = (LAS float*)(F.lds + F.wave * 16384);
    const int gw = vb * 8 + F.wave, NGW = nvb * 8;
    const int hl = l >> 1; const bool odd = l & 1;
    constexpr int I_IN = 16 * 176, I_OUT = 44 * 32, I_MO = 16 * 32;
    const int I_MI = odd ? 16 * 45 : 16 * 88;
    const int I_X = odd ? (4 * 24 + 2 * 32) : (16 + 16 + 32);
    const int total = 2 * I_IN + 2 * I_OUT + I_MI + I_MO + I_X;
    const int it_lo = (int)((long)total * part / nparts), it_hi = (int)((long)total * (part + 1) / nparts);
    auto desc = [&](int it) -> CvtDesc {
        CvtDesc d; d.kdst = 0; d.mode = 0; d.gain = nullptr;
        int r = it;
        if (r < I_IN) { d.W = inp<2>() + (size_t)l * DM * 2 * FF; d.N = 2 * FF; d.gain = inp<1>() + l * DM; d.WT = (bf16_t*)(wb + WB_W1IN); d.ldt = DM; d.mode = 1; d.item = r; return d; } r -= I_IN;
        if (r < I_IN) { d.W = inp<6>() + (size_t)l * DM * 2 * FF; d.N = 2 * FF; d.gain = inp<5>() + l * DM; d.WT = (bf16_t*)(wb + WB_W2IN); d.ldt = DM; d.mode = 1; d.item = r; return d; } r -= I_IN;
        if (r < I_OUT) { d.W = inp<3>() + (size_t)l * FF * DM; d.N = DM; d.WT = (bf16_t*)(wb + WB_W1OUT); d.ldt = FF; d.item = r; return d; } r -= I_OUT;
        if (r < I_OUT) { d.W = inp<7>() + (size_t)l * FF * DM; d.N = DM; d.WT = (bf16_t*)(wb + WB_W2OUT); d.ldt = FF; d.item = r; return d; } r -= I_OUT;
        if (r < I_MI) {
            if (odd) { d.W = inp<25>() + (size_t)hl * DM * PO; d.N = PO; } else { d.W = inp<8>() + (size_t)hl * DM * PE; d.N = PE; }
            d.gain = inp<4>() + l * DM; d.WT = (bf16_t*)(wb + WB_WMIN); d.ldt = DM; d.item = r; return d; } r -= I_MI;
        if (r < I_MO) { d.W = (odd ? inp<26>() : inp<9>()) + (size_t)hl * DM * DM; d.N = DM; d.WT = (bf16_t*)(wb + WB_WMOUT); d.ldt = DM; d.item = r; return d; } r -= I_MO;
        if (odd) {
            if (r < 96) { d.W = inp<28>() + (size_t)hl * 256 * 768; d.N = 768; d.gain = inp<27>() + hl * 256; d.WT = (bf16_t*)(wb + WB_WX); d.ldt = 384; d.mode = 2; d.item = r; return d; } r -= 96;
            d.W = inp<30>() + (size_t)hl * 128 * 1024; d.N = 1024; d.gain = inp<29>() + hl * 128; d.WT = (bf16_t*)(wb + WB_WX) + (size_t)768 * 384; d.ldt = 384; d.kdst = 256; d.item = r; return d;
        }
        if (r < 16) { d.W = inp<16>() + (size_t)hl * 64 * 512; d.N = 512; d.WT = (bf16_t*)(wb + WB_WX); d.ldt = 64; d.item = r; return d; } r -= 16;
        if (r < 16) { d.W = inp<18>() + (size_t)hl * 64 * 512; d.N = 512; d.WT = (bf16_t*)(wb + WB_WX) + 512 * 64; d.ldt = 64; d.item = r; return d; } r -= 16;
        d.W = inp<19>() + (size_t)hl * 128 * 512; d.N = 512; d.WT = (bf16_t*)(wb + WB_WX) + 2 * 512 * 64; d.ldt = 128; d.item = r; return d;
    };
    {
        int it = it_lo + gw;
        if (it < it_hi) {
            CvtDesc d0 = desc(it), d1 = d0; f32x4 va[8], vc[8]; float ga[8], gc[8];
            cvt_load(d0, F.lane, va, ga);
            for (;;) {
                const int it1 = it + NGW; const bool h1 = it1 < it_hi;
                if (h1) { d1 = desc(it1); cvt_load(d1, F.lane, vc, gc); }
                cvt_finish(d0, F.lane, scr, va, ga);
                if (!h1) break;
                const int it2 = it1 + NGW; const bool h2 = it2 < it_hi;
                if (h2) { d0 = desc(it2); cvt_load(d0, F.lane, va, ga); }
                cvt_finish(d1, F.lane, scr, vc, gc);
                if (!h2) break;
                it = it2;
            }
        }
    }
    if (odd && part == 0) {
        const int gtid = vb * 512 + F.tid, gth = nvb * 512;
        zero_fill16(wb + WB_WMIN + (size_t)PO * DM * 2, DM * 2, 0, 128, POP - PO, gtid, gth);
        zero_fill16(wb + WB_WX, 384 * 2, 512, 16, 768, gtid, gth);
        zero_fill16(wb + WB_WX + (size_t)768 * 384 * 2, 384 * 2, 0, 32, 1024, gtid, gth);
    }
}

__device__ __forceinline__ void x_prologue(const Frame& F) {
    const float* x = inp<0>(); bf16_t* xb = (bf16_t*)(F.ws + WS_XB); float* ssq = (float*)(F.ws + WS_SSQ);
    const int gw = F.bid * 8 + F.wave, NGW = F.G * 8, lane = F.lane;
    for (int m = gw; m < T; m += NGW) {
        const f32x4* xr = (const f32x4*)(x + (size_t)m * DM) + lane;
        f32x4 v[4]; float s = 0.f;
#pragma unroll
        for (int j = 0; j < 4; ++j) { v[j] = xr[64 * j]; s += (v[j][0] * v[j][0] + v[j][1] * v[j][1]) + (v[j][2] * v[j][2] + v[j][3] * v[j][3]); }
        s = wave_sum(s);
        u32x2* o = (u32x2*)(xb + (size_t)m * DM) + lane;
#pragma unroll
        for (int j = 0; j < 4; ++j) st8_wt(o + 64 * j, pack4(v[j]));
        if (lane < 16) ssq[(size_t)lane * T + m] = (lane == 0) ? s : 0.f;
    }
    float* cosT = (float*)(F.ws + WS_COS); float* sinT = (float*)(F.ws + WS_SIN);
    for (int i = F.bid * 512 + F.tid; i < SEQ * 16; i += F.G * 512) {
        const int pos = i >> 4, k = i & 15;
        const float inv = exp2f(-(float)k * 0.8304820237218407f);
        const float ang = (float)pos * inv;
        const double rev = (double)ang * 0.15915494309189535;
        const float fr = (float)(rev - floor(rev));
        cosT[i] = __builtin_amdgcn_cosf(fr); sinT[i] = __builtin_amdgcn_sinf(fr);
    }
}
__device__ __forceinline__ void final_norm(const Frame& F) {
    const float* g = inp<35>(); float* x = F.out; const bf16_t* xb = (const bf16_t*)(F.ws + WS_XB);
    const int gw = F.bid * 8 + F.wave, NGW = F.G * 8, lane = F.lane;
    for (int m = gw; m < T; m += NGW) {
        f32x4* xr = (f32x4*)(x + (size_t)m * DM) + lane;
        const u32x2* br = (const u32x2*)(xb + (size_t)m * DM) + lane;
        f32x4 v[4]; float s = 0.f;
#pragma unroll
        for (int j = 0; j < 4; ++j) { v[j] = unpack4(br[64 * j]); s += (v[j][0] * v[j][0] + v[j][1] * v[j][1]) + (v[j][2] * v[j][2] + v[j][3] * v[j][3]); }
        s = wave_sum(s);
        const float rs = rsqrtf(s * (1.0f / 1024.0f) + RMS_EPS);
#pragma unroll
        for (int j = 0; j < 4; ++j) { const f32x4 gg = *((const f32x4*)g + lane + 64 * j); xr[64 * j] = v[j] * rs * gg; }
    }
}

__device__ __forceinline__ void gsu_item(const Frame& F, int item, int e) {
    const int nb = item >> 2, g = item & 3, tok0 = nb * 128, lane = F.lane, wave = F.wave, fr = lane & 15, fq = lane >> 4;
    const bf16_t* z = (const bf16_t*)(F.ws + WS_ACT);
    bf16_t* ymix = (bf16_t*)(F.ws + WS_YMIX);
    const float* ws = inp<10>() + (size_t)(e * 4 + g) * 128 * 128; const float* bs = inp<11>() + (e * 4 + g) * 128;
    const float* lng = inp<12>() + e * 512; const float* lnb = inp<13>() + e * 512;
    LAS bf16_t* vn = (LAS bf16_t*)F.lds;
    const int nks = (wave < 4) ? 2 : 4;
    f32x4 wf[4][2];
#pragma unroll
    for (int ks = 0; ks < 4; ++ks) { const float* wp = ws + (size_t)(wave * 16 + fr) * 128 + (ks < nks ? ks : 0) * 32 + fq * 8; wf[ks][0] = *(const f32x4*)wp; wf[ks][1] = *(const f32x4*)(wp + 4); }
    const float bsv = bs[wave * 16 + fr];
    u32x4 zrs[16];
#pragma unroll
    for (int fi = 0; fi < 16; ++fi) zrs[fi] = *(const u32x4*)(z + (size_t)(tok0 + wave * 16 + fi) * PE + 512 + lane * 8);
    float lgv[8], lbv[8];
#pragma unroll
    for (int k = 0; k < 8; ++k) { lgv[k] = lng[lane * 8 + k]; lbv[k] = lnb[lane * 8 + k]; }
#pragma unroll
    for (int fi = 0; fi < 16; ++fi) {
        const int frame = wave * 16 + fi;
        const u32x4 zr = zrs[fi];
        float gv[8]; gv[0] = bflo(zr.x); gv[1] = bfhi(zr.x); gv[2] = bflo(zr.y); gv[3] = bfhi(zr.y); gv[4] = bflo(zr.z); gv[5] = bfhi(zr.z); gv[6] = bflo(zr.w); gv[7] = bfhi(zr.w);
        float s = 0.f;
#pragma unroll
        for (int k = 0; k < 8; ++k) { gv[k] = gelu_tanh(gv[k]); s += gv[k]; }
        const float mean = wave_sum(s) * (1.0f / 512.0f); float qv = 0.f;
#pragma unroll
        for (int k = 0; k < 8; ++k) { gv[k] -= mean; qv += gv[k] * gv[k]; }
        const float rstd = rsqrtf(wave_sum(qv) * (1.0f / 512.0f) + 1e-5f);
        if ((lane >> 4) == g) {
            const int cl = (lane & 15) * 8;
#pragma unroll
            for (int k = 0; k < 8; ++k) { const float o = gv[k] * rstd * lgv[k] + lbv[k]; vn[(cl + k) * 136 + frame] = (bf16_t)(pk2(o, 0.f) & 0xffffu); }
        }
    }
    __syncthreads();
    const int i = wave * 16 + fr;
    f32x4 acc[8];
#pragma unroll
    for (int ct = 0; ct < 8; ++ct) acc[ct] = (f32x4){0.f, 0.f, 0.f, 0.f};
#pragma unroll
    for (int ks = 0; ks < 4; ++ks) {
        if (ks >= nks) continue;
        const f32x4 w0 = wf[ks][0], w1 = wf[ks][1];
        u32x4 wy; wy.x = pk2(w0[0], w0[1]); wy.y = pk2(w0[2], w0[3]); wy.z = pk2(w1[0], w1[1]); wy.w = pk2(w1[2], w1[3]);
        const bf16x8 Y = __builtin_bit_cast(bf16x8, wy);
#pragma unroll
        for (int ct = 0; ct < 8; ++ct) {
            const bf16x8 X = *(const LAS bf16x8*)(vn + (ct * 16 + fr) * 136 + ks * 32 + fq * 8);
            acc[ct] = __builtin_amdgcn_mfma_f32_16x16x32_bf16(X, Y, acc[ct], 0, 0, 0);
        }
    }
    const size_t tok = tok0 + i;
#pragma unroll
    for (int ct = 0; ct < 8; ++ct) {
        const int c = g * 128 + ct * 16 + fq * 4;
        const f32x4 uz = unpack4(*(const u32x2*)(z + tok * PE + c)); f32x4 o;
#pragma unroll
        for (int k = 0; k < 4; ++k) o[k] = gelu_tanh(uz[k]) * (acc[ct][k] + bsv);
        st8_wt(ymix + tok * DM + c, pack4(o));
    }
    __syncthreads();
}

__device__ __forceinline__ void prep_item(const Frame& F, int item, int e, const unsigned char* wb, bool stage) {
    const int tok0 = item * 32, b = tok0 / SEQ, t0 = tok0 % SEQ, lane = F.lane, h = F.wave, fr = lane & 15, fq = lane >> 4, tid = F.tid;
    const bf16_t* z = (const bf16_t*)(F.ws + WS_ACT);
    bf16_t* ymix = (bf16_t*)(F.ws + WS_YMIX); bf16_t* sc = (bf16_t*)(F.ws + WS_SC); float* cb = (float*)(F.ws + WS_CB);
    const float* mu = inp<14>() + e * PB; const float* w0p = inp<15>() + e * 512; const float* a0p = inp<17>() + e * 512;
    const float* kkp = inp<20>() + e * 512; const float* kap = inp<21>() + e * 512; const float* rkp = inp<22>() + e * 512;
    LAS bf16_t* At = (LAS bf16_t*)F.lds;
    LAS float* PRM = (LAS float*)(F.lds + 32768);
    if (stage) {
        PRM[0 * 512 + tid] = mu[tid]; PRM[1 * 512 + tid] = mu[512 + tid]; PRM[2 * 512 + tid] = mu[1024 + tid];
        PRM[3 * 512 + tid] = kkp[tid]; PRM[4 * 512 + tid] = kap[tid]; PRM[5 * 512 + tid] = rkp[tid];
        PRM[6 * 512 + tid] = w0p[tid]; PRM[7 * 512 + tid] = a0p[tid];
    }
    {
        const int token = tid >> 4, chunk = tid & 15, t = t0 + token; const size_t tok = tok0 + token;
        const bf16_t* zp = z + tok * PE + 2560 + chunk * 16;
        const u32x4 c0 = *(const u32x4*)zp, c1 = *(const u32x4*)(zp + 8);
        const bf16_t* zq = (t > 0) ? zp - PE : zp;
        u32x4 p0 = *(const u32x4*)zq, p1 = *(const u32x4*)(zq + 8);
        if (t == 0) { p0 = (u32x4){0u, 0u, 0u, 0u}; p1 = p0; }
        float cv[16], pv[16];
#pragma unroll
        for (int k = 0; k < 4; ++k) { cv[2 * k] = bflo(c0[k]); cv[2 * k + 1] = bfhi(c0[k]); cv[8 + 2 * k] = bflo(c1[k]); cv[9 + 2 * k] = bfhi(c1[k]);
                                      pv[2 * k] = bflo(p0[k]); pv[2 * k + 1] = bfhi(p0[k]); pv[8 + 2 * k] = bflo(p1[k]); pv[9 + 2 * k] = bfhi(p1[k]); }
        const f32x4* mup = (const f32x4*)(mu + 1536 + chunk * 16);
        const f32x4 m0 = mup[0], m1 = mup[1], m2 = mup[2], m3 = mup[3];
        const float mv_[16] = {m0[0], m0[1], m0[2], m0[3], m1[0], m1[1], m1[2], m1[3], m2[0], m2[1], m2[2], m2[3], m3[0], m3[1], m3[2], m3[3]};
#pragma unroll
        for (int k = 0; k < 16; ++k) cv[k] = cv[k] + mv_[k] * (pv[k] - cv[k]);
        if (chunk < 4) {
#pragma unroll
            for (int k = 0; k < 16; ++k) cv[k] = tanh_(cv[k]);
        } else if (chunk >= 8) {
#pragma unroll
            for (int k = 0; k < 16; ++k) cv[k] = sigmoidf_(cv[k]);
        }
        u32x4 o0, o1;
#pragma unroll
        for (int k = 0; k < 4; ++k) { o0[k] = pk2(cv[2 * k], cv[2 * k + 1]); o1[k] = pk2(cv[8 + 2 * k], cv[9 + 2 * k]); }
        *(LAS u32x4*)(At + token * 264 + chunk * 16) = o0; *(LAS u32x4*)(At + token * 264 + chunk * 16 + 8) = o1;
    }
    __syncthreads();
    const bf16_t* DUt = (const bf16_t*)(wb + WB_WX); const bf16_t* IUt = DUt + 512 * 64; const bf16_t* GUt = DUt + 2 * 512 * 64;
#pragma unroll
    for (int mt = 0; mt < 2; ++mt) {
        const LAS bf16_t* Ar = At + (mt * 16 + fr) * 264 + fq * 8;
        const int t = t0 + mt * 16 + fr; const size_t tok = tok0 + mt * 16 + fr; const bool hp = t > 0;
        f32x4 ev[4], av[4];
        {
            f32x4 acc[4];
#pragma unroll
            for (int nt = 0; nt < 4; ++nt) acc[nt] = (f32x4){0.f, 0.f, 0.f, 0.f};
#pragma unroll
            for (int ks = 0; ks < 2; ++ks) {
                const bf16x8 Yv = *(const LAS bf16x8*)(Ar + 0 + ks * 32);
#pragma unroll
                for (int nt = 0; nt < 4; ++nt) {
                    const bf16x8 X = *(const bf16x8*)(DUt + (size_t)(h * 64 + 32 * (nt >> 1) + 8 * (fr >> 2) + 4 * (nt & 1) + (fr & 3)) * 64 + ks * 32 + fq * 8);
                    acc[nt] = __builtin_amdgcn_mfma_f32_16x16x32_bf16(X, Yv, acc[nt], 0, 0, 0);
                }
            }
#pragma unroll
            for (int nt = 0; nt < 4; ++nt) {
                const f32x4 w0 = *(const LAS f32x4*)(PRM + 6 * 512 + h * 64 + 32 * (nt >> 1) + 8 * fq + 4 * (nt & 1));
#pragma unroll
                for (int k = 0; k < 4; ++k) ev[nt][k] = 0.6065306597126334f * __builtin_amdgcn_rcpf(1.0f + __expf(-(w0[k] + acc[nt][k])));
            }
        }
        {
            f32x4 acc[4];
#pragma unroll
            for (int nt = 0; nt < 4; ++nt) acc[nt] = (f32x4){0.f, 0.f, 0.f, 0.f};
#pragma unroll
            for (int ks = 0; ks < 2; ++ks) {
                const bf16x8 Yv = *(const LAS bf16x8*)(Ar + 64 + ks * 32);
#pragma unroll
                for (int nt = 0; nt < 4; ++nt) {
                    const bf16x8 X = *(const bf16x8*)(IUt + (size_t)(h * 64 + 32 * (nt >> 1) + 8 * (fr >> 2) + 4 * (nt & 1) + (fr & 3)) * 64 + ks * 32 + fq * 8);
                    acc[nt] = __builtin_amdgcn_mfma_f32_16x16x32_bf16(X, Yv, acc[nt], 0, 0, 0);
                }
            }
#pragma unroll
            for (int nt = 0; nt < 4; ++nt) {
                const f32x4 a0 = *(const LAS f32x4*)(PRM + 7 * 512 + h * 64 + 32 * (nt >> 1) + 8 * fq + 4 * (nt & 1));
#pragma unroll
                for (int k = 0; k < 4; ++k) av[nt][k] = sigmoidf_(a0[k] + acc[nt][k]);
            }
        }
        {
            f32x4 acc[4];
#pragma unroll
            for (int nt = 0; nt < 4; ++nt) acc[nt] = (f32x4){0.f, 0.f, 0.f, 0.f};
#pragma unroll
            for (int ks = 0; ks < 4; ++ks) {
                const bf16x8 Yv = *(const LAS bf16x8*)(Ar + 128 + ks * 32);
#pragma unroll
                for (int nt = 0; nt < 4; ++nt) {
                    const bf16x8 X = *(const bf16x8*)(GUt + (size_t)(h * 64 + 32 * (nt >> 1) + 8 * (fr >> 2) + 4 * (nt & 1) + (fr & 3)) * 128 + ks * 32 + fq * 8);
                    acc[nt] = __builtin_amdgcn_mfma_f32_16x16x32_bf16(X, Yv, acc[nt], 0, 0, 0);
                }
            }
#pragma unroll
            for (int a2 = 0; a2 < 2; ++a2) { const u32x2 p0 = pack4(acc[2 * a2]), p1 = pack4(acc[2 * a2 + 1]);
                st16_wt(ymix + tok * DM + 512 + h * 64 + 32 * a2 + 8 * fq, (u32x4){p0.x, p0.y, p1.x, p1.y}); }
        }
        f32x4 rv[4], kv[4], kk[4]; float ssq = 0.f;
        bf16_t* sp = sc + ((size_t)(b * 8 + h) * SEQ + t) * 384;
#define PK8(lo4, hi4) ({ const u32x2 p0_ = pack4(lo4), p1_ = pack4(hi4); (u32x4){p0_.x, p0_.y, p1_.x, p1_.y}; })
#pragma unroll
        for (int a2 = 0; a2 < 2; ++a2) {
            const int cl = 32 * a2 + 8 * fq, c = h * 64 + cl;
            const bf16_t* zp = z + tok * PE + 1024 + c;
            const u32x4 zr = *(const u32x4*)zp, zk = *(const u32x4*)(zp + 512), zv = *(const u32x4*)(zp + 1024);
            const bf16_t* zq = hp ? zp - PE : zp; const float hm = hp ? 1.0f : 0.0f;
            const u32x4 qr = *(const u32x4*)zq, qk = *(const u32x4*)(zq + 512), qv = *(const u32x4*)(zq + 1024);
            f32x4 vv[2];
#pragma unroll
            for (int hh = 0; hh < 2; ++hh) {
                const int nt = 2 * a2 + hh, c4 = c + 4 * hh;
                const f32x4 cr = unpack4(hh ? (u32x2){zr.z, zr.w} : (u32x2){zr.x, zr.y}), ck = unpack4(hh ? (u32x2){zk.z, zk.w} : (u32x2){zk.x, zk.y}), cvv = unpack4(hh ? (u32x2){zv.z, zv.w} : (u32x2){zv.x, zv.y});
                const f32x4 pr = unpack4(hh ? (u32x2){qr.z, qr.w} : (u32x2){qr.x, qr.y}) * hm, pk = unpack4(hh ? (u32x2){qk.z, qk.w} : (u32x2){qk.x, qk.y}) * hm, pvv = unpack4(hh ? (u32x2){qv.z, qv.w} : (u32x2){qv.x, qv.y}) * hm;
                const f32x4 mr = *(const LAS f32x4*)(PRM + c4), mk = *(const LAS f32x4*)(PRM + 512 + c4), mv = *(const LAS f32x4*)(PRM + 1024 + c4);
                rv[nt] = cr + mr * (pr - cr); kv[nt] = ck + mk * (pk - ck); vv[hh] = cvv + mv * (pvv - cvv);
                kk[nt] = kv[nt] * *(const LAS f32x4*)(PRM + 3 * 512 + c4);
                ssq += (kk[nt][0] * kk[nt][0] + kk[nt][1] * kk[nt][1]) + (kk[nt][2] * kk[nt][2] + kk[nt][3] * kk[nt][3]);
            }
            st16_wt(sp + 5 * 64 + cl, PK8(vv[0], vv[1]));
            st16_wt(sp + 4 * 64 + cl, PK8(rv[2 * a2], rv[2 * a2 + 1]));
            st16_wt(sp + 0 * 64 + cl, PK8(ev[2 * a2], ev[2 * a2 + 1]));
        }
        ssq += __shfl_xor(ssq, 16); ssq = xor32_add(ssq);
        const float inv = 1.0f / fmaxf(sqrtf(ssq), 1e-12f);
        float cbp = 0.f;
#pragma unroll
        for (int a2 = 0; a2 < 2; ++a2) {
            const int cl = 32 * a2 + 8 * fq, c = h * 64 + cl;
            f32x4 kp[2], nk[2], nb[2];
#pragma unroll
            for (int hh = 0; hh < 2; ++hh) {
                const int nt = 2 * a2 + hh, c4 = c + 4 * hh;
                const f32x4 a = av[nt], kkn = kk[nt] * inv;
                const f32x4 ka = *(const LAS f32x4*)(PRM + 4 * 512 + c4), rk = *(const LAS f32x4*)(PRM + 5 * 512 + c4);
                kp[hh] = kv[nt] * (1.0f + (a - 1.0f) * ka);
                const f32x4 pr = rv[nt] * kp[hh] * rk; cbp += (pr[0] + pr[1]) + (pr[2] + pr[3]);
                nk[hh] = -kkn; nb[hh] = kkn * a;
            }
            st16_wt(sp + 1 * 64 + cl, PK8(kp[0], kp[1]));
            st16_wt(sp + 2 * 64 + cl, PK8(nk[0], nk[1]));
            st16_wt(sp + 3 * 64 + cl, PK8(nb[0], nb[1]));
        }
#undef PK8
        cbp += __shfl_xor(cbp, 16); cbp = xor32_add(cbp);
        if (fq == 0) cb[tok * 8 + h] = cbp;
    }
    __syncthreads();
}

__device__ __forceinline__ void red16x2(float& a, float& b) {
    a += dpp_f<0x140>(a); b += dpp_f<0x140>(b);
    a += dpp_f<0x141>(a); b += dpp_f<0x141>(b);
    a += dpp_f<0xB1>(a);  b += dpp_f<0xB1>(b);
    a += dpp_f<0x4E>(a);  b += dpp_f<0x4E>(b);
}
__device__ __forceinline__ void red16x4(float& a, float& b, float& c, float& d) {
    a += dpp_f<0x140>(a); b += dpp_f<0x140>(b); c += dpp_f<0x140>(c); d += dpp_f<0x140>(d);
    a += dpp_f<0x141>(a); b += dpp_f<0x141>(b); c += dpp_f<0x141>(c); d += dpp_f<0x141>(d);
    a += dpp_f<0xB1>(a);  b += dpp_f<0xB1>(b);  c += dpp_f<0xB1>(c);  d += dpp_f<0xB1>(d);
    a += dpp_f<0x4E>(a);  b += dpp_f<0x4E>(b);  c += dpp_f<0x4E>(c);  d += dpp_f<0x4E>(d);
}
__device__ __forceinline__ void scan_item(const Frame& F, int item) {
    const int bh = item >> 2, rq = item & 3, b = bh >> 3, h = bh & 7, lane = F.lane, wave = F.wave;
    const bf16_t* sc = (const bf16_t*)(F.ws + WS_SC) + (size_t)bh * SEQ * 384;
    float* Y = (float*)(F.ws + WS_Y);
    LAS float* buf = (LAS float*)F.lds;
    constexpr int CH = 32, NP = CH / 2, PSTR = 712, CHF = NP * PSTR;
    const int ltid = F.tid - 256;
    const int lpair = ltid >> 4, lsub = ltid & 15;
    u32x2 raw0A[6], raw1A[6], raw0B[6], raw1B[6];
#define SCAN_GL(S, c) do { const bf16_t* src_ = sc + ((size_t)(c) * CH + 2 * lpair) * 384 + lsub * 4; \
        _Pragma("unroll") for (int p = 0; p < 6; ++p) { raw0##S[p] = *(const u32x2*)(src_ + p * 64); raw1##S[p] = *(const u32x2*)(src_ + 384 + p * 64); } } while (0)
#define SCAN_LW(S, bi) do { LAS float* pp_ = buf + (bi) * CHF + lpair * PSTR; LAS float* dst_ = pp_ + lsub * 4; \
        f32x4 e0_ = unpack4(raw0##S[0]), k0_ = unpack4(raw0##S[1]), a0_ = unpack4(raw0##S[2]), b0_ = unpack4(raw0##S[3]), r0_ = unpack4(raw0##S[4]), v0_ = unpack4(raw0##S[5]); \
        f32x4 e1_ = unpack4(raw1##S[0]), k1_ = unpack4(raw1##S[1]), a1_ = unpack4(raw1##S[2]), b1_ = unpack4(raw1##S[3]), r1_ = unpack4(raw1##S[4]), v1_ = unpack4(raw1##S[5]); \
        f32x4 w0_, w1_; _Pragma("unroll") for (int k = 0; k < 4; ++k) { w0_[k] = __expf(-e0_[k]); w1_[k] = __expf(-e1_[k]); } \
        const f32x4 ba_ = b0_ * a1_, ka_ = k0_ * a1_, br_ = b0_ * r0_, kr_ = k0_ * r0_; \
        float s0_ = (ba_[0] + ba_[1]) + (ba_[2] + ba_[3]), s1_ = (ka_[0] + ka_[1]) + (ka_[2] + ka_[3]), s2_ = (br_[0] + br_[1]) + (br_[2] + br_[3]), s3_ = (kr_[0] + kr_[1]) + (kr_[2] + kr_[3]); \
        red16x4(s0_, s1_, s2_, s3_); \
        *(LAS f32x4*)(dst_) = a0_; *(LAS f32x4*)(dst_ + 64) = w0_ * a1_; *(LAS f32x4*)(dst_ + 128) = w0_ * r0_; *(LAS f32x4*)(dst_ + 192) = r1_; \
        *(LAS f32x4*)(dst_ + 256) = w0_ * w1_; *(LAS f32x4*)(dst_ + 320) = b0_ * w1_; *(LAS f32x4*)(dst_ + 384) = k0_ * w1_; *(LAS f32x4*)(dst_ + 448) = b1_; \
        *(LAS f32x4*)(dst_ + 512) = k1_; *(LAS f32x4*)(dst_ + 576) = v0_; *(LAS f32x4*)(dst_ + 640) = v1_; \
        if (lsub == 0) *(LAS f32x4*)(pp_ + 704) = (f32x4){s0_, s1_, s2_, s3_}; } while (0)
    if (wave >= 4) { SCAN_GL(A, 0); SCAN_GL(B, 1); SCAN_LW(A, 0); SCAN_GL(A, 2); }
    __syncthreads();
    const int l16 = lane & 15, rl = wave * 4 + (lane >> 4), row = rq * 16 + rl, c4 = l16 * 4;
    f32x2 s01 = (f32x2){0.f, 0.f}, s23 = s01;
    f32x4 rprev = (f32x4){0.f, 0.f, 0.f, 0.f};
    float ykeep = 0.f;
    LAS float* ybuf = buf + 2 * CHF;
    LAS float* ywr = ybuf + l16 * 16 + rl;
    float* yflush = Y + ((size_t)b * SEQ + (ltid >> 2)) * 512 + h * 64 + rq * 16 + (ltid & 3) * 4;
#define SCAN_FLUSH(f) do { if (ltid < 128) { const f32x4 yv_ = *(const LAS f32x4*)(ybuf + ((f) & 3) * 512 + (ltid >> 2) * 16 + (ltid & 3) * 4); st16_wt(yflush + (size_t)(f) * 32 * 512, __builtin_bit_cast(u32x4, yv_)); } } while (0)
#define DOT4(x) ({ f32x2 p_ = s01 * (f32x2){(x)[0], (x)[1]}; p_ = __builtin_elementwise_fma(s23, (f32x2){(x)[2], (x)[3]}, p_); p_[0] + p_[1]; })
#define LDP(P, q) const f32x4 P##a = *(const LAS f32x4*)((q) + c4), P##wa = *(const LAS f32x4*)((q) + 64 + c4), P##wr = *(const LAS f32x4*)((q) + 128 + c4), P##r1 = *(const LAS f32x4*)((q) + 192 + c4), \
        P##ww = *(const LAS f32x4*)((q) + 256 + c4), P##bw = *(const LAS f32x4*)((q) + 320 + c4), P##kw = *(const LAS f32x4*)((q) + 384 + c4), P##b1 = *(const LAS f32x4*)((q) + 448 + c4), \
        P##k1 = *(const LAS f32x4*)((q) + 512 + c4), P##sc = *(const LAS f32x4*)((q) + 704); const float P##v0 = (q)[576 + row], P##v1 = (q)[640 + row]
    for (int c = 0; c < SEQ / CH; ++c) {
        if (wave >= 4) {
            if (c + 1 < SEQ / CH) {
                if ((c + 1) & 1) { SCAN_LW(B, 1); if (c + 3 < SEQ / CH) SCAN_GL(B, c + 3); }
                else { SCAN_LW(A, 0); if (c + 3 < SEQ / CH) SCAN_GL(A, c + 3); }
            }
            if (c >= 2) SCAN_FLUSH(c - 2);
        }
        else {
            const LAS float* bp = buf + (c & 1) * CHF;
            f32x4 Ca, Cwa, Cwr, Cr1, Cww, Cbw, Ckw, Cb1, Ck1, Csc; float Cv0, Cv1;
            { LDP(T, bp); Ca = Ta; Cwa = Twa; Cwr = Twr; Cr1 = Tr1; Cww = Tww; Cbw = Tbw; Ckw = Tkw; Cb1 = Tb1; Ck1 = Tk1; Csc = Tsc; Cv0 = Tv0; Cv1 = Tv1; }
#pragma unroll 1
            for (int hb = 0; hb < 2; ++hb) {
#pragma unroll
                for (int i = 0; i < 8; ++i) {
                    const int p = hb * 8 + i;
                    const LAS float* qn = bp + ((p + 1 < NP) ? (p + 1) : (NP - 1)) * PSTR;
                    LDP(N, qn);
                    float d0 = DOT4(rprev), d1 = DOT4(Ca), d2 = DOT4(Cwa), d3 = DOT4(Cwr);
                    red16x4(d0, d1, d2, d3);
                    ykeep = (l16 == ((2 * i + 15) & 15)) ? d0 : ykeep;
                    if (i == 0) { const int blk = 2 * c + hb - 1; if (blk >= 0) ywr[((blk >> 1) & 3) * 512 + (blk & 1) * 256] = ykeep; }
                    const float sa0 = d1;
                    const float yt = __builtin_fmaf(sa0, Csc[2], __builtin_fmaf(Cv0, Csc[3], d3));
                    ykeep = (l16 == (2 * i)) ? yt : ykeep;
                    const float sa1 = __builtin_fmaf(sa0, Csc[0], __builtin_fmaf(Cv0, Csc[1], d2));
                    const f32x2 a0v = (f32x2){sa0, sa0}, a1v = (f32x2){sa1, sa1}, v0v = (f32x2){Cv0, Cv0}, v1v = (f32x2){Cv1, Cv1};
                    f32x2 t01 = (f32x2){Ckw[0], Ckw[1]} * v0v, t23 = (f32x2){Ckw[2], Ckw[3]} * v0v;
                    t01 = __builtin_elementwise_fma((f32x2){Cbw[0], Cbw[1]}, a0v, t01); t23 = __builtin_elementwise_fma((f32x2){Cbw[2], Cbw[3]}, a0v, t23);
                    t01 = __builtin_elementwise_fma((f32x2){Ck1[0], Ck1[1]}, v1v, t01); t23 = __builtin_elementwise_fma((f32x2){Ck1[2], Ck1[3]}, v1v, t23);
                    t01 = __builtin_elementwise_fma((f32x2){Cb1[0], Cb1[1]}, a1v, t01); t23 = __builtin_elementwise_fma((f32x2){Cb1[2], Cb1[3]}, a1v, t23);
                    s01 = __builtin_elementwise_fma(s01, (f32x2){Cww[0], Cww[1]}, t01); s23 = __builtin_elementwise_fma(s23, (f32x2){Cww[2], Cww[3]}, t23);
                    rprev = Cr1;
                    Ca = Na; Cwa = Nwa; Cwr = Nwr; Cr1 = Nr1; Cww = Nww; Cbw = Nbw; Ckw = Nkw; Cb1 = Nb1; Ck1 = Nk1; Csc = Nsc; Cv0 = Nv0; Cv1 = Nv1;
                }
            }
        }
        __syncthreads();
    }
    if (wave < 4) {
        float d0 = DOT4(rprev), z1 = 0.f, z2 = 0.f, z3 = 0.f; red16x4(d0, z1, z2, z3);
        ykeep = (l16 == 15) ? d0 : ykeep;
        ywr[3 * 512 + 256] = ykeep;
    }
    __syncthreads();
    if (wave >= 4) { SCAN_FLUSH(SEQ / CH - 2); SCAN_FLUSH(SEQ / CH - 1); }
    __syncthreads();
#undef SCAN_FLUSH
#undef SCAN_GL
#undef SCAN_LW
#undef DOT4
#undef LDP
}
__device__ __forceinline__ void post_rows(const Frame& F, int e) {
    const float* Y = (const float*)(F.ws + WS_Y); const bf16_t* sc = (const bf16_t*)(F.ws + WS_SC); const float* cb = (const float*)(F.ws + WS_CB);
    bf16_t* ymix = (bf16_t*)(F.ws + WS_YMIX);
    const float* lg = inp<23>() + e * 512; const float* lb = inp<24>() + e * 512;
    const int lane = F.lane, hh = lane >> 3;
    for (int tl = (F.bid >> 3) * 8 + F.wave; tl < SEQ; tl += F.G) {
        const int tok = (F.bid & 7) * SEQ + tl;
        const int b = tok / SEQ, t = tok % SEQ;
        const f32x4 y0 = *(const f32x4*)(Y + (size_t)tok * 512 + lane * 8), y1 = *(const f32x4*)(Y + (size_t)tok * 512 + lane * 8 + 4);
        float yv[8] = {y0[0], y0[1], y0[2], y0[3], y1[0], y1[1], y1[2], y1[3]};
        float s = 0.f;
#pragma unroll
        for (int k = 0; k < 8; ++k) s += yv[k];
        s += __shfl_xor(s, 1); s += __shfl_xor(s, 2); s += __shfl_xor(s, 4);
        const float mean = s * (1.0f / 64.0f); float qv = 0.f;
#pragma unroll
        for (int k = 0; k < 8; ++k) { yv[k] -= mean; qv += yv[k] * yv[k]; }
        qv += __shfl_xor(qv, 1); qv += __shfl_xor(qv, 2); qv += __shfl_xor(qv, 4);
        const float rstd = rsqrtf(qv * (1.0f / 64.0f) + 64e-5f);
        const u32x4 vr = *(const u32x4*)(sc + ((size_t)(b * 8 + hh) * SEQ + t) * 384 + 5 * 64 + (lane & 7) * 8);
        bf16_t* gp = ymix + (size_t)tok * DM + 512 + lane * 8;
        const u32x4 gr = *(const u32x4*)gp;
        const float cbv = cb[(size_t)tok * 8 + hh];
        float vv[8] = {bflo(vr.x), bfhi(vr.x), bflo(vr.y), bfhi(vr.y), bflo(vr.z), bfhi(vr.z), bflo(vr.w), bfhi(vr.w)};
        float gg[8] = {bflo(gr.x), bfhi(gr.x), bflo(gr.y), bfhi(gr.y), bflo(gr.z), bfhi(gr.z), bflo(gr.w), bfhi(gr.w)};
        float o[8];
#pragma unroll
        for (int k = 0; k < 8; ++k) o[k] = (yv[k] * rstd * lg[lane * 8 + k] + lb[lane * 8 + k] + cbv * vv[k]) * gg[k];
        u32x4 ow; ow.x = pk2(o[0], o[1]); ow.y = pk2(o[2], o[3]); ow.z = pk2(o[4], o[5]); ow.w = pk2(o[6], o[7]);
        st16_wt(gp, ow);
    }
}

__device__ __forceinline__ void conv_item(const Frame& F, int item, int o) {
    const int b = item >> 6, tt = item & 63, t0 = tt * 32, c = F.tid, lane = F.lane, wave = F.wave;
    const bf16_t* z = (const bf16_t*)(F.ws + WS_ACT);
    bf16_t* ymix = (bf16_t*)(F.ws + WS_YMIX);
    const float* cw = inp<31>() + (size_t)o * 31 * 512; const float* cbias = inp<32>() + o * 512;
    const float* lg = inp<33>() + o * 512; const float* lb = inp<34>() + o * 512;
    LAS float* co = (LAS float*)F.lds;
    const size_t tokb = (size_t)b * SEQ;
    float hv[62];
#pragma unroll
    for (int i = 0; i < 62; ++i) {
        const int t = t0 - 30 + i; float hval = 0.f;
        if (t >= 0) { const bf16_t* zp = z + (tokb + t) * POP + 416 + c; const float za = bf1(zp[0]), zg = bf1(zp[512]); hval = za * sigmoidf_(zg); }
        hv[i] = hval;
    }
    float wv[31];
#pragma unroll
    for (int k = 0; k < 31; ++k) wv[k] = cw[k * 512 + c];
    const float bias = cbias[c];
#pragma unroll
    for (int i = 0; i < 32; ++i) {
        float a = bias;
#pragma unroll
        for (int k = 0; k < 31; ++k) a += wv[k] * hv[i + k];
        co[i * 512 + c] = a;
    }
    {
        const int token = F.tid >> 4, i = F.tid & 15, t = t0 + token;
        const bf16_t* zp = z + (tokb + t) * POP + 384;
        const float x1 = bf1(zp[i]), x2 = bf1(zp[16 + i]);
        const float cs = ((const float*)(F.ws + WS_COS))[t * 16 + i], sn = ((const float*)(F.ws + WS_SIN))[t * 16 + i];
        bf16_t* kr = (bf16_t*)(F.ws + WS_SC + SC_KR) + (tokb + t) * 32;
        const int kp_ = 8 * (i >> 2) + (i & 3);
        kr[kp_] = (bf16_t)(pk2(x1 * cs - x2 * sn, 0.f) & 0xffffu); kr[kp_ + 4] = (bf16_t)(pk2(x1 * sn + x2 * cs, 0.f) & 0xffffu);
    }
    __syncthreads();
#pragma unroll
    for (int j = 0; j < 4; ++j) {
        const int ti = wave * 4 + j;
        const f32x4 v0 = *(const LAS f32x4*)(co + ti * 512 + lane * 8), v1 = *(const LAS f32x4*)(co + ti * 512 + lane * 8 + 4);
        float v[8] = {v0[0], v0[1], v0[2], v0[3], v1[0], v1[1], v1[2], v1[3]};
        float s = 0.f;
#pragma unroll
        for (int k = 0; k < 8; ++k) s += v[k];
        const float mean = wave_sum(s) * (1.0f / 512.0f); float qv = 0.f;
#pragma unroll
        for (int k = 0; k < 8; ++k) { v[k] -= mean; qv += v[k] * v[k]; }
        const float rstd = rsqrtf(wave_sum(qv) * (1.0f / 512.0f) + 1e-5f);
        float ov[8];
#pragma unroll
        for (int k = 0; k < 8; ++k) { const float y = v[k] * rstd * lg[lane * 8 + k] + lb[lane * 8 + k]; ov[k] = y * sigmoidf_(y); }
        u32x4 ow; ow.x = pk2(ov[0], ov[1]); ow.y = pk2(ov[2], ov[3]); ow.z = pk2(ov[4], ov[5]); ow.w = pk2(ov[6], ov[7]);
        st16_wt(ymix + (tokb + t0 + ti) * DM + 512 + lane * 8, ow);
    }
    __syncthreads();
}

constexpr int AT_KS = 104, AT_VS = 80, AT_KB = 64 * AT_KS * 2, AT_VB = 64 * AT_VS * 2, AT_BUF = AT_KB + AT_VB;
typedef short v4i16_t __attribute__((ext_vector_type(4)));
__device__ __forceinline__ void attn_unit(const Frame& F, int b, int h, int qb) {
    const int lane = F.lane, wave = F.wave, tid = F.tid, fr = lane & 15, fq = lane >> 4;
    const bf16_t* Q = (const bf16_t*)(F.ws + WS_SC + SC_Q); const bf16_t* KV = (const bf16_t*)(F.ws + WS_SC + SC_KV); const bf16_t* KR = (const bf16_t*)(F.ws + WS_SC + SC_KR);
    bf16_t* ymix = (bf16_t*)(F.ws + WS_YMIX);
    const size_t tokb = (size_t)b * SEQ;
    const int q0 = qb * 256 + wave * 32;
    const int ntb = 4 * qb + 4, ntw = 4 * qb + 1 + (wave >> 1);
    bf16x8 qf[2][3];
#pragma unroll
    for (int mt = 0; mt < 2; ++mt)
#pragma unroll
        for (int ks = 0; ks < 3; ++ks) qf[mt][ks] = *(const bf16x8*)(Q + (tokb + q0 + mt * 16 + fr) * 768 + h * 96 + ks * 32 + fq * 8);
    const int key0 = tid / 12, ch0 = tid % 12, key1 = (tid + 512) / 12, ch1 = (tid + 512) % 12;
    const bool has1 = tid < 256;
    const int vkey = tid >> 3, vch = tid & 7;
    const bf16_t* ksrc0 = (ch0 < 8) ? KV + (tokb + key0) * 1024 + h * 128 + ch0 * 8 : KR + (tokb + key0) * 32 + (ch0 - 8) * 8;
    const bf16_t* ksrc1 = (ch1 < 8) ? KV + (tokb + key1) * 1024 + h * 128 + ch1 * 8 : KR + (tokb + key1) * 32 + (ch1 - 8) * 8;
    const int kstr0 = (ch0 < 8) ? 64 * 1024 : 64 * 32, kstr1 = (ch1 < 8) ? 64 * 1024 : 64 * 32;
    const bf16_t* vsrc = KV + (tokb + vkey) * 1024 + h * 128 + 64 + vch * 8;
    const unsigned kdst0 = key0 * (AT_KS * 2) + ch0 * 16, kdst1 = key1 * (AT_KS * 2) + ch1 * 16;
    u32x4 rk0[2], rk1[2], rv[2];
#pragma unroll
    for (int k = 0; k < 2; ++k) { rk0[k] = (u32x4){0u, 0u, 0u, 0u}; rk1[k] = rk0[k]; rv[k] = rk0[k]; }
#define AT_GLOAD(j, st) do { rk0[st] = *(const u32x4*)(ksrc0 + (size_t)(j) * kstr0); if (has1) rk1[st] = *(const u32x4*)(ksrc1 + (size_t)(j) * kstr1); rv[st] = *(const u32x4*)(vsrc + (size_t)(j) * 64 * 1024); } while (0)
#define AT_LSTORE(bi, st) do { LAS unsigned char* kb_ = F.lds + (bi) * AT_BUF; LAS bf16_t* vb_ = (LAS bf16_t*)(kb_ + AT_KB); \
        *(LAS u32x4*)(kb_ + kdst0) = rk0[st]; if (has1) *(LAS u32x4*)(kb_ + kdst1) = rk1[st]; \
        *(LAS u32x4*)(vb_ + vkey * AT_VS + vch * 8) = rv[st]; } while (0)
    f32x4 o[2][4];
#pragma unroll
    for (int mt = 0; mt < 2; ++mt)
#pragma unroll
        for (int dt = 0; dt < 4; ++dt) o[mt][dt] = (f32x4){0.f, 0.f, 0.f, 0.f};
    float mrun[2] = {-INFINITY, -INFINITY}, lsum[2] = {0.f, 0.f};
#pragma unroll
    for (int k = 0; k < 2; ++k) AT_GLOAD(k, k);
    for (int j0 = 0; j0 < ntb; j0 += 2) {
      AT_LSTORE(j0 & 3, 0); AT_LSTORE((j0 & 3) + 1, 1);
      __syncthreads();
      if (j0 + 2 < ntb) { AT_GLOAD(j0 + 2, 0); AT_GLOAD(j0 + 3, 1); }
#pragma unroll
      for (int kk = 0; kk < 2; ++kk) {
        const int j = j0 + kk;
        if (j < ntw) {
            const LAS unsigned char* kb = F.lds + (j & 3) * AT_BUF; const LAS bf16_t* vb = (const LAS bf16_t*)(kb + AT_KB);
            f32x4 st[2][4];
#pragma unroll
            for (int kt = 0; kt < 4; ++kt) {
                st[0][kt] = (f32x4){0.f, 0.f, 0.f, 0.f}; st[1][kt] = st[0][kt];
#pragma unroll
                for (int ks = 0; ks < 3; ++ks) {
                    const bf16x8 X = *(const LAS bf16x8*)(kb + (kt * 16 + fr) * (AT_KS * 2) + (ks * 32 + fq * 8) * 2);
                    st[0][kt] = __builtin_amdgcn_mfma_f32_16x16x32_bf16(X, qf[0][ks], st[0][kt], 0, 0, 0);
                    st[1][kt] = __builtin_amdgcn_mfma_f32_16x16x32_bf16(X, qf[1][ks], st[1][kt], 0, 0, 0);
                }
            }
            bf16x8 Yp[2][2];
#pragma unroll
            for (int mt = 0; mt < 2; ++mt) {
                float mx = fmaxf(fmaxf(st[mt][0][0], st[mt][0][1]), fmaxf(st[mt][0][2], st[mt][0][3]));
#pragma unroll
                for (int kt = 1; kt < 4; ++kt) mx = fmaxf(mx, fmaxf(fmaxf(st[mt][kt][0], st[mt][kt][1]), fmaxf(st[mt][kt][2], st[mt][kt][3])));
                mx = fmaxf(mx, __shfl_xor(mx, 16)); mx = xor32_max(mx);
                const float mnew = fmaxf(mrun[mt], mx), alpha = __builtin_amdgcn_exp2f(mrun[mt] - mnew);
                mrun[mt] = mnew;
                float ps = 0.f;
#pragma unroll
                for (int kt = 0; kt < 4; ++kt)
#pragma unroll
                    for (int k = 0; k < 4; ++k) { st[mt][kt][k] = __builtin_amdgcn_exp2f(st[mt][kt][k] - mnew); ps += st[mt][kt][k]; }
                lsum[mt] = lsum[mt] * alpha + ps;
#pragma unroll
                for (int dt = 0; dt < 4; ++dt) o[mt][dt] = o[mt][dt] * alpha;
#pragma unroll
                for (int g2 = 0; g2 < 2; ++g2) {
                    u32x4 pw; pw.x = pk2(st[mt][2 * g2][0], st[mt][2 * g2][1]); pw.y = pk2(st[mt][2 * g2][2], st[mt][2 * g2][3]); pw.z = pk2(st[mt][2 * g2 + 1][0], st[mt][2 * g2 + 1][1]); pw.w = pk2(st[mt][2 * g2 + 1][2], st[mt][2 * g2 + 1][3]);
                    Yp[mt][g2] = __builtin_bit_cast(bf16x8, pw);
                }
            }
#pragma unroll
            for (int g2 = 0; g2 < 2; ++g2)
#pragma unroll
                for (int dt = 0; dt < 4; ++dt) {
                    const LAS bf16_t* vp = vb + (g2 * 32 + fq * 4 + (fr >> 2)) * AT_VS + 32 * (dt >> 1) + 8 * (fr & 3) + 4 * (dt & 1);
                    const v4i16_t lo = __builtin_amdgcn_ds_read_tr16_b64_v4i16((LAS v4i16_t*)vp), hi = __builtin_amdgcn_ds_read_tr16_b64_v4i16((LAS v4i16_t*)(vp + 16 * AT_VS));
                    const bf16x8 Xv = (bf16x8){lo[0], lo[1], lo[2], lo[3], hi[0], hi[1], hi[2], hi[3]};
                    o[0][dt] = __builtin_amdgcn_mfma_f32_16x16x32_bf16(Xv, Yp[0][g2], o[0][dt], 0, 0, 0);
                    o[1][dt] = __builtin_amdgcn_mfma_f32_16x16x32_bf16(Xv, Yp[1][g2], o[1][dt], 0, 0, 0);
                }
        }
      }
    }
#undef AT_GLOAD
#undef AT_LSTORE
#pragma unroll
    for (int mt = 0; mt < 2; ++mt) {
        float ls = lsum[mt]; ls += __shfl_xor(ls, 16); ls = xor32_add(ls);
        const float il = 1.0f / ls;
#pragma unroll
        for (int a2 = 0; a2 < 2; ++a2) { const u32x2 p0 = pack4(o[mt][2 * a2] * il), p1 = pack4(o[mt][2 * a2 + 1] * il);
            st16_wt(ymix + (tokb + q0 + mt * 16 + fr) * DM + h * 64 + 32 * a2 + 8 * fq, (u32x4){p0.x, p0.y, p1.x, p1.y}); }
    }
    __syncthreads();
}

constexpr int NPHASE = 1 + 9 * DEPTH + 1;
__global__ void __launch_bounds__(512, 2) mk_fwd(Args args) {
    extern __shared__ __attribute__((aligned(16))) unsigned char lds_raw[];
    Frame F;
    F.lds = (LAS unsigned char*)lds_raw;
    F.tid = threadIdx.x; F.lane = F.tid & 63; F.wave = __builtin_amdgcn_readfirstlane(F.tid >> 6);
    F.G = gridDim.x; F.bid = blockIdx.x; F.out = args.out; F.ws = args.ws;
    const int lo = args.ph_lo, hi = args.ph_hi;
    cg::grid_group grid = cg::this_grid();
    volatile LAS unsigned* bst = (volatile LAS unsigned*)(F.lds + 135168);
    if (threadIdx.x < 8) bst[threadIdx.x] = 0u;
    __syncthreads();
    XcdBarrier xbar = xcd_barrier_post((unsigned*)args.ws, bst);
    int vbid = blockIdx.x; bool regular = false;
#define IN(k) (lo <= (k) && (k) < hi)
#define ENTER() do { int t_ = threadIdx.x; int b_ = vbid; asm volatile("" : "+v"(t_), "+s"(b_)); F.tid = t_; F.lane = t_ & 63; F.wave = __builtin_amdgcn_readfirstlane(t_ >> 6); F.bid = b_; } while (0)
#define SEAM(k) do { if (IN(k) && IN((k) + 1)) { if (regular && (k) != 0 && (((k) - 1) % 9) != 8) xcd_local_barrier(xbar); else xcd_barrier(xbar); } } while (0)

    if (lo > hi) grid.sync();
    if (IN(0)) { ENTER(); { convert_layer(F, 0, 0, 1, F.bid, F.G); x_prologue(F); } }
    SEAM(0);
    if (IN(0) && IN(1)) {
        const unsigned reg_ = bst[2], rank_ = bst[3];
        regular = __builtin_amdgcn_readfirstlane((int)reg_) != 0;
        if (regular) vbid = __builtin_amdgcn_readfirstlane((int)(rank_ * 8u + xbar.x));
    }
    for (int l = 0; l < DEPTH; ++l) {
        const int p0 = 1 + 9 * l; const bool odd = l & 1; const int hl = l >> 1;
        size_t z0 = 0; asm volatile("" : "+s"(z0));
        unsigned char* ws = args.ws + z0;
        F.ws = ws;
        float* ssq = (float*)(ws + WS_SSQ);
        bf16_t* xb = (bf16_t*)(ws + WS_XB); bf16_t* ymix = (bf16_t*)(ws + WS_YMIX); bf16_t* act = (bf16_t*)(ws + WS_ACT);
        const unsigned char* wb = ws + WS_WBUF0 + (size_t)(l & 1) * WBUF_BYTES;
        if (IN(p0 + 0)) {
            ENTER();
            pg8::Gemm g{xb, (const bf16_t*)(wb + WB_W1IN), T, 2 * FF, DM, DM, DM}; pg8::StaticOrder S; S.init(T, 2 * FF, F.G, F.bid);
            EpiSwiGLU E{act, ssq}; pg8::gemm_phase(F.lds, g, S, E);
            ENTER();
            if (l + 1 < DEPTH) {
                const int nfull = ((T / 256) * (2 * FF / 256)) % F.G;
                if (nfull == 0) { __syncthreads(); convert_layer(F, l + 1, 0, 2, F.bid, F.G); }
                else if (F.bid >= nfull) { __syncthreads(); convert_layer(F, l + 1, 0, 2, F.bid - nfull, F.G - nfull); }
            }
        }
        SEAM(p0 + 0);
        if (IN(p0 + 1)) {
            ENTER();
            pg8::Gemm g{act, (const bf16_t*)(wb + WB_W1OUT), T, DM, FF, FF, FF}; pg8::StaticOrder S; S.init(T, DM, F.G, F.bid);
            EpiResid E{xb, ssq, 0.5f}; pg8::gemm_phase(F.lds, g, S, E);
        }
        SEAM(p0 + 1);
        if (IN(p0 + 2)) {
            ENTER();
            if (odd) { pg8::Gemm g{xb, (const bf16_t*)(wb + WB_WMIN), T, POP, DM, DM, DM}; pg8::StaticOrder S; S.init(T, POP, F.G, F.bid);
                EpiZ<true> E{act, POP, ssq, (float*)(ws + WS_PQ), (float*)(ws + WS_PKV)}; pg8::gemm_phase(F.lds, g, S, E); }
            else { pg8::Gemm g{xb, (const bf16_t*)(wb + WB_WMIN), T, PE, DM, DM, DM}; pg8::StaticOrder S; S.init(T, PE, F.G, F.bid);
                EpiZ<false> E{act, PE, ssq, nullptr, nullptr}; pg8::gemm_phase(F.lds, g, S, E); }
        }
        SEAM(p0 + 2);
        if (IN(p0 + 3)) {
            ENTER();
            if (odd) {
                pg8::Gemm g{act, (const bf16_t*)(wb + WB_WX), T, 1792, 384, POP, 384}; pg8::StaticOrder S; S.init(T, 1792, F.G, F.bid);
                EpiUp E{(bf16_t*)(ws + WS_SC + SC_Q), (bf16_t*)(ws + WS_SC + SC_KV), (const float*)(ws + WS_PQ), (const float*)(ws + WS_PKV), (const float*)(ws + WS_COS), (const float*)(ws + WS_SIN)};
                pg8::gemm_phase(F.lds, g, S, E);
                __syncthreads();
                ENTER();
                for (int j = F.bid >> 3; j < 64; j += F.G >> 3) conv_item(F, (F.bid & 7) * 64 + j, hl);
            } else {
                for (int j = F.bid >> 3; j < 64; j += F.G >> 3) prep_item(F, (F.bid & 7) * 64 + j, hl, wb, j == (F.bid >> 3));
                for (int j = F.bid >> 3; j < 64; j += F.G >> 3) gsu_item(F, (F.bid & 7) * 64 + j, hl);
            }
        }
        SEAM(p0 + 3);
        if (IN(p0 + 4)) {
            ENTER();
            if (odd) {
                for (int j = F.bid >> 3; j < 32; j += F.G >> 3) {
                    const int bh = (F.bid & 7) * 8 + (j & 7), pr = j >> 3;
                    attn_unit(F, bh >> 3, bh & 7, pr);
                    attn_unit(F, bh >> 3, bh & 7, 7 - pr);
                }
            } else {
                for (int j = F.bid >> 3; j < 32; j += F.G >> 3) scan_item(F, (F.bid & 7) * 32 + j);
            }
        }
        SEAM(p0 + 4);
        if (IN(p0 + 5)) { ENTER(); if (!odd) post_rows(F, hl); }
        if (!odd) SEAM(p0 + 5);
        if (IN(p0 + 6)) {
            ENTER();
            pg8::Gemm g{ymix, (const bf16_t*)(wb + WB_WMOUT), T, DM, DM, DM, DM}; pg8::StaticOrder S; S.init(T, DM, F.G, F.bid);
            EpiResid E{xb, ssq, 1.0f}; pg8::gemm_phase(F.lds, g, S, E);
        }
        SEAM(p0 + 6);
        if (IN(p0 + 7)) {
            ENTER();
            pg8::Gemm g{xb, (const bf16_t*)(wb + WB_W2IN), T, 2 * FF, DM, DM, DM}; pg8::StaticOrder S; S.init(T, 2 * FF, F.G, F.bid);
            EpiSwiGLU E{act, ssq}; pg8::gemm_phase(F.lds, g, S, E);
            ENTER();
            if (l + 1 < DEPTH) {
                const int nfull = ((T / 256) * (2 * FF / 256)) % F.G;
                if (nfull == 0) { __syncthreads(); convert_layer(F, l + 1, 1, 2, F.bid, F.G); }
                else if (F.bid >= nfull) { __syncthreads(); convert_layer(F, l + 1, 1, 2, F.bid - nfull, F.G - nfull); }
            }
        }
        SEAM(p0 + 7);
        if (IN(p0 + 8)) {
            ENTER();
            pg8::Gemm g{act, (const bf16_t*)(wb + WB_W2OUT), T, DM, FF, FF, FF}; pg8::StaticOrder S; S.init(T, DM, F.G, F.bid);
            EpiResid E{xb, ssq, 0.5f}; pg8::gemm_phase(F.lds, g, S, E);
        }
        SEAM(p0 + 8);
    }
    if (IN(NPHASE - 1)) { ENTER(); final_norm(F); }
#undef IN
#undef SEAM
#undef ENTER
}

extern "C" void kernel_launch(void* const* d_in, const int* in_sizes, int n_in, void* d_out, int out_size, void* d_ws, size_t ws_size, hipStream_t stream) {
    static int grid = 0;
    if (grid == 0) {
        if (n_in != 36 || out_size != T * DM || ws_size < WS_END) { fprintf(stderr, "kernel_launch: unexpected shapes (n_in %d out %d ws %zu)\n", n_in, out_size, ws_size); grid = -1; return; }
        int dev = 0, cus = 0, per_cu = 0;
        (void)hipGetDevice(&dev); (void)hipDeviceGetAttribute(&cus, hipDeviceAttributeMultiprocessorCount, dev);
        (void)hipFuncSetAttribute((const void*)mk_fwd, hipFuncAttributeMaxDynamicSharedMemorySize, LDS_BYTES);
        (void)hipOccupancyMaxActiveBlocksPerMultiprocessor(&per_cu, (const void*)mk_fwd, 512, LDS_BYTES);
        if (per_cu < 1) per_cu = 1;
        grid = cus * per_cu; if (grid > 256) grid = 256; if (grid < 1) grid = 256;
        (void)hipGetLastError();
    }
    if (grid < 0) return;
    (void)hipMemsetAsync(d_ws, 0, 32768, stream);
    Args a{};
    for (int i = 0; i < 36; ++i) a.in[i] = (const float*)d_in[i];
    a.out = (float*)d_out; a.ws = (unsigned char*)d_ws;
#if MK_MULTI
    for (int p = 0; p < NPHASE; ++p) {
        if (p >= 1 && p < NPHASE - 1) { const int l = (p - 1) / 9, k = (p - 1) % 9; if ((l & 1) && k == 5) continue; }
        a.ph_lo = p; a.ph_hi = p + 1;
        hipLaunchKernelGGL(mk_fwd, dim3(grid), dim3(512), LDS_BYTES, stream, a);
    }
#else
    a.ph_lo = 0; a.ph_hi = NPHASE;
    void* kargs[] = {&a};
    hipError_t e = hipLaunchCooperativeKernel((const void*)mk_fwd, dim3(grid), dim3(512), kargs, LDS_BYTES, stream);
    if (e != hipSuccess) fprintf(stderr, "cooperative launch failed: %s (grid %d)\n", hipGetErrorString(e), grid);
#endif
}
```
